# Optimizing an MI355X kernel written in HIP

```python
import jax, jax.numpy as jnp
from jax import lax
import numpy as np

D_MODEL = 1024
BATCH = 4
SEQ = 8192
DEPTH = 2

GRID_W = 64
CTX_LEN = 256
ROPE_THETA = 10000.0
LN_EPS = 1e-6
NEG_INF = -1e30
DN_ALPHA = (2 * DEPTH) ** 0.25
DN_BETA = (8 * DEPTH) ** -0.25
N_EVEN = (DEPTH + 1) // 2
N_ODD = DEPTH // 2

LRU_WIDTH = 512
LRU_BLOCKS = 8
LRU_BLOCK_DIM = LRU_WIDTH // LRU_BLOCKS
LRU_CONV_W = 4
LRU_C = 8.0
SWA_HEADS = 8
SWA_KV_HEADS = 2
SWA_HEAD_DIM = 64
WINDOW = 128
Q_BLOCK = 128
EVEN_IN = 2 * LRU_WIDTH + (SWA_HEADS + 2 * SWA_KV_HEADS) * SWA_HEAD_DIM
EVEN_MIX = LRU_WIDTH + SWA_HEADS * SWA_HEAD_DIM
MLA_HEADS = 8
MLA_Q_RANK = 256
MLA_KV_RANK = 128
MLA_NOPE = 64
MLA_ROPE = 32
MLA_V = 64
CONF_CH = 512
CONF_K = 31
ODD_IN = MLA_Q_RANK + MLA_KV_RANK + MLA_ROPE + 2 * CONF_CH
ODD_MIX = MLA_HEADS * MLA_V + CONF_CH
N_GROUPS = 4
EXPERTS_PER_GROUP = 8
N_EXPERTS = N_GROUPS * EXPERTS_PER_GROUP
TOP_K = 2
D_EXPERT = 512
MOE_BLOCK = 128

kernel_name = "hybrid_rglru_swa_mla_conformer_hmoe_dit"


def _layer_norm(x, g, b):
    xf = x.astype(jnp.float32)
    mu = jnp.mean(xf, axis=-1, keepdims=True)
    var = jnp.mean(jnp.square(xf - mu), axis=-1, keepdims=True)
    return ((xf - mu) * lax.rsqrt(var + LN_EPS) * g + b).astype(x.dtype)


def _rms_norm(x, g):
    xf = x.astype(jnp.float32)
    return (xf * lax.rsqrt(jnp.mean(jnp.square(xf), axis=-1, keepdims=True) + LN_EPS) * g).astype(x.dtype)


def _grid_positions(n):
    rows = n // GRID_W
    row = jnp.repeat(jnp.arange(rows, dtype=jnp.int32), GRID_W)
    col = jnp.tile(jnp.arange(GRID_W, dtype=jnp.int32), rows)
    return row, col


def _rope_1d(x, pos):
    half = x.shape[-1] // 2
    inv_freq = ROPE_THETA ** (-jnp.arange(half, dtype=jnp.float32) / half)
    ang = pos.astype(jnp.float32)[:, None] * inv_freq[None, :]
    cos = jnp.cos(ang)[:, None, :]
    sin = jnp.sin(ang)[:, None, :]
    xf = x.astype(jnp.float32)
    x1, x2 = xf[..., :half], xf[..., half:]
    return jnp.concatenate([x1 * cos - x2 * sin, x1 * sin + x2 * cos], axis=-1).astype(x.dtype)


def _rope_2d(x, row, col):
    d = x.shape[-1] // 2
    return jnp.concatenate([_rope_1d(x[..., :d], row), _rope_1d(x[..., d:], col)], axis=-1)


def _depthwise_conv(x, w, b):
    k, ch = w.shape
    y = lax.conv_general_dilated(x, w[:, None, :].astype(x.dtype), (1,), [((k - 1) // 2, k // 2)],
                                 dimension_numbers=('NWC', 'WIO', 'NWC'), feature_group_count=ch)
    return y + b


def _modulation(cond, w, b):
    m = (jax.nn.silu(cond) @ w + b)[..., None, :]
    return jnp.split(m, 6, axis=-1)


def _modulate(x, shift, scale):
    return x * (1.0 + scale) + shift


def _rglru_coeffs(u, wa, ba, wx, bx, lam):
    bsz, n, w = u.shape
    ub = u.reshape(bsz, n, LRU_BLOCKS, LRU_BLOCK_DIM)
    r = jax.nn.sigmoid((jnp.einsum('bnkc,kcd->bnkd', ub, wa).reshape(bsz, n, w) + ba).astype(jnp.float32))
    i = jax.nn.sigmoid((jnp.einsum('bnkc,kcd->bnkd', ub, wx).reshape(bsz, n, w) + bx).astype(jnp.float32))
    log_a = -LRU_C * r * jax.nn.softplus(-lam.astype(jnp.float32))
    a = jnp.exp(log_a)
    b = jnp.sqrt(-jnp.expm1(2.0 * log_a)) * (i * u.astype(jnp.float32))
    return a, b


def _linear_scan(a, b, h0):
    b = b.at[:, 0].add(a[:, 0] * h0)

    def combine(left, right):
        a_l, b_l = left
        a_r, b_r = right
        return a_l * a_r, a_r * b_l + b_r

    return lax.associative_scan(combine, (a, b), axis=1)[1]


def _rglru_bidir(u_ctx, u_lat, wa, ba, wx, bx, lam):
    h_ctx = 0.0
    h_lat = 0.0
    for d in range(2):
        a_c, b_c = _rglru_coeffs(u_ctx, wa[d], ba[d], wx[d], bx[d], lam[d])
        a_l, b_l = _rglru_coeffs(u_lat, wa[d], ba[d], wx[d], bx[d], lam[d])
        if d == 1:
            a_c, b_c, a_l, b_l = [jnp.flip(t, axis=1) for t in (a_c, b_c, a_l, b_l)]
        s_c = _linear_scan(a_c, b_c, jnp.zeros_like(a_c[:, 0]))
        s_l = _linear_scan(a_l, b_l, s_c[:, -1])
        if d == 1:
            s_c, s_l = jnp.flip(s_c, axis=1), jnp.flip(s_l, axis=1)
        h_ctx = h_ctx + s_c
        h_lat = h_lat + s_l
    return h_ctx, h_lat


def _sink_column(sink, kvh, g, shape):
    return jnp.broadcast_to(sink.astype(jnp.float32).reshape(kvh, g)[:, :, None, None], shape)


def _swa_latent(q, k, v, k_ctx, v_ctx, sink):
    bsz, n, h, hd = q.shape
    kvh = k.shape[2]
    g = h // kvh
    nb = n // Q_BLOCK
    qb = q.reshape(bsz, nb, Q_BLOCK, kvh, g, hd)

    def band(t):
        tb = jnp.pad(t.reshape(bsz, nb, Q_BLOCK, kvh, hd), ((0, 0), (1, 1), (0, 0), (0, 0), (0, 0)))
        return jnp.concatenate([tb[:, :-2], tb[:, 1:-1], tb[:, 2:]], axis=2)

    kb, vb = band(k), band(v)
    scale = hd ** -0.5
    s_win = jnp.einsum('bnqkgd,bnmkd->bnkgqm', qb, kb).astype(jnp.float32) * scale
    qpos = jnp.arange(nb)[:, None] * Q_BLOCK + jnp.arange(Q_BLOCK)[None, :]
    kpos = (jnp.arange(nb)[:, None] - 1) * Q_BLOCK + jnp.arange(3 * Q_BLOCK)[None, :]
    valid = (jnp.abs(qpos[:, :, None] - kpos[:, None, :]) <= WINDOW) & (kpos[:, None, :] >= 0) & (kpos[:, None, :] < n)
    s_win = jnp.where(valid[None, :, None, None], s_win, NEG_INF)
    s_ctx = jnp.einsum('bnqkgd,bckd->bnkgqc', qb, k_ctx).astype(jnp.float32) * scale
    s_sink = _sink_column(sink, kvh, g, s_win.shape[:-1] + (1,))
    p = jax.nn.softmax(jnp.concatenate([s_win, s_ctx, s_sink], axis=-1), axis=-1)
    nw = 3 * Q_BLOCK
    p_win = p[..., :nw].astype(v.dtype)
    p_ctx = p[..., nw:nw + k_ctx.shape[1]].astype(v.dtype)
    out = jnp.einsum('bnkgqm,bnmkd->bnqkgd', p_win, vb) + jnp.einsum('bnkgqc,bckd->bnqkgd', p_ctx, v_ctx)
    return out.reshape(bsz, n, h * hd)


def _gqa_sink_dense(q, k, v, sink):
    bsz, n, h, hd = q.shape
    kvh = k.shape[2]
    g = h // kvh
    qg = q.reshape(bsz, n, kvh, g, hd)
    s = jnp.einsum('bqkgd,bckd->bkgqc', qg, k).astype(jnp.float32) * hd ** -0.5
    s_sink = _sink_column(sink, kvh, g, s.shape[:-1] + (1,))
    p = jax.nn.softmax(jnp.concatenate([s, s_sink], axis=-1), axis=-1)[..., :-1]
    return jnp.einsum('bkgqc,bckd->bqkgd', p.astype(v.dtype), v).reshape(bsz, n, h * hd)


def _dense_attn(q, k, v):
    s = jnp.einsum('bqhd,bkhd->bhqk', q, k).astype(jnp.float32) * q.shape[-1] ** -0.5
    p = jax.nn.softmax(s, axis=-1).astype(v.dtype)
    return jnp.einsum('bhqk,bkhd->bqhd', p, v)


def _mla_q(cq, q_norm, w_uq, pos):
    bsz, n, _ = cq.shape
    q = (_rms_norm(cq, q_norm) @ w_uq).reshape(bsz, n, MLA_HEADS, MLA_NOPE + MLA_ROPE)
    q_pe = q[..., MLA_NOPE:]
    if pos is not None:
        q_pe = _rope_2d(q_pe, *pos)
    return jnp.concatenate([q[..., :MLA_NOPE], q_pe], axis=-1)


def _mla_kv(ckv, kpe, kv_norm, w_uk, w_uv, pos):
    bsz, n, _ = ckv.shape
    c_n = _rms_norm(ckv, kv_norm)
    k_nope = (c_n @ w_uk).reshape(bsz, n, MLA_HEADS, MLA_NOPE)
    v = (c_n @ w_uv).reshape(bsz, n, MLA_HEADS, MLA_V)
    k_pe = kpe[:, :, None, :]
    if pos is not None:
        k_pe = _rope_2d(k_pe, *pos)
    k = jnp.concatenate([k_nope, jnp.broadcast_to(k_pe, (bsz, n, MLA_HEADS, MLA_ROPE))], axis=-1)
    return k, v


def _mla_latent(q, k, v, k_ctx, v_ctx):
    bsz, n, h, dq = q.shape
    keys = jnp.concatenate([k_ctx, k], axis=1)
    vals = jnp.concatenate([v_ctx, v], axis=1)
    qb = jnp.moveaxis(q.reshape(bsz, n // Q_BLOCK, Q_BLOCK, h, dq), 1, 0)
    out = lax.map(lambda qi: _dense_attn(qi, keys, vals), qb)
    return jnp.moveaxis(out, 0, 1).reshape(bsz, n, h * v.shape[-1])


def _conformer_conv(u, dw_w, dw_b, ln_g, ln_b):
    a, gate = jnp.split(u, 2, axis=-1)
    y = _depthwise_conv(a * jax.nn.sigmoid(gate), dw_w, dw_b)
    return jax.nn.silu(_layer_norm(y, ln_g, ln_b))


def _even_mixer(h_lat, h_ctx, pos, need_ctx, w_in, b_in, conv_w, conv_b, wa, ba, wx, bx, lam, sink, w_out, b_out):
    splits = np.cumsum([LRU_WIDTH, LRU_WIDTH, SWA_HEADS * SWA_HEAD_DIM, SWA_KV_HEADS * SWA_HEAD_DIM]).tolist()

    def project(h):
        bsz, n, _ = h.shape
        g, u, q, k, v = jnp.split(h @ w_in + b_in, splits, axis=-1)
        return (g, u, q.reshape(bsz, n, SWA_HEADS, SWA_HEAD_DIM),
                k.reshape(bsz, n, SWA_KV_HEADS, SWA_HEAD_DIM), v.reshape(bsz, n, SWA_KV_HEADS, SWA_HEAD_DIM))

    g_l, u_l, q_l, k_l, v_l = project(h_lat)
    g_c, u_c, q_c, k_c, v_c = project(h_ctx)
    rec_c, rec_l = _rglru_bidir(_depthwise_conv(u_c, conv_w, conv_b), _depthwise_conv(u_l, conv_w, conv_b),
                                wa, ba, wx, bx, lam)
    att_l = _swa_latent(_rope_2d(q_l, *pos), _rope_2d(k_l, *pos), v_l, k_c, v_c, sink)
    y_l = jnp.concatenate([jax.nn.gelu(g_l) * rec_l.astype(g_l.dtype), att_l], axis=-1) @ w_out + b_out
    y_c = None
    if need_ctx:
        att_c = _gqa_sink_dense(q_c, k_c, v_c, sink)
        y_c = jnp.concatenate([jax.nn.gelu(g_c) * rec_c.astype(g_c.dtype), att_c], axis=-1) @ w_out + b_out
    return y_l, y_c


def _odd_mixer(h_lat, h_ctx, pos, need_ctx, w_in, b_in, q_norm, kv_norm, w_uq, w_uk, w_uv,
               dw_w, dw_b, cln_g, cln_b, w_out, b_out):
    splits = np.cumsum([MLA_Q_RANK, MLA_KV_RANK, MLA_ROPE]).tolist()
    cq_l, ckv_l, kpe_l, cv_l = jnp.split(h_lat @ w_in + b_in, splits, axis=-1)
    cq_c, ckv_c, kpe_c, cv_c = jnp.split(h_ctx @ w_in + b_in, splits, axis=-1)
    k_c, v_c = _mla_kv(ckv_c, kpe_c, kv_norm, w_uk, w_uv, None)
    k_l, v_l = _mla_kv(ckv_l, kpe_l, kv_norm, w_uk, w_uv, pos)
    att_l = _mla_latent(_mla_q(cq_l, q_norm, w_uq, pos), k_l, v_l, k_c, v_c)
    conv_l = _conformer_conv(cv_l, dw_w, dw_b, cln_g, cln_b)
    y_l = jnp.concatenate([att_l, conv_l], axis=-1) @ w_out + b_out
    y_c = None
    if need_ctx:
        bsz, n, _ = cq_c.shape
        att_c = _dense_attn(_mla_q(cq_c, q_norm, w_uq, None), k_c, v_c).reshape(bsz, n, MLA_HEADS * MLA_V)
        conv_c = _conformer_conv(cv_c, dw_w, dw_b, cln_g, cln_b)
        y_c = jnp.concatenate([att_c, conv_c], axis=-1) @ w_out + b_out
    return y_l, y_c


def _hier_moe(h, w_group, b_group, w_router, b_router, w1, w3, w2):
    n_tok, d = h.shape
    g_logits = (h @ w_group + b_group).astype(jnp.float32)
    g_idx = jnp.argmax(g_logits, axis=-1)
    g_prob = jnp.take_along_axis(jax.nn.softmax(g_logits, axis=-1), g_idx[:, None], axis=-1)
    e_logits = (h @ w_router + b_router).astype(jnp.float32).reshape(n_tok, N_GROUPS, EXPERTS_PER_GROUP)
    e_logits = jnp.take_along_axis(e_logits, g_idx[:, None, None], axis=1)[:, 0]
    top_p, top_i = lax.top_k(jax.nn.softmax(e_logits, axis=-1), TOP_K)
    gates = g_prob * top_p / jnp.sum(top_p, axis=-1, keepdims=True)
    expert = (g_idx[:, None] * EXPERTS_PER_GROUP + top_i).reshape(-1)
    token = jnp.repeat(jnp.arange(n_tok, dtype=jnp.int32), TOP_K)
    gate = gates.reshape(-1)
    n_assign = n_tok * TOP_K
    order = jnp.argsort(expert)
    e_s, t_s, g_s = expert[order], token[order], gate[order]
    counts = jnp.bincount(expert, length=N_EXPERTS)
    starts = jnp.cumsum(counts) - counts
    padded = (counts + MOE_BLOCK - 1) // MOE_BLOCK * MOE_BLOCK
    p_ends = jnp.cumsum(padded)
    p_starts = p_ends - padded
    dest = p_starts[e_s] + jnp.arange(n_assign) - starts[e_s]
    n_blocks = -(-(n_assign + N_EXPERTS * (MOE_BLOCK - 1)) // MOE_BLOCK)
    slot_tok = jnp.zeros((n_blocks * MOE_BLOCK,), jnp.int32).at[dest].set(t_s)
    slot_gate = jnp.zeros((n_blocks * MOE_BLOCK,), jnp.float32).at[dest].set(g_s)
    block_expert = jnp.minimum(jnp.searchsorted(p_ends, jnp.arange(n_blocks) * MOE_BLOCK, side='right'), N_EXPERTS - 1)
    xb = h[slot_tok].reshape(n_blocks, MOE_BLOCK, d)

    def expert_block(args):
        xi, e = args
        return (jax.nn.silu(xi @ w1[e]) * (xi @ w3[e])) @ w2[e]

    yb = lax.map(expert_block, (xb, block_expert)).reshape(-1, d)
    return jax.ops.segment_sum(yb * slot_gate[:, None].astype(yb.dtype), slot_tok, num_segments=n_tok)


def setup_inputs(seed: int = 0) -> dict:
    key = jax.random.key(seed)
    keys = jax.random.split(key, 64)
    counter = [0]

    def nxt():
        k = keys[counter[0]]
        counter[0] += 1
        return k

    def nrm(shape, scale):
        return jax.random.normal(nxt(), shape, jnp.float32) * scale

    def gain(shape):
        return 1.0 + nrm(shape, 0.05)

    D = D_MODEL
    u = jax.random.uniform(nxt(), (N_EVEN, 2, LRU_WIDTH), jnp.float32, 0.9, 0.999)
    a0 = u ** (1.0 / LRU_C)
    lam = jnp.log(a0) - jnp.log1p(-a0)
    return {
        "x": nrm((BATCH, SEQ, D), 1.0),
        "c": nrm((BATCH, D), 1.0),
        "ctx": nrm((BATCH, CTX_LEN, D), 1.0),
        "c_ctx": nrm((D,), 1.0),
        "w_mod": nrm((DEPTH, D, 6 * D), 0.5 * D ** -0.5),
        "b_mod": nrm((DEPTH, 6 * D), 0.02),
        "ln_g": gain((DEPTH, 2, D)),
        "ln_b": nrm((DEPTH, 2, D), 0.02),
        "e_w_in": nrm((N_EVEN, D, EVEN_IN), D ** -0.5),
        "e_b_in": nrm((N_EVEN, EVEN_IN), 0.02),
        "e_conv_w": nrm((N_EVEN, LRU_CONV_W, LRU_WIDTH), LRU_CONV_W ** -0.5),
        "e_conv_b": nrm((N_EVEN, LRU_WIDTH), 0.02),
        "e_lru_wa": nrm((N_EVEN, 2, LRU_BLOCKS, LRU_BLOCK_DIM, LRU_BLOCK_DIM), LRU_BLOCK_DIM ** -0.5),
        "e_lru_ba": nrm((N_EVEN, 2, LRU_WIDTH), 0.02),
        "e_lru_wx": nrm((N_EVEN, 2, LRU_BLOCKS, LRU_BLOCK_DIM, LRU_BLOCK_DIM), LRU_BLOCK_DIM ** -0.5),
        "e_lru_bx": nrm((N_EVEN, 2, LRU_WIDTH), 0.02),
        "e_lru_lambda": lam,
        "e_sink": nrm((N_EVEN, SWA_HEADS), 0.5),
        "e_w_out": nrm((N_EVEN, EVEN_MIX, D), EVEN_MIX ** -0.5 * DN_BETA),
        "e_b_out": nrm((N_EVEN, D), 0.02),
        "o_w_in": nrm((N_ODD, D, ODD_IN), D ** -0.5),
        "o_b_in": nrm((N_ODD, ODD_IN), 0.02),
        "o_q_norm": gain((N_ODD, MLA_Q_RANK)),
        "o_kv_norm": gain((N_ODD, MLA_KV_RANK)),
        "o_w_uq": nrm((N_ODD, MLA_Q_RANK, MLA_HEADS * (MLA_NOPE + MLA_ROPE)), MLA_Q_RANK ** -0.5),
        "o_w_uk": nrm((N_ODD, MLA_KV_RANK, MLA_HEADS * MLA_NOPE), MLA_KV_RANK ** -0.5),
        "o_w_uv": nrm((N_ODD, MLA_KV_RANK, MLA_HEADS * MLA_V), MLA_KV_RANK ** -0.5),
        "o_dw_w": nrm((N_ODD, CONF_K, CONF_CH), CONF_K ** -0.5),
        "o_dw_b": nrm((N_ODD, CONF_CH), 0.02),
        "o_cln_g": gain((N_ODD, CONF_CH)),
        "o_cln_b": nrm((N_ODD, CONF_CH), 0.02),
        "o_w_out": nrm((N_ODD, ODD_MIX, D), ODD_MIX ** -0.5 * DN_BETA),
        "o_b_out": nrm((N_ODD, D), 0.02),
        "moe_w_group": nrm((DEPTH, D, N_GROUPS), D ** -0.5),
        "moe_b_group": nrm((DEPTH, N_GROUPS), 0.01),
        "moe_w_router": nrm((DEPTH, D, N_EXPERTS), D ** -0.5),
        "moe_b_router": nrm((DEPTH, N_EXPERTS), 0.01),
        "moe_w1": nrm((DEPTH, N_EXPERTS, D, D_EXPERT), D ** -0.5),
        "moe_w3": nrm((DEPTH, N_EXPERTS, D, D_EXPERT), D ** -0.5),
        "moe_w2": nrm((DEPTH, N_EXPERTS, D_EXPERT, D), D_EXPERT ** -0.5 * DN_BETA),
    }


def reference(x, c, ctx, c_ctx, w_mod, b_mod, ln_g, ln_b,
              e_w_in, e_b_in, e_conv_w, e_conv_b, e_lru_wa, e_lru_ba, e_lru_wx, e_lru_bx, e_lru_lambda,
              e_sink, e_w_out, e_b_out,
              o_w_in, o_b_in, o_q_norm, o_kv_norm, o_w_uq, o_w_uk, o_w_uv, o_dw_w, o_dw_b, o_cln_g, o_cln_b,
              o_w_out, o_b_out,
              moe_w_group, moe_b_group, moe_w_router, moe_b_router, moe_w1, moe_w3, moe_w2):
    pos = _grid_positions(x.shape[1])
    x_lat, x_ctx = x, ctx
    for layer in range(DEPTH):
        need_ctx = layer < DEPTH - 1
        m_l = _modulation(c, w_mod[layer], b_mod[layer])
        m_c = _modulation(c_ctx, w_mod[layer], b_mod[layer])
        h_l = _modulate(x_lat, m_l[0], m_l[1])
        h_c = _modulate(x_ctx, m_c[0], m_c[1])
        p = layer // 2
        if layer % 2 == 0:
            y_l, y_c = _even_mixer(h_l, h_c, pos, need_ctx, e_w_in[p], e_b_in[p], e_conv_w[p], e_conv_b[p],
                                   e_lru_wa[p], e_lru_ba[p], e_lru_wx[p], e_lru_bx[p], e_lru_lambda[p],
                                   e_sink[p], e_w_out[p], e_b_out[p])
        else:
            y_l, y_c = _odd_mixer(h_l, h_c, pos, need_ctx, o_w_in[p], o_b_in[p], o_q_norm[p], o_kv_norm[p],
                                  o_w_uq[p], o_w_uk[p], o_w_uv[p], o_dw_w[p], o_dw_b[p], o_cln_g[p], o_cln_b[p],
                                  o_w_out[p], o_b_out[p])
        x_lat = _layer_norm(DN_ALPHA * x_lat + m_l[2] * y_l, ln_g[layer, 0], ln_b[layer, 0])
        f_l = _modulate(x_lat, m_l[3], m_l[4])
        n_lat = f_l.shape[0] * f_l.shape[1]
        if need_ctx:
            x_ctx = _layer_norm(DN_ALPHA * x_ctx + m_c[2] * y_c, ln_g[layer, 0], ln_b[layer, 0])
            f_c = _modulate(x_ctx, m_c[3], m_c[4])
            tokens = jnp.concatenate([f_l.reshape(n_lat, -1), f_c.reshape(-1, f_c.shape[-1])], axis=0)
        else:
            tokens = f_l.reshape(n_lat, -1)
        ffn = _hier_moe(tokens, moe_w_group[layer], moe_b_group[layer], moe_w_router[layer], moe_b_router[layer],
                        moe_w1[layer], moe_w3[layer], moe_w2[layer])
        x_lat = _layer_norm(DN_ALPHA * x_lat + m_l[5] * ffn[:n_lat].reshape(x_lat.shape), ln_g[layer, 1], ln_b[layer, 1])
        if need_ctx:
            x_ctx = _layer_norm(DN_ALPHA * x_ctx + m_c[5] * ffn[n_lat:].reshape(x_ctx.shape), ln_g[layer, 1], ln_b[layer, 1])
    return x_lat
```

```cpp
#ifndef CPU_SIM
#include <hip/hip_runtime.h>
#include <hip/hip_cooperative_groups.h>
#include <cstdio>
namespace cg = cooperative_groups;
#define DEV __device__ __forceinline__
#else
#define DEV inline
#endif
#include <cstdint>
#include <cmath>

#ifdef SIM_SMALL
constexpr int DM = 192, NB = 2, SEQ = 512, CTX = 64, GRID_W = 64;
constexpr int LRU_W = 64, LRU_NBLK = 8, SWA_H = 8, SWA_KV = 2, SWA_HD = 16, WINDOW = 128;
constexpr int MLA_H = 8, MLA_QR = 32, MLA_KVR = 16, MLA_NOPE = 16, MLA_ROPE = 8, MLA_V = 16;
constexpr int CONF_CH = 64, CONF_K = 31, N_GROUPS = 4, EPG = 8, D_EXP = 32;
#else
constexpr int DM = 1024, NB = 4, SEQ = 8192, CTX = 256, GRID_W = 64;
constexpr int LRU_W = 512, LRU_NBLK = 8, SWA_H = 8, SWA_KV = 2, SWA_HD = 64, WINDOW = 128;
constexpr int MLA_H = 8, MLA_QR = 256, MLA_KVR = 128, MLA_NOPE = 64, MLA_ROPE = 32, MLA_V = 64;
constexpr int CONF_CH = 512, CONF_K = 31, N_GROUPS = 4, EPG = 8, D_EXP = 512;
#endif
constexpr int LRU_BD = LRU_W / LRU_NBLK;
constexpr int SWA_Q = SWA_H * SWA_HD, SWA_KVW = SWA_KV * SWA_HD;
constexpr int EVEN_IN = 2 * LRU_W + SWA_Q + 2 * SWA_KVW, EVEN_MIX = LRU_W + SWA_Q;
constexpr int MLA_QD = MLA_NOPE + MLA_ROPE;
constexpr int ODD_IN = MLA_QR + MLA_KVR + MLA_ROPE + 2 * CONF_CH, ODD_MIX = MLA_H * MLA_V + CONF_CH;
constexpr int N_EXP = N_GROUPS * EPG;
constexpr int TL = NB * SEQ, TC = NB * CTX, TT = TL + TC;
constexpr int PLD = (EVEN_IN > ODD_IN ? EVEN_IN : ODD_IN);
constexpr float LN_EPS = 1e-6f, LRU_C = 8.0f;
constexpr float DN_ALPHA = 1.41421356237309515f;
static_assert(EVEN_MIX == DM && ODD_MIX == DM, "mixer widths");

typedef unsigned short bf16_t;
DEV bf16_t f2bf(float f) { unsigned u; __builtin_memcpy(&u, &f, 4); u = (u + 0x7fffu + ((u >> 16) & 1u)) >> 16; return (bf16_t)u; }
DEV float bf2f(bf16_t h) { unsigned u = ((unsigned)h) << 16; float f; __builtin_memcpy(&f, &u, 4); return f; }

struct Params {
    const float *x, *c, *ctx, *c_ctx, *w_mod, *b_mod, *ln_g, *ln_b;
    const float *e_w_in, *e_b_in, *e_conv_w, *e_conv_b, *e_wa, *e_ba, *e_wx, *e_bx, *e_lam, *e_sink, *e_w_out, *e_b_out;
    const float *o_w_in, *o_b_in, *o_q_norm, *o_kv_norm, *o_w_uq, *o_w_uk, *o_w_uv, *o_dw_w, *o_dw_b, *o_cln_g, *o_cln_b, *o_w_out, *o_b_out;
    const float *moe_wg, *moe_bg, *moe_wr, *moe_br, *moe_w1, *moe_w3, *moe_w2;
    float* out;
    float* MOD;
    float* XC;
    float* R1;
    float* R2;
    float* R3;
    int* cnt;
    int* slot_tok;
    float* slot_gate;
    int ph_lo, ph_hi;
};
constexpr size_t R3_FLOATS = (size_t)TT * DM + (size_t)TT * 128;

DEV float sigmoidf_(float v) { return 1.0f / (1.0f + expf(-v)); }
DEV float siluf_(float v) { return v * sigmoidf_(v); }
DEV float geluf_(float v) { return 0.5f * v * (1.0f + tanhf(0.7978845608028654f * (v + 0.044715f * v * v * v))); }
DEV float softplusf_(float v) { return v > 20.f ? v : log1pf(expf(v)); }

DEV void ph_mod(const Params& p, long gtid, long gsize) {
    const long total = 2L * (NB + 1) * 6 * DM;
    for (long i = gtid; i < total; i += gsize) {
        const int j = (int)(i % (6 * DM)); const int cn = (int)((i / (6 * DM)) % (NB + 1)); const int l = (int)(i / ((long)6 * DM * (NB + 1)));
        const float* cond = cn < NB ? p.c + (size_t)cn * DM : p.c_ctx;
        const float* w = p.w_mod + (size_t)l * DM * 6 * DM;
        float acc = p.b_mod[(size_t)l * 6 * DM + j];
        for (int k = 0; k < DM; ++k) acc += siluf_(cond[k]) * w[(size_t)k * 6 * DM + j];
        p.MOD[i] = acc;
    }
    for (long i = gtid; i < 2 * N_EXP; i += gsize) p.cnt[i] = 0;
}
DEV int cond_of_row(int r) { return r < TL ? r / SEQ : NB; }
DEV void ph_modulate(const Params& p, int l, long gtid, long gsize) {
    const long total = (long)TT * DM;
    for (long i = gtid; i < total; i += gsize) {
        const int r = (int)(i / DM), d = (int)(i % DM);
        const float* xin = l == 0 ? (r < TL ? p.x + (size_t)r * DM : p.ctx + (size_t)(r - TL) * DM) : (r < TL ? p.out + (size_t)r * DM : p.XC + (size_t)(r - TL) * DM);
        const float* m = p.MOD + ((size_t)l * (NB + 1) + cond_of_row(r)) * 6 * DM;
        p.R1[i] = xin[d] * (1.0f + m[DM + d]) + m[d];
    }
}
template <bool OUT_BF16>
DEV void ph_gemm(const float* A, int lda, const float* B, int ldb, const float* bias, void* C, int ldc, int M, int N, int K, long gtid, long gsize) {
    const int n4 = N / 4; const long total = (long)(M / 4) * n4;
    for (long i = gtid; i < total; i += gsize) {
        const int nn = (int)(i % n4) * 4; const int mm = (int)(i / n4) * 4;
        float acc[4][4];
#pragma unroll
        for (int a = 0; a < 4; ++a)
#pragma unroll
            for (int b = 0; b < 4; ++b) acc[a][b] = bias ? bias[nn + b] : 0.f;
        for (int k = 0; k < K; ++k) {
            float av[4], bv[4];
#pragma unroll
            for (int a = 0; a < 4; ++a) av[a] = A[(size_t)(mm + a) * lda + k];
#pragma unroll
            for (int b = 0; b < 4; ++b) bv[b] = B[(size_t)k * ldb + nn + b];
#pragma unroll
            for (int a = 0; a < 4; ++a)
#pragma unroll
                for (int b = 0; b < 4; ++b) acc[a][b] += av[a] * bv[b];
        }
#pragma unroll
        for (int a = 0; a < 4; ++a)
#pragma unroll
            for (int b = 0; b < 4; ++b) {
                if (OUT_BF16) ((bf16_t*)C)[(size_t)(mm + a) * ldc + nn + b] = f2bf(acc[a][b]);
                else ((float*)C)[(size_t)(mm + a) * ldc + nn + b] = acc[a][b];
            }
    }
}
DEV void seq_bounds(int r, int& lo, int& hi) { if (r < TL) { lo = (r / SEQ) * SEQ; hi = lo + SEQ; } else { lo = TL + ((r - TL) / CTX) * CTX; hi = lo + CTX; } }
DEV void ph_conv4(const Params& p, long gtid, long gsize) {
    float* UC = p.R3; const float* P = p.R2;
    const long total = (long)TT * LRU_W;
    for (long i = gtid; i < total; i += gsize) {
        const int r = (int)(i / LRU_W), c = (int)(i % LRU_W); int lo, hi; seq_bounds(r, lo, hi);
        float acc = p.e_conv_b[c];
#pragma unroll
        for (int j = 0; j < 4; ++j) { const int rr = r + j - 1; if (rr >= lo && rr < hi) acc += p.e_conv_w[j * LRU_W + c] * P[(size_t)rr * PLD + LRU_W + c]; }
        UC[i] = acc;
    }
}
DEV void lru_gate(const Params& p, const float* UC, int row, int d, int c, float& a, float& b) {
    const int blk = c / LRU_BD, cd = c % LRU_BD;
    const float* wa = p.e_wa + ((size_t)(d * LRU_NBLK + blk) * LRU_BD) * LRU_BD + cd;
    const float* wx = p.e_wx + ((size_t)(d * LRU_NBLK + blk) * LRU_BD) * LRU_BD + cd;
    const float* u = UC + (size_t)row * LRU_W + blk * LRU_BD;
    float ra = p.e_ba[d * LRU_W + c], ri = p.e_bx[d * LRU_W + c];
    for (int k = 0; k < LRU_BD; ++k) { ra += u[k] * wa[(size_t)k * LRU_BD]; ri += u[k] * wx[(size_t)k * LRU_BD]; }
    const float r = sigmoidf_(ra), ii = sigmoidf_(ri);
    const float log_a = -LRU_C * r * softplusf_(-p.e_lam[d * LRU_W + c]);
    a = expf(log_a); b = sqrtf(-expm1f(2.0f * log_a)) * (ii * UC[(size_t)row * LRU_W + c]);
}
DEV void ph_scan(const Params& p, long gtid, long gsize) {
    const float* UC = p.R3; float* MIX = p.R1;
    for (long i = gtid; i < (long)NB * LRU_W; i += gsize) {
        const int b = (int)(i / LRU_W), c = (int)(i % LRU_W);
        float h = 0.f, a, bb;
        for (int s = 0; s < CTX; ++s) { const int row = TL + b * CTX + s; lru_gate(p, UC, row, 0, c, a, bb); h = a * h + bb; MIX[(size_t)row * DM + c] = h; }
        for (int s = 0; s < SEQ; ++s) { const int row = b * SEQ + s; lru_gate(p, UC, row, 0, c, a, bb); h = a * h + bb; MIX[(size_t)row * DM + c] = h; }
        h = 0.f;
        for (int s = CTX - 1; s >= 0; --s) { const int row = TL + b * CTX + s; lru_gate(p, UC, row, 1, c, a, bb); h = a * h + bb; MIX[(size_t)row * DM + c] += h; }
        for (int s = SEQ - 1; s >= 0; --s) { const int row = b * SEQ + s; lru_gate(p, UC, row, 1, c, a, bb); h = a * h + bb; MIX[(size_t)row * DM + c] += h; }
    }
}
DEV void rope_cs(int s, int part, int i, int half, float& cs, float& sn) {
    const int pos = part == 0 ? s / GRID_W : s % GRID_W;
    const float inv = powf(10000.0f, -(float)i / (float)half);
    const float ang = (float)pos * inv; cs = cosf(ang); sn = sinf(ang);
}
DEV void ph_rope_swa(const Params& p, long gtid, long gsize) {
    float* P = p.R2; constexpr int half = SWA_HD / 4, NH = SWA_H + SWA_KV;
    const long total = (long)TL * NH * 2 * half;
    for (long i = gtid; i < total; i += gsize) {
        const int pi = (int)(i % half); const int part = (int)((i / half) % 2); const int hh = (int)((i / (2 * half)) % NH); const int r = (int)(i / ((long)2 * half * NH));
        float* v = P + (size_t)r * PLD + 2 * LRU_W + hh * SWA_HD + part * (SWA_HD / 2);
        float cs, sn; rope_cs(r % SEQ, part, pi, half, cs, sn);
        const float x1 = v[pi], x2 = v[half + pi];
        v[pi] = x1 * cs - x2 * sn; v[half + pi] = x1 * sn + x2 * cs;
    }
}
DEV void ph_swa(const Params& p, long gtid, long gsize) {
    const float* P = p.R2; float* MIX = p.R1;
    const float scale = 1.0f / sqrtf((float)SWA_HD);
    for (long i = gtid; i < (long)TL * SWA_H; i += gsize) {
        const int r = (int)(i % TL), h = (int)(i / TL), kv = h / (SWA_H / SWA_KV), b = r / SEQ, s = r % SEQ;
        float q[SWA_HD], o[SWA_HD];
#pragma unroll
        for (int d = 0; d < SWA_HD; ++d) { q[d] = P[(size_t)r * PLD + 2 * LRU_W + h * SWA_HD + d] * scale; o[d] = 0.f; }
        float m = p.e_sink[h], l = 1.0f;
        const int klo = s - WINDOW < 0 ? 0 : s - WINDOW, khi = s + WINDOW >= SEQ ? SEQ - 1 : s + WINDOW;
        const int nwin = khi - klo + 1;
        for (int kk = 0; kk < nwin + CTX; ++kk) {
            const int kr = kk < nwin ? b * SEQ + klo + kk : TL + b * CTX + (kk - nwin);
            const float* kp = P + (size_t)kr * PLD + 2 * LRU_W + SWA_Q + kv * SWA_HD; const float* vp = kp + SWA_KVW;
            float sc = 0.f;
#pragma unroll
            for (int d = 0; d < SWA_HD; ++d) sc += q[d] * kp[d];
            const float mn = fmaxf(m, sc), f = expf(m - mn), pe = expf(sc - mn);
            l = l * f + pe; m = mn;
#pragma unroll
            for (int d = 0; d < SWA_HD; ++d) o[d] = o[d] * f + pe * vp[d];
        }
        const float il = 1.0f / l;
#pragma unroll
        for (int d = 0; d < SWA_HD; ++d) MIX[(size_t)r * DM + LRU_W + h * SWA_HD + d] = o[d] * il;
    }
}
DEV void ph_ctxattn(const Params& p, long gtid, long gsize) {
    const float* P = p.R2; float* MIX = p.R1;
    const float scale = 1.0f / sqrtf((float)SWA_HD);
    for (long i = gtid; i < (long)TC * SWA_H; i += gsize) {
        const int rc = (int)(i % TC), h = (int)(i / TC), kv = h / (SWA_H / SWA_KV), b = rc / CTX, r = TL + rc;
        float q[SWA_HD], o[SWA_HD];
#pragma unroll
        for (int d = 0; d < SWA_HD; ++d) { q[d] = P[(size_t)r * PLD + 2 * LRU_W + h * SWA_HD + d] * scale; o[d] = 0.f; }
        float m = p.e_sink[h], l = 1.0f;
        for (int kk = 0; kk < CTX; ++kk) {
            const int kr = TL + b * CTX + kk;
            const float* kp = P + (size_t)kr * PLD + 2 * LRU_W + SWA_Q + kv * SWA_HD; const float* vp = kp + SWA_KVW;
            float sc = 0.f;
#pragma unroll
            for (int d = 0; d < SWA_HD; ++d) sc += q[d] * kp[d];
            const float mn = fmaxf(m, sc), f = expf(m - mn), pe = expf(sc - mn);
            l = l * f + pe; m = mn;
#pragma unroll
            for (int d = 0; d < SWA_HD; ++d) o[d] = o[d] * f + pe * vp[d];
        }
        const float il = 1.0f / l;
#pragma unroll
        for (int d = 0; d < SWA_HD; ++d) MIX[(size_t)r * DM + LRU_W + h * SWA_HD + d] = o[d] * il;
    }
}
DEV void ph_mixfin(const Params& p, long gtid, long gsize) {
    const float* P = p.R2; float* MIX = p.R1;
    for (long i = gtid; i < (long)TT * LRU_W; i += gsize) { const int r = (int)(i / LRU_W), c = (int)(i % LRU_W); MIX[(size_t)r * DM + c] *= geluf_(P[(size_t)r * PLD + c]); }
}
DEV void ph_ln1(const Params& p, int l, long gtid, long gsize) {
    const float* Y = p.R2; float* F = p.R1; float* FFN = p.R3;
    const int nrows = l == 0 ? TT : TL;
    for (long r = gtid; r < nrows; r += gsize) {
        const float* xin = l == 0 ? (r < TL ? p.x + (size_t)r * DM : p.ctx + (size_t)(r - TL) * DM) : p.out + (size_t)r * DM;
        float* xo = r < TL ? p.out + (size_t)r * DM : p.XC + (size_t)(r - TL) * DM;
        const float* m = p.MOD + ((size_t)l * (NB + 1) + cond_of_row((int)r)) * 6 * DM;
        const float* g = p.ln_g + (size_t)(l * 2 + 0) * DM; const float* bb = p.ln_b + (size_t)(l * 2 + 0) * DM;
        const float* y = Y + (size_t)r * PLD;
        float s = 0.f;
        for (int d = 0; d < DM; ++d) s += DN_ALPHA * xin[d] + m[2 * DM + d] * y[d];
        const float mu = s / DM; float q = 0.f;
        for (int d = 0; d < DM; ++d) { const float v = DN_ALPHA * xin[d] + m[2 * DM + d] * y[d] - mu; q += v * v; }
        const float rstd = 1.0f / sqrtf(q / DM + LN_EPS);
        float lg[N_GROUPS], le[N_EXP];
#pragma unroll
        for (int j = 0; j < N_GROUPS; ++j) lg[j] = p.moe_bg[l * N_GROUPS + j];
#pragma unroll
        for (int j = 0; j < N_EXP; ++j) le[j] = p.moe_br[l * N_EXP + j];
        const float* wg = p.moe_wg + (size_t)l * DM * N_GROUPS; const float* wr = p.moe_wr + (size_t)l * DM * N_EXP;
        for (int d = 0; d < DM; ++d) {
            const float v = (DN_ALPHA * xin[d] + m[2 * DM + d] * y[d] - mu) * rstd * g[d] + bb[d];
            const float f = v * (1.0f + m[4 * DM + d]) + m[3 * DM + d];
            xo[d] = v; F[(size_t)r * DM + d] = f; FFN[(size_t)r * DM + d] = 0.f;
#pragma unroll
            for (int j = 0; j < N_GROUPS; ++j) lg[j] += f * wg[d * N_GROUPS + j];
#pragma unroll
            for (int j = 0; j < N_EXP; ++j) le[j] += f * wr[d * N_EXP + j];
        }
        int gi = 0; float gm = lg[0];
#pragma unroll
        for (int j = 1; j < N_GROUPS; ++j) if (lg[j] > gm) { gm = lg[j]; gi = j; }
        float gs = 0.f;
#pragma unroll
        for (int j = 0; j < N_GROUPS; ++j) gs += expf(lg[j] - gm);
        const float gprob = 1.0f / gs;
        float ev[EPG];
#pragma unroll
        for (int j = 0; j < EPG; ++j) { float v = 0.f;
#pragma unroll
            for (int g2 = 0; g2 < N_GROUPS; ++g2) if (g2 == gi) v = le[g2 * EPG + j];
            ev[j] = v; }
        int i0 = 0; float m0 = ev[0];
#pragma unroll
        for (int j = 1; j < EPG; ++j) if (ev[j] > m0) { m0 = ev[j]; i0 = j; }
        int i1 = -1; float m1 = -3.0e38f;
#pragma unroll
        for (int j = 0; j < EPG; ++j) if (j != i0 && ev[j] > m1) { m1 = ev[j]; i1 = j; }
        const float e1 = expf(m1 - m0), g0 = gprob / (1.0f + e1), g1 = gprob * e1 / (1.0f + e1);
        const int ex0 = gi * EPG + i0, ex1 = gi * EPG + i1;
        const int p0 = atomicAdd(&p.cnt[l * N_EXP + ex0], 1); p.slot_tok[(size_t)ex0 * TT + p0] = (int)r; p.slot_gate[(size_t)ex0 * TT + p0] = g0;
        const int p1 = atomicAdd(&p.cnt[l * N_EXP + ex1], 1); p.slot_tok[(size_t)ex1 * TT + p1] = (int)r; p.slot_gate[(size_t)ex1 * TT + p1] = g1;
    }
}
DEV void moe_find(const int* cnt, int cr, int& e, int& pos) { int s = 0; e = 0; for (int j = 0; j < N_EXP; ++j) { const int c = cnt[j]; if (cr >= s && cr < s + c) { e = j; pos = cr - s; } s += c; } }
DEV void ph_moe1(const Params& p, int l, long gtid, long gsize) {
    const float* F = p.R1; float* H1 = p.R2; const int* cnt = p.cnt + l * N_EXP;
    const int ntok = l == 0 ? TT : TL; constexpr int n4 = D_EXP / 4;
    for (long i = gtid; i < (long)2 * ntok * n4; i += gsize) {
        const int nn = (int)(i % n4) * 4, cr = (int)(i / n4); int e, pos; moe_find(cnt, cr, e, pos);
        const int tok = p.slot_tok[(size_t)e * TT + pos];
        const float* w1 = p.moe_w1 + ((size_t)(l * N_EXP + e) * DM) * D_EXP + nn; const float* w3 = p.moe_w3 + ((size_t)(l * N_EXP + e) * DM) * D_EXP + nn;
        const float* a = F + (size_t)tok * DM;
        float a1[4] = {0, 0, 0, 0}, a3[4] = {0, 0, 0, 0};
        for (int k = 0; k < DM; ++k) { const float av = a[k];
#pragma unroll
            for (int j = 0; j < 4; ++j) { a1[j] += av * w1[(size_t)k * D_EXP + j]; a3[j] += av * w3[(size_t)k * D_EXP + j]; } }
#pragma unroll
        for (int j = 0; j < 4; ++j) H1[(size_t)cr * D_EXP + nn + j] = siluf_(a1[j]) * a3[j];
    }
}
DEV void ph_moe2(const Params& p, int l, long gtid, long gsize) {
    const float* H1 = p.R2; float* FFN = p.R3; const int* cnt = p.cnt + l * N_EXP;
    const int ntok = l == 0 ? TT : TL; constexpr int n4 = DM / 4;
    for (long i = gtid; i < (long)2 * ntok * n4; i += gsize) {
        const int nn = (int)(i % n4) * 4, cr = (int)(i / n4); int e, pos; moe_find(cnt, cr, e, pos);
        const int tok = p.slot_tok[(size_t)e * TT + pos]; const float gate = p.slot_gate[(size_t)e * TT + pos];
        const float* w2 = p.moe_w2 + ((size_t)(l * N_EXP + e) * D_EXP) * DM + nn; const float* a = H1 + (size_t)cr * D_EXP;
        float acc[4] = {0, 0, 0, 0};
        for (int k = 0; k < D_EXP; ++k) { const float av = a[k];
#pragma unroll
            for (int j = 0; j < 4; ++j) acc[j] += av * w2[(size_t)k * DM + j]; }
#pragma unroll
        for (int j = 0; j < 4; ++j) atomicAdd(&FFN[(size_t)tok * DM + nn + j], gate * acc[j]);
    }
}
DEV void ph_ln2(const Params& p, int l, long gtid, long gsize) {
    const float* FFN = p.R3; const int nrows = l == 0 ? TT : TL;
    for (long r = gtid; r < nrows; r += gsize) {
        float* xo = r < TL ? p.out + (size_t)r * DM : p.XC + (size_t)(r - TL) * DM;
        const float* m = p.MOD + ((size_t)l * (NB + 1) + cond_of_row((int)r)) * 6 * DM;
        const float* g = p.ln_g + (size_t)(l * 2 + 1) * DM; const float* bb = p.ln_b + (size_t)(l * 2 + 1) * DM;
        const float* f = FFN + (size_t)r * DM;
        float s = 0.f;
        for (int d = 0; d < DM; ++d) s += DN_ALPHA * xo[d] + m[5 * DM + d] * f[d];
        const float mu = s / DM; float q = 0.f;
        for (int d = 0; d < DM; ++d) { const float v = DN_ALPHA * xo[d] + m[5 * DM + d] * f[d] - mu; q += v * v; }
        const float rstd = 1.0f / sqrtf(q / DM + LN_EPS);
        for (int d = 0; d < DM; ++d) xo[d] = (DN_ALPHA * xo[d] + m[5 * DM + d] * f[d] - mu) * rstd * g[d] + bb[d];
    }
}
constexpr int OC_CKV = MLA_QR, OC_KPE = MLA_QR + MLA_KVR, OC_A = OC_KPE + MLA_ROPE, OC_G = OC_A + CONF_CH;
DEV void ph_mla_norm(const Params& p, long gtid, long gsize) {
    float* P = p.R2;
    for (long r = gtid; r < TT; r += gsize) {
        float* row = P + (size_t)r * PLD;
        if (r < TL) { float s = 0.f; for (int d = 0; d < MLA_QR; ++d) s += row[d] * row[d]; const float rs = 1.0f / sqrtf(s / MLA_QR + LN_EPS); for (int d = 0; d < MLA_QR; ++d) row[d] = row[d] * rs * p.o_q_norm[d]; }
        float s = 0.f; for (int d = 0; d < MLA_KVR; ++d) s += row[OC_CKV + d] * row[OC_CKV + d]; const float rs = 1.0f / sqrtf(s / MLA_KVR + LN_EPS);
        for (int d = 0; d < MLA_KVR; ++d) row[OC_CKV + d] = row[OC_CKV + d] * rs * p.o_kv_norm[d];
    }
}
DEV bf16_t* mla_Q(const Params& p) { return (bf16_t*)p.R3; }
DEV bf16_t* mla_KN(const Params& p) { return mla_Q(p) + (size_t)TL * MLA_H * MLA_QD; }
DEV bf16_t* mla_V(const Params& p) { return mla_KN(p) + (size_t)TT * MLA_H * MLA_NOPE; }
DEV bf16_t* mla_KPE(const Params& p) { return mla_V(p) + (size_t)TT * MLA_H * MLA_V; }
DEV void ph_mla_rope(const Params& p, long gtid, long gsize) {
    constexpr int half = MLA_ROPE / 4; bf16_t* Q = mla_Q(p); bf16_t* KPE = mla_KPE(p); const float* P = p.R2;
    const long nq = (long)TL * MLA_H * 2 * half;
    for (long i = gtid; i < nq; i += gsize) {
        const int pi = (int)(i % half), part = (int)((i / half) % 2), h = (int)((i / (2 * half)) % MLA_H), r = (int)(i / ((long)2 * half * MLA_H));
        bf16_t* v = Q + (size_t)r * MLA_H * MLA_QD + h * MLA_QD + MLA_NOPE + part * (MLA_ROPE / 2);
        float cs, sn; rope_cs(r % SEQ, part, pi, half, cs, sn);
        const float x1 = bf2f(v[pi]), x2 = bf2f(v[half + pi]);
        v[pi] = f2bf(x1 * cs - x2 * sn); v[half + pi] = f2bf(x1 * sn + x2 * cs);
    }
    const long nk = (long)TT * 2 * half;
    for (long i = gtid; i < nk; i += gsize) {
        const int pi = (int)(i % half), part = (int)((i / half) % 2), r = (int)(i / (2 * half));
        const float* v = P + (size_t)r * PLD + OC_KPE + part * (MLA_ROPE / 2); bf16_t* o = KPE + (size_t)r * MLA_ROPE + part * (MLA_ROPE / 2);
        float cs = 1.f, sn = 0.f; if (r < TL) rope_cs(r % SEQ, part, pi, half, cs, sn);
        const float x1 = v[pi], x2 = v[half + pi];
        o[pi] = f2bf(x1 * cs - x2 * sn); o[half + pi] = f2bf(x1 * sn + x2 * cs);
    }
}
DEV void ph_conf_conv(const Params& p, long gtid, long gsize) {
    const float* P = p.R2; float* MIX = p.R1;
    for (long i = gtid; i < (long)TL * CONF_CH; i += gsize) {
        const int r = (int)(i / CONF_CH), c = (int)(i % CONF_CH); const int lo = (r / SEQ) * SEQ, hi = lo + SEQ;
        float acc = p.o_dw_b[c];
        for (int j = 0; j < CONF_K; ++j) { const int rr = r + j - (CONF_K - 1) / 2; if (rr >= lo && rr < hi) { const float* row = P + (size_t)rr * PLD; acc += p.o_dw_w[j * CONF_CH + c] * row[OC_A + c] * sigmoidf_(row[OC_G + c]); } }
        MIX[(size_t)r * DM + MLA_H * MLA_V + c] = acc;
    }
}
DEV void ph_conf_ln(const Params& p, long gtid, long gsize) {
    float* MIX = p.R1;
    for (long r = gtid; r < TL; r += gsize) {
        float* v = MIX + (size_t)r * DM + MLA_H * MLA_V; float s = 0.f;
        for (int d = 0; d < CONF_CH; ++d) s += v[d];
        const float mu = s / CONF_CH; float q = 0.f;
        for (int d = 0; d < CONF_CH; ++d) q += (v[d] - mu) * (v[d] - mu);
        const float rstd = 1.0f / sqrtf(q / CONF_CH + LN_EPS);
        for (int d = 0; d < CONF_CH; ++d) v[d] = siluf_((v[d] - mu) * rstd * p.o_cln_g[d] + p.o_cln_b[d]);
    }
}
DEV void ph_mla_attn(const Params& p, long gtid, long gsize) {
    const bf16_t* Q = mla_Q(p); const bf16_t* KN = mla_KN(p); const bf16_t* V = mla_V(p); const bf16_t* KPE = mla_KPE(p); float* MIX = p.R1;
    const float scale = 1.0f / sqrtf((float)MLA_QD);
    for (long i = gtid; i < (long)TL * MLA_H; i += gsize) {
        const int r = (int)(i % TL), h = (int)(i / TL), b = r / SEQ;
        float q[MLA_QD], o[MLA_V];
#pragma unroll
        for (int d = 0; d < MLA_QD; ++d) q[d] = bf2f(Q[(size_t)r * MLA_H * MLA_QD + h * MLA_QD + d]) * scale;
#pragma unroll
        for (int d = 0; d < MLA_V; ++d) o[d] = 0.f;
        float m = -3.0e38f, l = 0.f;
        for (int kk = 0; kk < CTX + SEQ; ++kk) {
            const int kr = kk < CTX ? TL + b * CTX + kk : b * SEQ + (kk - CTX);
            const bf16_t* kn = KN + (size_t)kr * MLA_H * MLA_NOPE + h * MLA_NOPE; const bf16_t* kp = KPE + (size_t)kr * MLA_ROPE; const bf16_t* vp = V + (size_t)kr * MLA_H * MLA_V + h * MLA_V;
            float sc = 0.f;
#pragma unroll
            for (int d = 0; d < MLA_NOPE; ++d) sc += q[d] * bf2f(kn[d]);
#pragma unroll
            for (int d = 0; d < MLA_ROPE; ++d) sc += q[MLA_NOPE + d] * bf2f(kp[d]);
            const float mn = fmaxf(m, sc), f = expf(m - mn), pe = expf(sc - mn);
            l = l * f + pe; m = mn;
#pragma unroll
            for (int d = 0; d < MLA_V; ++d) o[d] = o[d] * f + pe * bf2f(vp[d]);
        }
        const float il = 1.0f / l;
#pragma unroll
        for (int d = 0; d < MLA_V; ++d) MIX[(size_t)r * DM + h * MLA_V + d] = o[d] * il;
    }
}

constexpr int N_PHASES = 27;
DEV void run_phase(const Params& p, int ph, long gtid, long gsize) {
    switch (ph) {
    case 0: ph_mod(p, gtid, gsize); break;
    case 1: ph_modulate(p, 0, gtid, gsize); break;
    case 2: ph_gemm<false>(p.R1, DM, p.e_w_in, EVEN_IN, p.e_b_in, p.R2, PLD, TT, EVEN_IN, DM, gtid, gsize); break;
    case 3: ph_conv4(p, gtid, gsize); ph_rope_swa(p, gtid, gsize); break;
    case 4: ph_scan(p, gtid, gsize); ph_swa(p, gtid, gsize); ph_ctxattn(p, gtid, gsize); break;
    case 5: ph_mixfin(p, gtid, gsize); break;
    case 6: ph_gemm<false>(p.R1, DM, p.e_w_out, DM, p.e_b_out, p.R2, PLD, TT, DM, DM, gtid, gsize); break;
    case 7: ph_ln1(p, 0, gtid, gsize); break;
    case 8: ph_moe1(p, 0, gtid, gsize); break;
    case 9: ph_moe2(p, 0, gtid, gsize); break;
    case 10: ph_ln2(p, 0, gtid, gsize); break;
    case 11: ph_modulate(p, 1, gtid, gsize); break;
    case 12: ph_gemm<false>(p.R1, DM, p.o_w_in, ODD_IN, p.o_b_in, p.R2, PLD, TT, ODD_IN, DM, gtid, gsize); break;
    case 13: ph_mla_norm(p, gtid, gsize); break;
    case 14: ph_gemm<true>(p.R2, PLD, p.o_w_uq, MLA_H * MLA_QD, nullptr, mla_Q(p), MLA_H * MLA_QD, TL, MLA_H * MLA_QD, MLA_QR, gtid, gsize);
             ph_gemm<true>(p.R2 + OC_CKV, PLD, p.o_w_uk, MLA_H * MLA_NOPE, nullptr, mla_KN(p), MLA_H * MLA_NOPE, TT, MLA_H * MLA_NOPE, MLA_KVR, gtid, gsize);
             ph_gemm<true>(p.R2 + OC_CKV, PLD, p.o_w_uv, MLA_H * MLA_V, nullptr, mla_V(p), MLA_H * MLA_V, TT, MLA_H * MLA_V, MLA_KVR, gtid, gsize);
             ph_conf_conv(p, gtid, gsize); break;
    case 15: ph_mla_rope(p, gtid, gsize); ph_conf_ln(p, gtid, gsize); break;
    case 16: ph_mla_attn(p, gtid, gsize); break;
    case 17: ph_gemm<false>(p.R1, DM, p.o_w_out, DM, p.o_b_out, p.R2, PLD, TL, DM, DM, gtid, gsize); break;
    case 18: ph_ln1(p, 1, gtid, gsize); break;
    case 19: ph_moe1(p, 1, gtid, gsize); break;
    case 20: ph_moe2(p, 1, gtid, gsize); break;
    case 21: ph_ln2(p, 1, gtid, gsize); break;
    default: break;
    }
}
constexpr int LAST_PHASE = 21;

static size_t fill_params(Params& p, void* const* d_in, void* d_out, void* d_ws) {
    const float* const* in = (const float* const*)d_in;
    int k = 0;
    p.x = in[k++]; p.c = in[k++]; p.ctx = in[k++]; p.c_ctx = in[k++]; p.w_mod = in[k++]; p.b_mod = in[k++]; p.ln_g = in[k++]; p.ln_b = in[k++];
    p.e_w_in = in[k++]; p.e_b_in = in[k++]; p.e_conv_w = in[k++]; p.e_conv_b = in[k++]; p.e_wa = in[k++]; p.e_ba = in[k++]; p.e_wx = in[k++]; p.e_bx = in[k++];
    p.e_lam = in[k++]; p.e_sink = in[k++]; p.e_w_out = in[k++]; p.e_b_out = in[k++];
    p.o_w_in = in[k++]; p.o_b_in = in[k++]; p.o_q_norm = in[k++]; p.o_kv_norm = in[k++]; p.o_w_uq = in[k++]; p.o_w_uk = in[k++]; p.o_w_uv = in[k++];
    p.o_dw_w = in[k++]; p.o_dw_b = in[k++]; p.o_cln_g = in[k++]; p.o_cln_b = in[k++]; p.o_w_out = in[k++]; p.o_b_out = in[k++];
    p.moe_wg = in[k++]; p.moe_bg = in[k++]; p.moe_wr = in[k++]; p.moe_br = in[k++]; p.moe_w1 = in[k++]; p.moe_w3 = in[k++]; p.moe_w2 = in[k++];
    p.out = (float*)d_out;
    char* w = (char*)d_ws; size_t off = 0;
    auto take = [&](size_t bytes) { char* r = w + off; off += (bytes + 255) & ~(size_t)255; return r; };
    p.MOD = (float*)take((size_t)2 * (NB + 1) * 6 * DM * 4);
    p.XC = (float*)take((size_t)TC * DM * 4);
    p.cnt = (int*)take(2 * N_EXP * 4);
    p.slot_tok = (int*)take((size_t)N_EXP * TT * 4);
    p.slot_gate = (float*)take((size_t)N_EXP * TT * 4);
    p.R1 = (float*)take((size_t)TT * DM * 4);
    p.R2 = (float*)take((size_t)TT * PLD * 4);
    p.R3 = (float*)take(R3_FLOATS * 4);
    return off;
}

#ifndef CPU_SIM
__global__ void __launch_bounds__(256) mega(Params p) {
    cg::grid_group grid = cg::this_grid();
    const long gtid = (long)blockIdx.x * blockDim.x + threadIdx.x, gsize = (long)gridDim.x * blockDim.x;
    for (int ph = p.ph_lo; ph <= p.ph_hi; ++ph) {
        run_phase(p, ph, gtid, gsize);
        if (ph < p.ph_hi) grid.sync();
    }
}

extern "C" void kernel_launch(void* const* d_in, const int* in_sizes, int n_in, void* d_out, int out_size, void* d_ws, size_t ws_size, hipStream_t stream) {
    static int grid_blocks = 0;
    if (!grid_blocks) {
        int dev = 0, cus = 0, per_cu = 0;
        hipGetDevice(&dev);
        hipDeviceGetAttribute(&cus, hipDeviceAttributeMultiprocessorCount, dev);
        hipOccupancyMaxActiveBlocksPerMultiprocessor(&per_cu, mega, 256, 0);
        if (per_cu > 4) per_cu = 4;
        if (per_cu < 1) per_cu = 1;
        grid_blocks = cus * per_cu;
    }
    Params p{};
    const size_t need = fill_params(p, d_in, d_out, d_ws);
    if (need > ws_size) { fprintf(stderr, "workspace too small: need %zu have %zu\n", need, ws_size); return; }
    p.ph_lo = 0; p.ph_hi = LAST_PHASE;
    void* args[] = {&p};
    hipError_t e = hipLaunchCooperativeKernel((void*)mega, dim3(grid_blocks), dim3(256), args, 0, stream);
    if (e != hipSuccess) fprintf(stderr, "cooperative launch failed: %s (grid %d)\n", hipGetErrorString(e), grid_blocks);
}
#endif
```

```cpp
#ifndef CPU_SIM
#include <hip/hip_runtime.h>
#include <hip/hip_cooperative_groups.h>
#include <cstdio>
namespace cg = cooperative_groups;
#define DEV __device__ __forceinline__
#else
#define DEV inline
#endif
#include <cstdint>
#include <cmath>

#ifdef SIM_SMALL
constexpr int DM = 192, NB = 2, SEQ = 512, CTX = 64, GRID_W = 64;
constexpr int LRU_W = 64, LRU_NBLK = 8, SWA_H = 8, SWA_KV = 2, SWA_HD = 16, WINDOW = 128;
constexpr int MLA_H = 8, MLA_QR = 32, MLA_KVR = 16, MLA_NOPE = 16, MLA_ROPE = 8, MLA_V = 16;
constexpr int CONF_CH = 64, CONF_K = 31, N_GROUPS = 4, EPG = 8, D_EXP = 32;
constexpr int MOE_PAD = 4;
constexpr int OPLD = 224;
#else
constexpr int DM = 1024, NB = 4, SEQ = 8192, CTX = 256, GRID_W = 64;
constexpr int LRU_W = 512, LRU_NBLK = 8, SWA_H = 8, SWA_KV = 2, SWA_HD = 64, WINDOW = 128;
constexpr int MLA_H = 8, MLA_QR = 256, MLA_KVR = 128, MLA_NOPE = 64, MLA_ROPE = 32, MLA_V = 64;
constexpr int CONF_CH = 512, CONF_K = 31, N_GROUPS = 4, EPG = 8, D_EXP = 512;
constexpr int MOE_PAD = 256;
constexpr int OPLD = 1536;
#endif
constexpr int LRU_BD = LRU_W / LRU_NBLK;
constexpr int SWA_Q = SWA_H * SWA_HD, SWA_KVW = SWA_KV * SWA_HD;
constexpr int EVEN_IN = 2 * LRU_W + SWA_Q + 2 * SWA_KVW, EVEN_MIX = LRU_W + SWA_Q;
constexpr int MLA_QD = MLA_NOPE + MLA_ROPE;
constexpr int ODD_IN = MLA_QR + MLA_KVR + MLA_ROPE + 2 * CONF_CH, ODD_MIX = MLA_H * MLA_V + CONF_CH;
constexpr int N_EXP = N_GROUPS * EPG;
constexpr int TL = NB * SEQ, TC = NB * CTX, TT = TL + TC;
constexpr int EPLD = EVEN_IN;
constexpr int CR_MAX = ((2 * TT + N_EXP * (MOE_PAD - 1)) / MOE_PAD + 1) * MOE_PAD;
constexpr int CS = 32;
constexpr float LN_EPS = 1e-6f, LRU_C = 8.0f;
constexpr float DN_ALPHA = 1.41421356237309515f;
constexpr float LOG2E = 1.4426950408889634f;
static_assert(EVEN_MIX == DM && ODD_MIX == DM && OPLD >= ODD_IN, "mixer widths");
constexpr int EC_G = 0, EC_U = LRU_W, EC_Q = 2 * LRU_W, EC_K = EC_Q + SWA_Q, EC_V = EC_K + SWA_KVW;
constexpr int OC_CKV = MLA_QR, OC_KPE = MLA_QR + MLA_KVR, OC_A = OC_KPE + MLA_ROPE, OC_G = OC_A + CONF_CH;

typedef unsigned short bf16_t;
DEV bf16_t f2bf(float f) { unsigned u; __builtin_memcpy(&u, &f, 4); u = (u + 0x7fffu + ((u >> 16) & 1u)) >> 16; return (bf16_t)u; }
DEV float bf2f(bf16_t h) { unsigned u = ((unsigned)h) << 16; float f; __builtin_memcpy(&f, &u, 4); return f; }
struct alignas(16) U128 { unsigned a, b, c, d; };

struct Params {
    const float *x, *c, *ctx, *c_ctx, *w_mod, *b_mod, *ln_g, *ln_b;
    const float *e_w_in, *e_b_in, *e_conv_w, *e_conv_b, *e_wa, *e_ba, *e_wx, *e_bx, *e_lam, *e_sink, *e_w_out, *e_b_out;
    const float *o_w_in, *o_b_in, *o_q_norm, *o_kv_norm, *o_w_uq, *o_w_uk, *o_w_uv, *o_dw_w, *o_dw_b, *o_cln_g, *o_cln_b, *o_w_out, *o_b_out;
    const float *moe_wg, *moe_bg, *moe_wr, *moe_br, *moe_w1, *moe_w3, *moe_w2;
    float* out;
    float* MOD;
    float* XC;
    float* ROPE_SWA;
    float* ROPE_MLA;
    float* SSQ;
    bf16_t* ACT;
    unsigned char* M;
    bf16_t *W_ein, *W_eout, *W_oin, *W_oout, *W_uq, *W_ukv, *W_up, *W_dn;
    int* cnt;
    int* tok_e;
    int* tok_pos;
    float* tok_gate;
    int* tok_row;
    int* slot_tok;
    unsigned* bar;
    bf16_t* LRUW;
    float* LRUC;
    float* WTR;
    bf16_t* WRH;
    bf16_t* WRL;
    int ph_lo, ph_hi;
};
constexpr size_t M_P = 0;
constexpr size_t M_P_END = (size_t)TT * EPLD * 2;
constexpr size_t M_UC = M_P_END;
constexpr size_t M_REC = M_UC + (size_t)TT * LRU_W * 4;
constexpr int LRU_CH = 32, LRU_NV = (SEQ + CTX) / LRU_CH;
constexpr size_t M_GW = M_UC;
constexpr size_t M_SUM = M_REC + (size_t)TT * LRU_W * 4;
constexpr size_t M_HIN = M_SUM + (size_t)NB * 2 * LRU_NV * LRU_W * 8;
constexpr size_t M_L0_END = M_HIN + (size_t)NB * 2 * LRU_NV * LRU_W * 4;
constexpr size_t M_Q = M_P_END;
constexpr size_t M_K = M_Q + (size_t)TL * MLA_H * MLA_QD * 2;
constexpr size_t M_V = M_K + (size_t)TT * MLA_H * MLA_QD * 2;
constexpr size_t M_CV = M_V + (size_t)TT * MLA_H * MLA_V * 2;
constexpr size_t M_L1_END = M_CV + (size_t)TL * CONF_CH * 2;
constexpr float FP8_SF = 4.0f, FP8_SW1 = 128.0f, FP8_SH = 4.0f, FP8_SW2 = 64.0f;
constexpr size_t M_XS = 0;
constexpr size_t M_H1 = (size_t)CR_MAX * DM * 2;
constexpr size_t M_MOE_END = M_H1 + (size_t)CR_MAX * D_EXP * 2;
constexpr size_t cmax3(size_t a, size_t b, size_t c) { return a > b ? (a > c ? a : c) : (b > c ? b : c); }
constexpr size_t M_BYTES = cmax3(M_L0_END, M_L1_END, M_MOE_END);

DEV float sigmoidf_(float v) { return 1.0f / (1.0f + expf(-v)); }
DEV float siluf_(float v) { return v * sigmoidf_(v); }
DEV float geluf_(float v) { return 0.5f * v * (1.0f + tanhf(0.7978845608028654f * (v + 0.044715f * v * v * v))); }
DEV float softplusf_(float v) { return v > 20.f ? v : log1pf(expf(v)); }
DEV int cond_of_row(int r) { return r < TL ? r / SEQ : NB; }
DEV bf16_t* P_of(const Params& p) { return (bf16_t*)(p.M + M_P); }

DEV void ph_misc_body(const Params& p, long gtid, long gsize);
DEV void ph_misc(const Params& p, long gtid, long gsize) { ph_misc_body(p, gtid, gsize); }
DEV void ph_mod(const Params& p, long gtid, long gsize) {
    const long total = 2L * (NB + 1) * 6 * DM;
    for (long i = gtid; i < total; i += gsize) {
        const int j = (int)(i % (6 * DM)); const int cn = (int)((i / (6 * DM)) % (NB + 1)); const int l = (int)(i / ((long)6 * DM * (NB + 1)));
        const float* cond = cn < NB ? p.c + (size_t)cn * DM : p.c_ctx;
        const float* w = p.w_mod + (size_t)l * DM * 6 * DM;
        float acc = p.b_mod[(size_t)l * 6 * DM + j];
        for (int k = 0; k < DM; ++k) acc += siluf_(cond[k]) * w[(size_t)k * 6 * DM + j];
        p.MOD[i] = acc;
    }
    ph_misc(p, gtid, gsize);
}
DEV void ph_misc_body(const Params& p, long gtid, long gsize) {
    for (long i = gtid; i < 2L * 64 * DM; i += gsize) { const int d = (int)(i % DM), j = (int)((i / DM) % 64), l = (int)(i / ((long)DM * 64)); float w = 0.f;
        if (j < N_GROUPS) w = p.moe_wg[((size_t)l * DM + d) * N_GROUPS + j]; else if (j < N_GROUPS + N_EXP) w = p.moe_wr[((size_t)l * DM + d) * N_EXP + (j - N_GROUPS)];
        const bf16_t h = f2bf(w); p.WRH[i] = h; p.WRL[i] = f2bf(w - bf2f(h)); }
    for (long i = gtid; i < 2L * (N_GROUPS + N_EXP) * DM; i += gsize) { const int d = (int)(i % DM), j = (int)((i / DM) % (N_GROUPS + N_EXP)), l = (int)(i / ((long)DM * (N_GROUPS + N_EXP)));
        p.WTR[i] = j < N_GROUPS ? p.moe_wg[((size_t)l * DM + d) * N_GROUPS + j] : p.moe_wr[((size_t)l * DM + d) * N_EXP + (j - N_GROUPS)]; }
    for (long i = gtid; i < (long)2 * LRU_NBLK * 2 * LRU_BD * LRU_BD; i += gsize) {
        const int k = (int)(i % LRU_BD), n = (int)((i / LRU_BD) % LRU_BD), m = (int)((i / (LRU_BD * LRU_BD)) % 2), db = (int)(i / (2 * LRU_BD * LRU_BD));
        p.LRUW[i] = f2bf((m ? p.e_wx : p.e_wa)[((size_t)db * LRU_BD + k) * LRU_BD + n]); }
    for (long i = gtid; i < 2L * LRU_W; i += gsize) { p.LRUC[3 * i] = p.e_ba[i]; p.LRUC[3 * i + 1] = p.e_bx[i]; p.LRUC[3 * i + 2] = softplusf_(-p.e_lam[i]); }
    for (long i = gtid; i < 2 * N_EXP * CS; i += gsize) p.cnt[i] = 0;
    for (long i = gtid; i < 128L * (SWA_HD / 4); i += gsize) { const int pos = (int)(i / (SWA_HD / 4)), k = (int)(i % (SWA_HD / 4)); const float ang = (float)pos * powf(10000.0f, -(float)k / (float)(SWA_HD / 4)); p.ROPE_SWA[2 * i] = cosf(ang); p.ROPE_SWA[2 * i + 1] = sinf(ang); }
    for (long i = gtid; i < 128L * (MLA_ROPE / 4); i += gsize) { const int pos = (int)(i / (MLA_ROPE / 4)), k = (int)(i % (MLA_ROPE / 4)); const float ang = (float)pos * powf(10000.0f, -(float)k / (float)(MLA_ROPE / 4)); p.ROPE_MLA[2 * i] = cosf(ang); p.ROPE_MLA[2 * i + 1] = sinf(ang); }
}
DEV void cvt_T(const float* src, int K, int Nsrc, int N, const float* scale, bf16_t* dst, long gtid, long gsize) {
    for (long i = gtid; i < (long)N * K; i += gsize) { const int k = (int)(i % K), n = (int)(i / K); dst[i] = n < Nsrc ? f2bf(src[(size_t)k * Nsrc + n] * (scale ? scale[k] : 1.0f)) : (bf16_t)0; }
}
constexpr int UPG = D_EXP < 128 ? D_EXP : 128;
DEV void cvt_up(const float* w1, const float* w3, bf16_t* dst, long gtid, long gsize) {
    for (long i = gtid; i < (long)N_EXP * 2 * D_EXP * DM; i += gsize) {
        const int k = (int)(i % DM); const int vr = (int)((i / DM) % (2 * D_EXP)); const int e = (int)(i / ((long)DM * 2 * D_EXP));
        const int grp = vr / (2 * UPG), w = (vr / UPG) & 1, j = grp * UPG + vr % UPG;
        const float* src = w ? w3 : w1; dst[i] = f2bf(src[((size_t)e * DM + k) * D_EXP + j]);
    }
}
DEV void ph_weights_small_naive(const Params& p, long gtid, long gsize) {
    cvt_T(p.e_w_in, DM, EVEN_IN, EVEN_IN, nullptr, p.W_ein, gtid, gsize);
    cvt_T(p.e_w_out, DM, DM, DM, nullptr, p.W_eout, gtid, gsize);
    cvt_T(p.o_w_in, DM, ODD_IN, OPLD, nullptr, p.W_oin, gtid, gsize);
    cvt_T(p.o_w_out, DM, DM, DM, nullptr, p.W_oout, gtid, gsize);
    cvt_T(p.o_w_uq, MLA_QR, MLA_H * MLA_QD, MLA_H * MLA_QD, p.o_q_norm, p.W_uq, gtid, gsize);
    cvt_T(p.o_w_uk, MLA_KVR, MLA_H * MLA_NOPE, MLA_H * MLA_NOPE, p.o_kv_norm, p.W_ukv, gtid, gsize);
    cvt_T(p.o_w_uv, MLA_KVR, MLA_H * MLA_V, MLA_H * MLA_V, p.o_kv_norm, p.W_ukv + (size_t)MLA_H * MLA_NOPE * MLA_KVR, gtid, gsize);
}
DEV void ph_weights_naive(const Params& p, long gtid, long gsize) {
    cvt_T(p.e_w_in, DM, EVEN_IN, EVEN_IN, nullptr, p.W_ein, gtid, gsize);
    cvt_T(p.e_w_out, DM, DM, DM, nullptr, p.W_eout, gtid, gsize);
    cvt_T(p.o_w_in, DM, ODD_IN, OPLD, nullptr, p.W_oin, gtid, gsize);
    cvt_T(p.o_w_out, DM, DM, DM, nullptr, p.W_oout, gtid, gsize);
    cvt_T(p.o_w_uq, MLA_QR, MLA_H * MLA_QD, MLA_H * MLA_QD, p.o_q_norm, p.W_uq, gtid, gsize);
    cvt_T(p.o_w_uk, MLA_KVR, MLA_H * MLA_NOPE, MLA_H * MLA_NOPE, p.o_kv_norm, p.W_ukv, gtid, gsize);
    cvt_T(p.o_w_uv, MLA_KVR, MLA_H * MLA_V, MLA_H * MLA_V, p.o_kv_norm, p.W_ukv + (size_t)MLA_H * MLA_NOPE * MLA_KVR, gtid, gsize);
    for (int l = 0; l < 2; ++l) {
        cvt_up(p.moe_w1 + (size_t)l * N_EXP * DM * D_EXP, p.moe_w3 + (size_t)l * N_EXP * DM * D_EXP, p.W_up + (size_t)l * N_EXP * 2 * D_EXP * DM, gtid, gsize);
        for (int e = 0; e < N_EXP; ++e) cvt_T(p.moe_w2 + ((size_t)l * N_EXP + e) * D_EXP * DM, D_EXP, DM, DM, nullptr, p.W_dn + ((size_t)l * N_EXP + e) * DM * D_EXP, gtid, gsize);
    }
}
DEV void ph_modulate0(const Params& p, long gtid, long gsize) {
    const long total = (long)TT * DM;
    for (long i = gtid; i < total; i += gsize) {
        const int r = (int)(i / DM), d = (int)(i % DM);
        const float* xin = r < TL ? p.x + (size_t)r * DM : p.ctx + (size_t)(r - TL) * DM;
        const float* m = p.MOD + ((size_t)cond_of_row(r)) * 6 * DM;
        p.ACT[i] = f2bf(xin[d] * (1.0f + m[DM + d]) + m[d]);
    }
}
template <class Epi>
DEV void gemm_naive(const bf16_t* A, int lda, const bf16_t* Bt, int K, int M, int N, const Epi& E, long gtid, long gsize) {
    const long total = (long)(M / 4) * N;
    for (long i = gtid; i < total; i += gsize) {
        const int n = (int)(i % N); const int mm = (int)(i / N) * 4;
        float acc[4] = {0.f, 0.f, 0.f, 0.f};
        for (int k = 0; k < K; ++k) { const float b = bf2f(Bt[(size_t)n * K + k]);
#pragma unroll
            for (int a = 0; a < 4; ++a) acc[a] += bf2f(A[(size_t)(mm + a) * lda + k]) * b; }
#pragma unroll
        for (int a = 0; a < 4; ++a) E(mm + a, n, acc[a]);
    }
}
constexpr float SWA_QSCALE = LOG2E / (SWA_HD == 64 ? 8.0f : 4.0f);
struct EpiInE_naive { const Params* p; DEV void operator()(int m, int n, float acc) const { P_of(*p)[(size_t)m * EPLD + n] = f2bf(acc + p->e_b_in[n]); } };
DEV void ph_rope_swa(const Params& p, long gtid, long gsize) {
    bf16_t* P = P_of(p); constexpr int half = SWA_HD / 4, NH = SWA_H + SWA_KV;
    const long total = (long)TT * NH * 2 * half;
    for (long i = gtid; i < total; i += gsize) {
        const int pi = (int)(i % half); const int part = (int)((i / half) % 2); const int hh = (int)((i / (2 * half)) % NH); const int r = (int)(i / ((long)2 * half * NH));
        bf16_t* v = P + (size_t)r * EPLD + EC_Q + hh * SWA_HD + part * (SWA_HD / 2);
        float cs = 1.f, sn = 0.f;
        if (r < TL) { const int s = r % SEQ; const int pos = part == 0 ? s / GRID_W : s % GRID_W; cs = p.ROPE_SWA[2 * (pos * half + pi)]; sn = p.ROPE_SWA[2 * (pos * half + pi) + 1]; }
        const float sc = hh < SWA_H ? SWA_QSCALE : 1.0f;
        const float x1 = bf2f(v[pi]), x2 = bf2f(v[half + pi]);
        v[pi] = f2bf((x1 * cs - x2 * sn) * sc); v[half + pi] = f2bf((x1 * sn + x2 * cs) * sc);
    }
}
DEV void seq_bounds(int r, int& lo, int& hi) { if (r < TL) { lo = (r / SEQ) * SEQ; hi = lo + SEQ; } else { lo = TL + ((r - TL) / CTX) * CTX; hi = lo + CTX; } }
DEV void ph_conv4(const Params& p, long gtid, long gsize) {
    float* UC = (float*)(p.M + M_UC); const bf16_t* P = P_of(p);
    for (long i = gtid; i < (long)TT * LRU_W; i += gsize) {
        const int r = (int)(i / LRU_W), c = (int)(i % LRU_W); int lo, hi; seq_bounds(r, lo, hi);
        float acc = p.e_conv_b[c];
#pragma unroll
        for (int j = 0; j < 4; ++j) { const int rr = r + j - 1; if (rr >= lo && rr < hi) acc += p.e_conv_w[j * LRU_W + c] * bf2f(P[(size_t)rr * EPLD + EC_U + c]); }
        UC[i] = acc;
    }
}
DEV void lru_gate(const Params& p, const float* UC, int row, int d, int c, float& a, float& b) {
    const int blk = c / LRU_BD, cd = c % LRU_BD;
    const float* wa = p.e_wa + ((size_t)(d * LRU_NBLK + blk) * LRU_BD) * LRU_BD + cd;
    const float* wx = p.e_wx + ((size_t)(d * LRU_NBLK + blk) * LRU_BD) * LRU_BD + cd;
    const float* u = UC + (size_t)row * LRU_W + blk * LRU_BD;
    float ra = p.e_ba[d * LRU_W + c], ri = p.e_bx[d * LRU_W + c];
    for (int k = 0; k < LRU_BD; ++k) { ra += u[k] * wa[(size_t)k * LRU_BD]; ri += u[k] * wx[(size_t)k * LRU_BD]; }
    const float r = sigmoidf_(ra), ii = sigmoidf_(ri);
    const float log_a = -LRU_C * r * softplusf_(-p.e_lam[d * LRU_W + c]);
    a = expf(log_a); b = sqrtf(-expm1f(2.0f * log_a)) * (ii * UC[(size_t)row * LRU_W + c]);
}
DEV void ph_scan(const Params& p, long gtid, long gsize) {
    const float* UC = (const float*)(p.M + M_UC); float* REC = (float*)(p.M + M_REC); const bf16_t* P = P_of(p); bf16_t* MIX = p.ACT;
    for (long i = gtid; i < (long)NB * LRU_W; i += gsize) {
        const int b = (int)(i / LRU_W), c = (int)(i % LRU_W);
        float h = 0.f, a, bb;
        for (int s = 0; s < CTX; ++s) { const int row = TL + b * CTX + s; lru_gate(p, UC, row, 0, c, a, bb); h = a * h + bb; REC[(size_t)row * LRU_W + c] = h; }
        for (int s = 0; s < SEQ; ++s) { const int row = b * SEQ + s; lru_gate(p, UC, row, 0, c, a, bb); h = a * h + bb; REC[(size_t)row * LRU_W + c] = h; }
        h = 0.f;
        for (int s = CTX - 1; s >= 0; --s) { const int row = TL + b * CTX + s; lru_gate(p, UC, row, 1, c, a, bb); h = a * h + bb; MIX[(size_t)row * DM + c] = f2bf((REC[(size_t)row * LRU_W + c] + h) * geluf_(bf2f(P[(size_t)row * EPLD + EC_G + c]))); }
        for (int s = SEQ - 1; s >= 0; --s) { const int row = b * SEQ + s; lru_gate(p, UC, row, 1, c, a, bb); h = a * h + bb; MIX[(size_t)row * DM + c] = f2bf((REC[(size_t)row * LRU_W + c] + h) * geluf_(bf2f(P[(size_t)row * EPLD + EC_G + c]))); }
    }
}

DEV void lru_chunk_geom(int u, int& b, int& row0, int& seq_lo, int& seq_hi, int& v0, int& v1) {
    b = u / LRU_NV; const int ci = u % LRU_NV; constexpr int NC = CTX / LRU_CH, NL = SEQ / LRU_CH;
    if (ci < NC) { seq_lo = TL + b * CTX; seq_hi = seq_lo + CTX; row0 = seq_lo + ci * LRU_CH; v0 = ci; v1 = NC - 1 - ci; }
    else { const int rc = ci - NC; seq_lo = b * SEQ; seq_hi = seq_lo + SEQ; row0 = seq_lo + rc * LRU_CH; v0 = NC + rc; v1 = NC + (NL - 1 - rc); }
}
DEV float lru_conv(const Params& p, const bf16_t* P, int row, int c, int lo, int hi) {
    float acc = p.e_conv_b[c];
#pragma unroll
    for (int j = 0; j < 4; ++j) { const int rr = row + j - 1; if (rr >= lo && rr < hi) acc += p.e_conv_w[j * LRU_W + c] * bf2f(P[(size_t)rr * EPLD + EC_U + c]); }
    return acc;
}
DEV void lru_gate2(const Params& p, const bf16_t* P, int row, int d, int c, int lo, int hi, float& la, float& bq) {
    const int blk = c / LRU_BD, cd = c % LRU_BD;
    const bf16_t* wa = p.LRUW + (((size_t)(d * LRU_NBLK + blk) * 2 + 0) * LRU_BD + cd) * LRU_BD; const bf16_t* wx = p.LRUW + (((size_t)(d * LRU_NBLK + blk) * 2 + 1) * LRU_BD + cd) * LRU_BD;
    float ra = 0.f, ri = 0.f;
    for (int k = 0; k < LRU_BD; ++k) { const float u = bf2f(f2bf(lru_conv(p, P, row, blk * LRU_BD + k, lo, hi))); ra += u * bf2f(wa[k]); ri += u * bf2f(wx[k]); }
    const float* cc = p.LRUC + (size_t)(d * LRU_W + c) * 3;
    const float r = sigmoidf_(ra + cc[0]), ii = sigmoidf_(ri + cc[1]);
    const float log_a = -LRU_C * r * cc[2]; const float a = expf(log_a);
    la = bf2f(f2bf(log_a)); bq = bf2f(f2bf(sqrtf(fmaxf(1.0f - a * a, 0.f)) * ii));
}
template <int PASS> DEV void ph_lru_naive(const Params& p, long gtid, long gsize) {
    const bf16_t* P = P_of(p); float* SUM = (float*)(p.M + M_SUM); const float* HIN = (const float*)(p.M + M_HIN); bf16_t* MIX = p.ACT;
    for (long i = gtid; i < (long)NB * LRU_NV * LRU_W; i += gsize) {
        const int c = (int)(i % LRU_W), u = (int)(i / LRU_W); int b, row0, lo, hi, v0, v1; lru_chunk_geom(u, b, row0, lo, hi, v0, v1);
        float hf[LRU_CH];
        for (int d = 0; d < 2; ++d) {
            const int v = d ? v1 : v0; const size_t sidx = (((size_t)b * 2 + d) * LRU_NV + v) * LRU_W + c;
            float h = PASS == 2 ? HIN[sidx] : 0.f, lsum = 0.f;
            for (int tt = 0; tt < LRU_CH; ++tt) { const int t = d ? LRU_CH - 1 - tt : tt; float la, bq; lru_gate2(p, P, row0 + t, d, c, lo, hi, la, bq);
                const float uc = lru_conv(p, P, row0 + t, c, lo, hi); h = expf(la) * h + bq * uc; lsum += la;
                if (PASS == 2) { if (d == 0) hf[t] = h; else MIX[(size_t)(row0 + t) * DM + c] = f2bf((hf[t] + h) * geluf_(bf2f(P[(size_t)(row0 + t) * EPLD + EC_G + c]))); } }
            if (PASS == 1) { SUM[2 * sidx] = expf(lsum); SUM[2 * sidx + 1] = h; }
        }
    }
}
DEV void ph_lru_carry(const Params& p, long gtid, long gsize) {
    const float* SUM = (const float*)(p.M + M_SUM); float* HIN = (float*)(p.M + M_HIN);
    for (long i = gtid; i < (long)NB * 2 * LRU_W; i += gsize) {
        const int c = (int)(i % LRU_W); const long bd = i / LRU_W; float h = 0.f;
        for (int v = 0; v < LRU_NV; ++v) { const size_t sidx = ((size_t)bd * LRU_NV + v) * LRU_W + c; HIN[sidx] = h; h = SUM[2 * sidx] * h + SUM[2 * sidx + 1]; }
    }
}
DEV void ph_swa(const Params& p, long gtid, long gsize) {
    const bf16_t* P = P_of(p); bf16_t* MIX = p.ACT;
    for (long i = gtid; i < (long)TL * SWA_H; i += gsize) {
        const int r = (int)(i % TL), h = (int)(i / TL), kv = h / (SWA_H / SWA_KV), b = r / SEQ, s = r % SEQ;
        float q[SWA_HD], o[SWA_HD];
#pragma unroll
        for (int d = 0; d < SWA_HD; ++d) { q[d] = bf2f(P[(size_t)r * EPLD + EC_Q + h * SWA_HD + d]); o[d] = 0.f; }
        float m = p.e_sink[h] * LOG2E, l = 1.0f;
        const int klo = s - WINDOW < 0 ? 0 : s - WINDOW, khi = s + WINDOW >= SEQ ? SEQ - 1 : s + WINDOW;
        const int nwin = khi - klo + 1;
        for (int kk = 0; kk < nwin + CTX; ++kk) {
            const int kr = kk < nwin ? b * SEQ + klo + kk : TL + b * CTX + (kk - nwin);
            const bf16_t* kp = P + (size_t)kr * EPLD + EC_K + kv * SWA_HD; const bf16_t* vp = P + (size_t)kr * EPLD + EC_V + kv * SWA_HD;
            float sc = 0.f;
#pragma unroll
            for (int d = 0; d < SWA_HD; ++d) sc += q[d] * bf2f(kp[d]);
            const float mn = fmaxf(m, sc), f = exp2f(m - mn), pe = exp2f(sc - mn);
            l = l * f + pe; m = mn;
#pragma unroll
            for (int d = 0; d < SWA_HD; ++d) o[d] = o[d] * f + pe * bf2f(vp[d]);
        }
        const float il = 1.0f / l;
#pragma unroll
        for (int d = 0; d < SWA_HD; ++d) MIX[(size_t)r * DM + LRU_W + h * SWA_HD + d] = f2bf(o[d] * il);
    }
}
DEV void ph_ctxattn(const Params& p, long gtid, long gsize) {
    const bf16_t* P = P_of(p); bf16_t* MIX = p.ACT;
    for (long i = gtid; i < (long)TC * SWA_H; i += gsize) {
        const int rc = (int)(i % TC), h = (int)(i / TC), kv = h / (SWA_H / SWA_KV), b = rc / CTX, r = TL + rc;
        float q[SWA_HD], o[SWA_HD];
#pragma unroll
        for (int d = 0; d < SWA_HD; ++d) { q[d] = bf2f(P[(size_t)r * EPLD + EC_Q + h * SWA_HD + d]); o[d] = 0.f; }
        float m = p.e_sink[h] * LOG2E, l = 1.0f;
        for (int kk = 0; kk < CTX; ++kk) {
            const int kr = TL + b * CTX + kk;
            const bf16_t* kp = P + (size_t)kr * EPLD + EC_K + kv * SWA_HD; const bf16_t* vp = P + (size_t)kr * EPLD + EC_V + kv * SWA_HD;
            float sc = 0.f;
#pragma unroll
            for (int d = 0; d < SWA_HD; ++d) sc += q[d] * bf2f(kp[d]);
            const float mn = fmaxf(m, sc), f = exp2f(m - mn), pe = exp2f(sc - mn);
            l = l * f + pe; m = mn;
#pragma unroll
            for (int d = 0; d < SWA_HD; ++d) o[d] = o[d] * f + pe * bf2f(vp[d]);
        }
        const float il = 1.0f / l;
#pragma unroll
        for (int d = 0; d < SWA_HD; ++d) MIX[(size_t)r * DM + LRU_W + h * SWA_HD + d] = f2bf(o[d] * il);
    }
}
struct EpiOut_naive { bf16_t* Y; const float* bias; DEV void operator()(int m, int n, float acc) const { Y[(size_t)m * DM + n] = f2bf(acc + bias[n]); } };
DEV void ph_ln1(const Params& p, int l, long gtid, long gsize) {
    const bf16_t* Y = P_of(p); bf16_t* F = p.ACT;
    const int nrows = l == 0 ? TT : TL;
    for (long r = gtid; r < nrows; r += gsize) {
        const float* xin = l == 0 ? (r < TL ? p.x + (size_t)r * DM : p.ctx + (size_t)(r - TL) * DM) : p.out + (size_t)r * DM;
        float* xo = r < TL ? p.out + (size_t)r * DM : p.XC + (size_t)(r - TL) * DM;
        const float* m = p.MOD + ((size_t)l * (NB + 1) + cond_of_row((int)r)) * 6 * DM;
        const float* g = p.ln_g + (size_t)(l * 2 + 0) * DM; const float* bb = p.ln_b + (size_t)(l * 2 + 0) * DM;
        const bf16_t* y = Y + (size_t)r * DM;
        float s = 0.f;
        for (int d = 0; d < DM; ++d) s += DN_ALPHA * xin[d] + m[2 * DM + d] * bf2f(y[d]);
        const float mu = s / DM; float q = 0.f;
        for (int d = 0; d < DM; ++d) { const float v = DN_ALPHA * xin[d] + m[2 * DM + d] * bf2f(y[d]) - mu; q += v * v; }
        const float rstd = 1.0f / sqrtf(q / DM + LN_EPS);
        float lg[N_GROUPS], le[N_EXP];
#pragma unroll
        for (int j = 0; j < N_GROUPS; ++j) lg[j] = p.moe_bg[l * N_GROUPS + j];
#pragma unroll
        for (int j = 0; j < N_EXP; ++j) le[j] = p.moe_br[l * N_EXP + j];
        const float* wg = p.moe_wg + (size_t)l * DM * N_GROUPS; const float* wr = p.moe_wr + (size_t)l * DM * N_EXP;
        for (int d = 0; d < DM; ++d) {
            const float v = (DN_ALPHA * xin[d] + m[2 * DM + d] * bf2f(y[d]) - mu) * rstd * g[d] + bb[d];
            const float f = v * (1.0f + m[4 * DM + d]) + m[3 * DM + d];
            xo[d] = v; F[(size_t)r * DM + d] = f2bf(f);
#pragma unroll
            for (int j = 0; j < N_GROUPS; ++j) lg[j] += f * wg[d * N_GROUPS + j];
#pragma unroll
            for (int j = 0; j < N_EXP; ++j) le[j] += f * wr[d * N_EXP + j];
        }
        int gi = 0; float gm = lg[0];
#pragma unroll
        for (int j = 1; j < N_GROUPS; ++j) if (lg[j] > gm) { gm = lg[j]; gi = j; }
        float gs = 0.f;
#pragma unroll
        for (int j = 0; j < N_GROUPS; ++j) gs += expf(lg[j] - gm);
        const float gprob = 1.0f / gs;
        float ev[EPG];
#pragma unroll
        for (int j = 0; j < EPG; ++j) { float v = 0.f;
#pragma unroll
            for (int g2 = 0; g2 < N_GROUPS; ++g2) if (g2 == gi) v = le[g2 * EPG + j];
            ev[j] = v; }
        int i0 = 0; float m0 = ev[0];
#pragma unroll
        for (int j = 1; j < EPG; ++j) if (ev[j] > m0) { m0 = ev[j]; i0 = j; }
        int i1 = -1; float m1 = -3.0e38f;
#pragma unroll
        for (int j = 0; j < EPG; ++j) if (j != i0 && ev[j] > m1) { m1 = ev[j]; i1 = j; }
        const float e1 = expf(m1 - m0), g0 = gprob / (1.0f + e1), g1 = gprob * e1 / (1.0f + e1);
        const int ex0 = gi * EPG + i0, ex1 = gi * EPG + i1;
        const int p0 = atomicAdd(&p.cnt[(l * N_EXP + ex0) * CS], 1);
        const int p1 = atomicAdd(&p.cnt[(l * N_EXP + ex1) * CS], 1);
        p.tok_e[2 * r] = ex0; p.tok_e[2 * r + 1] = ex1; p.tok_pos[2 * r] = p0; p.tok_pos[2 * r + 1] = p1; p.tok_gate[2 * r] = g0; p.tok_gate[2 * r + 1] = g1;
    }
}
DEV int moe_pstart(const int* cnt, int e) { int s = 0; for (int j = 0; j < e; ++j) s += (cnt[j * CS] + MOE_PAD - 1) / MOE_PAD * MOE_PAD; return s; }
DEV void ph_scatter(const Params& p, int l, long gtid, long gsize) {
    const int ntok = l == 0 ? TT : TL; const int* cnt = p.cnt + l * N_EXP * CS; bf16_t* XS = (bf16_t*)(p.M + M_XS);
    constexpr int CH = DM / 8;
    for (long i = gtid; i < (long)ntok * 2 * CH; i += gsize) {
        const int ch = (int)(i % CH), a = (int)(i / CH);
        const int row = moe_pstart(cnt, p.tok_e[a]) + p.tok_pos[a];
        if (ch == 0) p.tok_row[a] = row;
        const U128 v = *(const U128*)(p.ACT + (size_t)(a >> 1) * DM + ch * 8);
        *(U128*)(XS + (size_t)row * DM + ch * 8) = v;
    }
}
DEV void ph_moe1_naive(const Params& p, int l, long gtid, long gsize) {
    const int* cnt = p.cnt + l * N_EXP * CS; const bf16_t* XS = (const bf16_t*)(p.M + M_XS); bf16_t* H1 = (bf16_t*)(p.M + M_H1);
    for (long i = gtid; i < (long)CR_MAX * D_EXP; i += gsize) {
        const int j = (int)(i % D_EXP), row = (int)(i / D_EXP);
        int e = -1, s = 0; for (int k = 0; k < N_EXP; ++k) { if (row >= s && row < s + cnt[k * CS]) e = k; s += (cnt[k * CS] + MOE_PAD - 1) / MOE_PAD * MOE_PAD; }
        if (e < 0) continue;
        const bf16_t* Wb = p.W_up + ((size_t)(l * N_EXP + e) * 2 * D_EXP) * DM;
        const int grp = j / UPG, jj = j % UPG;
        const bf16_t* w1 = Wb + (size_t)(grp * 2 * UPG + jj) * DM; const bf16_t* w3 = Wb + (size_t)(grp * 2 * UPG + UPG + jj) * DM; const bf16_t* a = XS + (size_t)row * DM;
        float a1 = 0.f, a3 = 0.f;
        for (int k = 0; k < DM; ++k) { const float av = bf2f(a[k]); a1 += av * bf2f(w1[k]); a3 += av * bf2f(w3[k]); }
        H1[(size_t)row * D_EXP + j] = f2bf(siluf_(a1) * a3);
    }
}
DEV void ph_moe2_naive(const Params& p, int l, long gtid, long gsize) {
    const int* cnt = p.cnt + l * N_EXP * CS; const bf16_t* H1 = (const bf16_t*)(p.M + M_H1); bf16_t* YS = (bf16_t*)(p.M + M_XS);
    for (long i = gtid; i < (long)CR_MAX * DM; i += gsize) {
        const int n = (int)(i % DM), row = (int)(i / DM);
        int e = -1, s = 0; for (int k = 0; k < N_EXP; ++k) { if (row >= s && row < s + cnt[k * CS]) e = k; s += (cnt[k * CS] + MOE_PAD - 1) / MOE_PAD * MOE_PAD; }
        if (e < 0) continue;
        const bf16_t* w = p.W_dn + ((size_t)(l * N_EXP + e) * DM + n) * D_EXP; const bf16_t* a = H1 + (size_t)row * D_EXP;
        float acc = 0.f;
        for (int k = 0; k < D_EXP; ++k) acc += bf2f(a[k]) * bf2f(w[k]);
        YS[(size_t)row * DM + n] = f2bf(acc);
    }
}
DEV void ph_ln2(const Params& p, int l, long gtid, long gsize) {
    const bf16_t* YS = (const bf16_t*)(p.M + M_XS); const int nrows = l == 0 ? TT : TL;
    for (long r = gtid; r < nrows; r += gsize) {
        float* xo = r < TL ? p.out + (size_t)r * DM : p.XC + (size_t)(r - TL) * DM;
        const float* m = p.MOD + ((size_t)l * (NB + 1) + cond_of_row((int)r)) * 6 * DM;
        const float* g = p.ln_g + (size_t)(l * 2 + 1) * DM; const float* bb = p.ln_b + (size_t)(l * 2 + 1) * DM;
        const bf16_t* y0 = YS + (size_t)p.tok_row[2 * r] * DM; const bf16_t* y1 = YS + (size_t)p.tok_row[2 * r + 1] * DM;
        const float g0 = p.tok_gate[2 * r], g1 = p.tok_gate[2 * r + 1];
        float s = 0.f;
        for (int d = 0; d < DM; ++d) s += DN_ALPHA * xo[d] + m[5 * DM + d] * (g0 * bf2f(y0[d]) + g1 * bf2f(y1[d]));
        const float mu = s / DM; float q = 0.f;
        for (int d = 0; d < DM; ++d) { const float v = DN_ALPHA * xo[d] + m[5 * DM + d] * (g0 * bf2f(y0[d]) + g1 * bf2f(y1[d])) - mu; q += v * v; }
        const float rstd = 1.0f / sqrtf(q / DM + LN_EPS);
        const float* m1 = p.MOD + ((size_t)1 * (NB + 1) + cond_of_row((int)r)) * 6 * DM;
        for (int d = 0; d < DM; ++d) {
            const float v = (DN_ALPHA * xo[d] + m[5 * DM + d] * (g0 * bf2f(y0[d]) + g1 * bf2f(y1[d])) - mu) * rstd * g[d] + bb[d];
            xo[d] = v;
            if (l == 0) p.ACT[(size_t)r * DM + d] = f2bf(v * (1.0f + m1[DM + d]) + m1[d]);
        }
    }
}
struct EpiInO_naive { const Params* p; DEV void operator()(int m, int n, float acc) const { if (n < ODD_IN) P_of(*p)[(size_t)m * OPLD + n] = f2bf(acc + p->o_b_in[n]); } };
DEV void ph_l1_post_inproj(const Params& p, long gtid, long gsize) {
    const bf16_t* P = P_of(p); bf16_t* Kb = (bf16_t*)(p.M + M_K);
    for (long r = gtid; r < TT; r += gsize) {
        const bf16_t* row = P + (size_t)r * OPLD;
        float s = 0.f; for (int d = 0; d < MLA_QR; ++d) { const float v = bf2f(row[d]); s += v * v; }
        p.SSQ[r * 8 + 0] = s; p.SSQ[r * 8 + 1] = 0.f; p.SSQ[r * 8 + 2] = 0.f; p.SSQ[r * 8 + 3] = 0.f;
        s = 0.f; for (int d = 0; d < MLA_KVR; ++d) { const float v = bf2f(row[OC_CKV + d]); s += v * v; }
        p.SSQ[r * 8 + 4] = s; p.SSQ[r * 8 + 5] = 0.f; p.SSQ[r * 8 + 6] = 0.f; p.SSQ[r * 8 + 7] = 0.f;
        constexpr int half = MLA_ROPE / 4;
        for (int part = 0; part < 2; ++part) for (int pi = 0; pi < half; ++pi) {
            float cs = 1.f, sn = 0.f;
            if (r < TL) { const int sq = (int)(r % SEQ); const int pos = part == 0 ? sq / GRID_W : sq % GRID_W; cs = p.ROPE_MLA[2 * (pos * half + pi)]; sn = p.ROPE_MLA[2 * (pos * half + pi) + 1]; }
            const float x1 = bf2f(row[OC_KPE + part * (MLA_ROPE / 2) + pi]), x2 = bf2f(row[OC_KPE + part * (MLA_ROPE / 2) + half + pi]);
            const bf16_t o1 = f2bf(x1 * cs - x2 * sn), o2 = f2bf(x1 * sn + x2 * cs);
            for (int h = 0; h < MLA_H; ++h) { bf16_t* kd = Kb + (size_t)r * MLA_H * MLA_QD + h * MLA_QD + MLA_NOPE + part * (MLA_ROPE / 2); kd[pi] = o1; kd[half + pi] = o2; }
        }
    }
}
constexpr float MLA_QSCALE = LOG2E * (MLA_QD == 96 ? 0.10206207261596577f : 0.20412414523193154f);
DEV float rs_from_ssq(const float* s4, int n) { return 1.0f / sqrtf(((s4[0] + s4[1]) + (s4[2] + s4[3])) / (float)n + LN_EPS); }
DEV void ph_uq_naive(const Params& p, long gtid, long gsize) {
    const bf16_t* P = P_of(p); bf16_t* Q = (bf16_t*)(p.M + M_Q); constexpr int half = MLA_ROPE / 4;
    for (long i = gtid; i < (long)TL * MLA_H; i += gsize) {
        const int r = (int)(i / MLA_H), h = (int)(i % MLA_H); const float rs = rs_from_ssq(p.SSQ + (size_t)r * 8, MLA_QR);
        float q[MLA_QD];
        for (int d = 0; d < MLA_QD; ++d) { float acc = 0.f; const bf16_t* w = p.W_uq + (size_t)(h * MLA_QD + d) * MLA_QR; for (int k = 0; k < MLA_QR; ++k) acc += bf2f(P[(size_t)r * OPLD + k]) * bf2f(w[k]); q[d] = acc * rs; }
        const int sq = r % SEQ;
        for (int part = 0; part < 2; ++part) for (int pi = 0; pi < half; ++pi) {
            const int pos = part == 0 ? sq / GRID_W : sq % GRID_W; const float cs = p.ROPE_MLA[2 * (pos * half + pi)], sn = p.ROPE_MLA[2 * (pos * half + pi) + 1];
            float& x1 = q[MLA_NOPE + part * (MLA_ROPE / 2) + pi]; float& x2 = q[MLA_NOPE + part * (MLA_ROPE / 2) + half + pi];
            const float a = x1 * cs - x2 * sn, b = x1 * sn + x2 * cs; x1 = a; x2 = b;
        }
        for (int d = 0; d < MLA_QD; ++d) Q[(size_t)r * MLA_H * MLA_QD + h * MLA_QD + d] = f2bf(q[d] * MLA_QSCALE);
    }
}
struct EpiUkv_naive { const Params* p; DEV void operator()(int m, int n, float acc) const {
    const float v = acc * rs_from_ssq(p->SSQ + (size_t)m * 8 + 4, MLA_KVR);
    if (n < MLA_H * MLA_NOPE) ((bf16_t*)(p->M + M_K))[(size_t)m * MLA_H * MLA_QD + (n / MLA_NOPE) * MLA_QD + n % MLA_NOPE] = f2bf(v);
    else ((bf16_t*)(p->M + M_V))[(size_t)m * MLA_H * MLA_V + (n - MLA_H * MLA_NOPE)] = f2bf(v); } };
DEV void ph_conf_conv(const Params& p, long gtid, long gsize) {
    const bf16_t* P = P_of(p); bf16_t* CV = (bf16_t*)(p.M + M_CV);
    for (long i = gtid; i < (long)TL * CONF_CH; i += gsize) {
        const int r = (int)(i / CONF_CH), c = (int)(i % CONF_CH); const int lo = (r / SEQ) * SEQ, hi = lo + SEQ;
        float acc = p.o_dw_b[c];
        for (int j = 0; j < CONF_K; ++j) { const int rr = r + j - (CONF_K - 1) / 2; if (rr >= lo && rr < hi) { const bf16_t* row = P + (size_t)rr * OPLD; acc += p.o_dw_w[j * CONF_CH + c] * bf2f(row[OC_A + c]) * sigmoidf_(bf2f(row[OC_G + c])); } }
        CV[i] = f2bf(acc);
    }
}
DEV void ph_conf_ln(const Params& p, long gtid, long gsize) {
    const bf16_t* CV = (const bf16_t*)(p.M + M_CV); bf16_t* MIX = p.ACT;
    for (long r = gtid; r < TL; r += gsize) {
        const bf16_t* v = CV + (size_t)r * CONF_CH; float s = 0.f;
        for (int d = 0; d < CONF_CH; ++d) s += bf2f(v[d]);
        const float mu = s / CONF_CH; float q = 0.f;
        for (int d = 0; d < CONF_CH; ++d) q += (bf2f(v[d]) - mu) * (bf2f(v[d]) - mu);
        const float rstd = 1.0f / sqrtf(q / CONF_CH + LN_EPS);
        for (int d = 0; d < CONF_CH; ++d) MIX[(size_t)r * DM + MLA_H * MLA_V + d] = f2bf(siluf_((bf2f(v[d]) - mu) * rstd * p.o_cln_g[d] + p.o_cln_b[d]));
    }
}
DEV void ph_mla_attn(const Params& p, long gtid, long gsize) {
    const bf16_t* Q = (const bf16_t*)(p.M + M_Q); const bf16_t* Kb = (const bf16_t*)(p.M + M_K); const bf16_t* V = (const bf16_t*)(p.M + M_V); bf16_t* MIX = p.ACT;
    for (long i = gtid; i < (long)TL * MLA_H; i += gsize) {
        const int r = (int)(i % TL), h = (int)(i / TL), b = r / SEQ;
        float q[MLA_QD], o[MLA_V];
#pragma unroll
        for (int d = 0; d < MLA_QD; ++d) q[d] = bf2f(Q[(size_t)r * MLA_H * MLA_QD + h * MLA_QD + d]);
#pragma unroll
        for (int d = 0; d < MLA_V; ++d) o[d] = 0.f;
        float m = -3.0e38f, l = 0.f;
        for (int kk = 0; kk < CTX + SEQ; ++kk) {
            const int kr = kk < CTX ? TL + b * CTX + kk : b * SEQ + (kk - CTX);
            const bf16_t* kp = Kb + (size_t)kr * MLA_H * MLA_QD + h * MLA_QD; const bf16_t* vp = V + (size_t)kr * MLA_H * MLA_V + h * MLA_V;
            float sc = 0.f;
#pragma unroll
            for (int d = 0; d < MLA_QD; ++d) sc += q[d] * bf2f(kp[d]);
            const float mn = fmaxf(m, sc), f = exp2f(m - mn), pe = exp2f(sc - mn);
            l = l * f + pe; m = mn;
#pragma unroll
            for (int d = 0; d < MLA_V; ++d) o[d] = o[d] * f + pe * bf2f(vp[d]);
        }
        const float il = 1.0f / l;
#pragma unroll
        for (int d = 0; d < MLA_V; ++d) MIX[(size_t)r * DM + h * MLA_V + d] = f2bf(o[d] * il);
    }
}


#ifndef CPU_SIM
#define FLAS __attribute__((address_space(3)))
#endif
#ifndef CPU_SIM
namespace pg8 {
#define PG8_LAS __attribute__((address_space(3)))
typedef short bf16x8 __attribute__((ext_vector_type(8)));
typedef float f32x4 __attribute__((ext_vector_type(4)));
typedef unsigned u32x4 __attribute__((ext_vector_type(4)));
typedef unsigned v4u_ __attribute__((vector_size(16)));
__device__ __forceinline__ __amdgpu_buffer_rsrc_t wt_rsrc(const void* base) { return __builtin_amdgcn_make_buffer_rsrc((void*)base, (short)0, (int)0xFFFFFFFFu, 0x00020000); }
__device__ __forceinline__ void st_wt16(__amdgpu_buffer_rsrc_t r, unsigned off, u32x4 v) { __builtin_amdgcn_raw_buffer_store_b128(__builtin_bit_cast(v4u_, v), r, (int)off, 0, 16); }
constexpr int BM = 256, BK = 64, HALF = 128, HTB = HALF * BK * 2  , STAGE_BYTES = 8 * HTB, NXCD = 8, WGM = 8;

__host__ __device__ __forceinline__ int lds_byte(int r, int c) { const int st = (r >> 4) * 2 + (c >> 5), rr = r & 15, cc = c & 31, ob = rr * 64 + cc * 2; return st * 1024 + (ob ^ (((ob >> 9) & 1) << 5)); }
__host__ __device__ __forceinline__ void stage_rc(int b, int& R, int& C) { const int st = b / 1024, sb = b % 1024, swz = sb ^ (((sb >> 9) & 1) << 5); R = (st >> 1) * 16 + swz / 64; C = (st & 1) * 32 + (swz % 64) / 2; }
__host__ __device__ __forceinline__ int perm32(int rho) { const int n = rho >> 4, i = rho & 15; return 8 * (i >> 2) + 4 * n + (i & 3); }

struct Unit { int pm, pn; };
struct Gemm { const bf16_t* A; const bf16_t* Bt; int M, N, K, lda; };

struct StaticOrder {
    int nM, nN, nwg, G, c;
    __host__ __device__ void init(int M, int N, int G_, int c_) { nM = M / BM; nN = N / BM; nwg = nM * nN; G = G_; c = c_; }
    __host__ __device__ bool next(int i, Unit& u) const {
        const long L = (long)i * G + c; if (L >= nwg) return false;
        int wgid = (int)L; { const int q = nwg / NXCD, r = nwg % NXCD, xcd = wgid % NXCD, off = wgid / NXCD; wgid = (xcd < r ? xcd * (q + 1) : r * (q + 1) + (xcd - r) * q) + off; }
        const int nig = WGM * nN, gid = wgid / nig, fm = gid * WGM, gsz = (nM - fm) < WGM ? (nM - fm) : WGM;
        u.pm = fm + ((wgid % nig) % gsz); u.pn = (wgid % nig) / gsz; return true;
    }
    __device__ __forceinline__ void a_ready(const Unit&) const {}
    __device__ __forceinline__ void done(const Unit&) const {}
};
__device__ __forceinline__ unsigned cvt_pk_bf16(float lo, float hi) { unsigned r; asm volatile("v_cvt_pk_bf16_f32 %0, %1, %2" : "=v"(r) : "v"(lo), "v"(hi)); return r; }
typedef float f32x2 __attribute__((ext_vector_type(2)));
typedef int i32x4 __attribute__((ext_vector_type(4)));
typedef int i32x8 __attribute__((ext_vector_type(8)));
__device__ __forceinline__ i32x8 cat8(const bf16x8 a, const bf16x8 b) { return __builtin_shufflevector(__builtin_bit_cast(i32x4, a), __builtin_bit_cast(i32x4, b), 0, 1, 2, 3, 4, 5, 6, 7); }
__device__ __forceinline__ void mfma8(f32x4& c, const i32x8 a, const i32x8 b) { asm volatile("v_mfma_f32_16x16x128_f8f6f4 %0, %1, %2, %0" : "+v"(c) : "v"(a), "v"(b)); }
__device__ __forceinline__ void mfma8_drain() { asm volatile("s_nop 15\n\ts_nop 15\n\ts_nop 15" ::: "memory"); }
__device__ __forceinline__ unsigned pk8(float a, float b, float c, float d) {
    a = __builtin_amdgcn_fmed3f(a, -448.f, 448.f); b = __builtin_amdgcn_fmed3f(b, -448.f, 448.f); c = __builtin_amdgcn_fmed3f(c, -448.f, 448.f); d = __builtin_amdgcn_fmed3f(d, -448.f, 448.f);
    int v = __builtin_amdgcn_cvt_pk_fp8_f32(a, b, 0, false); v = __builtin_amdgcn_cvt_pk_fp8_f32(c, d, v, true); return (unsigned)v; }
template <class Epi, class Sched, bool ALIGN_EPI = false, bool SP2 = false, bool GATHER = false, bool FP8 = false>
__device__ __forceinline__ void gemm_phase(PG8_LAS unsigned char* lds, const Gemm g, const Sched& S, const Epi& E) {
    static_assert(!GATHER || SP2, "gathered A rows are wired into the SP2 loop only");
    const int tid = threadIdx.x, wid = __builtin_amdgcn_readfirstlane(tid >> 6), lane = tid & 63, wr = wid >> 2, wc = wid & 3, fr = lane & 15, fq = lane >> 4;
    const int K = g.K, nt = K / BK;
    unsigned voffA[2], voffB[2];
#pragma unroll
    for (int i = 0; i < 2; ++i) { int R, C; stage_rc(tid * 16 + i * 8192, R, C); const int Rb = Epi::PERM ? ((R & ~31) + perm32(R & 31)) : R;
        voffA[i] = (unsigned)(R * g.lda + C) * 2u; voffB[i] = (unsigned)(Rb * K + C) * 2u; }
    const size_t kstep = (size_t)(BK * 2);
    const size_t hstepB = (size_t)HALF * K * 2, hstepA = (size_t)HALF * g.lda * 2;
    const size_t tstepA = GATHER ? 0 : 2 * hstepA, tstepB = 2 * hstepB;
    const unsigned ldsw = (unsigned)wid * 1024u;
    const int aoff = lds_byte(wr * 64 + fr, fq * 8), boff = lds_byte(wc * 32 + fr, fq * 8);
#define PG8_SA(b, h) (((b) * 2 + (h)) * HTB)
#define PG8_SB(b, h) ((4 + (b) * 2 + (h)) * HTB)
#define PG8_STAGE(bufoff, gbase, voff) do { _Pragma("unroll") for (int _i = 0; _i < 2; ++_i) \
        __builtin_amdgcn_global_load_lds((const unsigned*)((const char*)(gbase) + (voff)[_i]), (PG8_LAS unsigned*)(lds + (bufoff) + ldsw + _i * 8192), 16, 0, 0); } while (0)
#define PG8_LDA(dst, b, h) do { _Pragma("unroll") for (int m = 0; m < 4; ++m) _Pragma("unroll") for (int k = 0; k < 2; ++k) dst[m][k] = *(const PG8_LAS bf16x8*)(lds + PG8_SA(b, h) + aoff + m * 2048 + k * 1024); } while (0)
#define PG8_LDB(dst, b, h) do { _Pragma("unroll") for (int n = 0; n < 2; ++n) _Pragma("unroll") for (int k = 0; k < 2; ++k) dst[n][k] = *(const PG8_LAS bf16x8*)(lds + PG8_SB(b, h) + boff + n * 2048 + k * 1024); } while (0)
#define PG8_MMA(ai, bj, At, Bt) do { __builtin_amdgcn_s_setprio(1); if constexpr (FP8) { _Pragma("unroll") for (int m = 0; m < 4; ++m) _Pragma("unroll") for (int n = 0; n < 2; ++n) \
        mfma8(acc[ai][bj][m][n], cat8(Bt[n][0], Bt[n][1]), cat8(At[m][0], At[m][1])); } else { \
        _Pragma("unroll") for (int m = 0; m < 4; ++m) _Pragma("unroll") for (int n = 0; n < 2; ++n) _Pragma("unroll") for (int k = 0; k < 2; ++k) \
        acc[ai][bj][m][n] = __builtin_amdgcn_mfma_f32_16x16x32_bf16(Bt[n][k], At[m][k], acc[ai][bj][m][n], 0, 0, 0); } __builtin_amdgcn_s_setprio(0); } while (0)
#define PG8_WAIT_V(n) asm volatile("s_waitcnt vmcnt(" #n ")" ::: "memory")
#define PG8_WAIT_L(n) asm volatile("s_waitcnt lgkmcnt(" #n ")" ::: "memory")
#define PG8_BAR __builtin_amdgcn_s_barrier()
#define PG8_SCHED __builtin_amdgcn_sched_barrier(0)
    Unit cur, nxt; int ui = 0;
    if (!S.next(0, cur)) return;
    unsigned vA[2][2], vN[2][2];
    if constexpr (GATHER) {
#pragma unroll
        for (int h = 0; h < 2; ++h)
#pragma unroll
            for (int i = 0; i < 2; ++i) { int R, C; stage_rc(tid * 16 + i * 8192, R, C); vA[h][i] = (unsigned)(S.a_row(cur, h * HALF + R) * g.lda + C) * 2u; vN[h][i] = vA[h][i]; }
    }
#define PG8_STAGE_A(bufoff, gbase, h, nx) do { if constexpr (GATHER) { const unsigned v2_[2] = {(nx) ? vN[h][0] : vA[h][0], (nx) ? vN[h][1] : vA[h][1]}; PG8_STAGE(bufoff, gbase, v2_); } \
        else { PG8_STAGE(bufoff, (gbase) + ((h) ? hstepA : 0), voffA); } } while (0)
    f32x4 acc[2][2][4][2];
#pragma unroll
    for (int a = 0; a < 2; ++a)
#pragma unroll
        for (int b = 0; b < 2; ++b)
#pragma unroll
            for (int m = 0; m < 4; ++m)
#pragma unroll
                for (int n = 0; n < 2; ++n) acc[a][b][m][n] = (f32x4){0.f, 0.f, 0.f, 0.f};
    bf16x8 At[4][2], B0[2][2], B1[2][2];
    const char* cA = (const char*)g.A + (size_t)cur.pm * tstepA; const char* cB = (const char*)g.Bt + (size_t)cur.pn * tstepB;
    S.a_ready(cur);
    if constexpr (SP2) {
        PG8_STAGE(PG8_SB(0, 0), cB, voffB); PG8_STAGE(PG8_SB(0, 1), cB + hstepB, voffB); PG8_STAGE_A(PG8_SA(0, 0), cA, 0, false); PG8_STAGE_A(PG8_SA(0, 1), cA, 1, false);
        if (wr == 1) PG8_BAR;
        PG8_WAIT_V(2); PG8_BAR;
        PG8_STAGE(PG8_SB(1, 0), cB + kstep, voffB); PG8_STAGE_A(PG8_SA(1, 0), cA + kstep, 0, false); PG8_STAGE(PG8_SB(1, 1), cB + hstepB + kstep, voffB);
        PG8_WAIT_V(6); PG8_BAR;
    } else {
        PG8_STAGE(PG8_SB(0, 0), cB, voffB); PG8_STAGE(PG8_SA(0, 0), cA, voffA); PG8_STAGE(PG8_SB(0, 1), cB + hstepB, voffB); PG8_STAGE(PG8_SA(0, 1), cA + hstepA, voffA);
        if (wr == 1) PG8_BAR;
        PG8_WAIT_V(4); PG8_BAR;
        PG8_STAGE(PG8_SB(1, 0), cB + kstep, voffB); PG8_STAGE(PG8_SA(1, 0), cA + kstep, voffA); PG8_STAGE(PG8_SB(1, 1), cB + hstepB + kstep, voffB);
        PG8_WAIT_V(6); PG8_BAR;
    }
    for (;;) {
        const bool has_next = S.next(ui + 1, nxt);
        if constexpr (GATHER) { if (has_next) { int t2 = threadIdx.x; asm volatile("" : "+v"(t2)); int rw_[2][2];
#pragma unroll
            for (int h = 0; h < 2; ++h)
#pragma unroll
                for (int i = 0; i < 2; ++i) { int R, C; stage_rc(t2 * 16 + i * 8192, R, C); rw_[h][i] = S.a_row(nxt, h * HALF + R); }
            asm volatile("" ::: "memory");
#pragma unroll
            for (int h = 0; h < 2; ++h)
#pragma unroll
                for (int i = 0; i < 2; ++i) { int R, C; stage_rc(t2 * 16 + i * 8192, R, C); vN[h][i] = (unsigned)(rw_[h][i] * g.lda + C) * 2u; } } }
        const char* nA = has_next ? (const char*)g.A + (size_t)nxt.pm * tstepA : cA; const char* nB = has_next ? (const char*)g.Bt + (size_t)nxt.pn * tstepB : cB;
#pragma nounroll
        for (int t = 0; t < nt; t += 2) {
            const bool last = (t == nt - 2);
            const char* a1 = cA + (size_t)(t + 1) * kstep;
            const char* a2 = last ? nA : cA + (size_t)(t + 2) * kstep; const char* b2 = last ? nB : cB + (size_t)(t + 2) * kstep;
            const char* a3 = a2 + kstep; const char* b3 = b2 + kstep;
            if (last && has_next) S.a_ready(nxt);
            if constexpr (SP2) {
            PG8_LDB(B0, 0, 0); PG8_LDB(B1, 0, 1); PG8_SCHED; PG8_LDA(At, 0, 0); PG8_STAGE_A(PG8_SA(1, 1), a1, 1, false);
            PG8_WAIT_V(8); PG8_WAIT_L(0); PG8_BAR; PG8_MMA(0, 0, At, B0); PG8_MMA(0, 1, At, B1); PG8_BAR; PG8_SCHED;
            PG8_LDA(At, 0, 1); PG8_STAGE(PG8_SB(0, 0), b2, voffB); PG8_STAGE(PG8_SB(0, 1), b2 + hstepB, voffB); PG8_STAGE_A(PG8_SA(0, 0), a2, 0, last);
            PG8_WAIT_V(8); PG8_WAIT_L(0); PG8_BAR; PG8_MMA(1, 0, At, B0); PG8_MMA(1, 1, At, B1); PG8_BAR; PG8_SCHED;
            PG8_LDB(B0, 1, 0); PG8_LDB(B1, 1, 1); PG8_SCHED; PG8_LDA(At, 1, 0); PG8_STAGE_A(PG8_SA(0, 1), a2, 1, last);
            PG8_WAIT_V(8); PG8_WAIT_L(0); PG8_BAR; PG8_MMA(0, 0, At, B0); PG8_MMA(0, 1, At, B1); PG8_BAR; PG8_SCHED;
            PG8_LDA(At, 1, 1); PG8_STAGE(PG8_SB(1, 0), b3, voffB); PG8_STAGE(PG8_SB(1, 1), b3 + hstepB, voffB); PG8_STAGE_A(PG8_SA(1, 0), a3, 0, last);
            PG8_WAIT_V(8); PG8_WAIT_L(0); PG8_BAR; PG8_MMA(1, 0, At, B0); PG8_MMA(1, 1, At, B1); PG8_BAR; PG8_SCHED;
            } else {
            PG8_LDB(B0, 0, 0); PG8_SCHED; PG8_LDA(At, 0, 0); PG8_STAGE(PG8_SA(1, 1), a1 + hstepA, voffA);
            PG8_WAIT_L(8); PG8_BAR; PG8_WAIT_L(0); PG8_MMA(0, 0, At, B0); PG8_BAR; PG8_SCHED;
            PG8_LDB(B1, 0, 1); PG8_STAGE(PG8_SB(0, 0), b2, voffB);
            PG8_BAR; PG8_WAIT_L(0); PG8_MMA(0, 1, At, B1); PG8_BAR;
            PG8_LDA(At, 0, 1); PG8_STAGE(PG8_SA(0, 0), a2, voffA);
            PG8_BAR; PG8_WAIT_L(0); PG8_MMA(1, 0, At, B0); PG8_BAR; PG8_SCHED;
            PG8_STAGE(PG8_SB(0, 1), b2 + hstepB, voffB);
            PG8_WAIT_V(6); PG8_BAR; PG8_MMA(1, 1, At, B1); PG8_BAR;
            PG8_LDB(B0, 1, 0); PG8_SCHED; PG8_LDA(At, 1, 0); PG8_STAGE(PG8_SA(0, 1), a2 + hstepA, voffA);
            PG8_WAIT_L(8); PG8_BAR; PG8_WAIT_L(0); PG8_MMA(0, 0, At, B0); PG8_BAR; PG8_SCHED;
            PG8_LDB(B1, 1, 1); PG8_STAGE(PG8_SB(1, 0), b3, voffB);
            PG8_BAR; PG8_WAIT_L(0); PG8_MMA(0, 1, At, B1); PG8_BAR;
            PG8_LDA(At, 1, 1); PG8_STAGE(PG8_SA(1, 0), a3, voffA);
            PG8_BAR; PG8_WAIT_L(0); PG8_MMA(1, 0, At, B0); PG8_BAR; PG8_SCHED;
            PG8_STAGE(PG8_SB(1, 1), b3 + hstepB, voffB);
            PG8_WAIT_V(6); PG8_BAR; PG8_MMA(1, 1, At, B1); PG8_BAR;
            }
        }
        if constexpr (FP8) { mfma8_drain(); PG8_SCHED; }
        if constexpr (ALIGN_EPI) { if (wr == 0) PG8_BAR; }
        if constexpr (!Epi::AFTER_DRAIN) { E(acc, cur, wr, wc, fr, fq); S.done(cur); }
        if (!has_next) break;
#pragma unroll
        for (int a = 0; a < 2; ++a)
#pragma unroll
            for (int b = 0; b < 2; ++b)
#pragma unroll
                for (int m = 0; m < 4; ++m)
#pragma unroll
                    for (int n = 0; n < 2; ++n) acc[a][b][m][n] = (f32x4){0.f, 0.f, 0.f, 0.f};
        cur = nxt; cA = nA; cB = nB; ++ui;
        if constexpr (GATHER) {
#pragma unroll
            for (int h = 0; h < 2; ++h)
#pragma unroll
                for (int i = 0; i < 2; ++i) vA[h][i] = vN[h][i]; }
        if constexpr (ALIGN_EPI) { if (wr == 1) PG8_BAR; }
    }
    PG8_WAIT_V(0);
    if constexpr (!ALIGN_EPI) { if (wr == 0) PG8_BAR; }
    PG8_BAR;
    if constexpr (Epi::AFTER_DRAIN) { E.fused(acc, cur, wr, wc, fr, fq, lds, wid, lane); S.done(cur); }
#undef PG8_SA
#undef PG8_SB
#undef PG8_STAGE
#undef PG8_STAGE_A
#undef PG8_LDA
#undef PG8_LDB
#undef PG8_MMA
#undef PG8_WAIT_V
#undef PG8_WAIT_L
#undef PG8_BAR
#undef PG8_SCHED
}
}
namespace pg8 {
__device__ __forceinline__ u32x4 pack8(const f32x4 v0, const f32x4 v1) { u32x4 w; w.x = cvt_pk_bf16(v0[0], v0[1]); w.y = cvt_pk_bf16(v0[2], v0[3]); w.z = cvt_pk_bf16(v1[0], v1[1]); w.w = cvt_pk_bf16(v1[2], v1[3]); return w; }
__device__ __forceinline__ float bfr(float v) { return __uint_as_float(cvt_pk_bf16(v, 0.f) << 16); }
#define PG8_EPI_LOOP for (int ai = 0; ai < 2; ++ai) _Pragma("unroll") for (int m = 0; m < 4; ++m) _Pragma("unroll") for (int bj = 0; bj < 2; ++bj)
struct EpiPlain {
    static constexpr bool PERM = true, AFTER_DRAIN = false;
    bf16_t* O; int ldc; const float* bias; int pn_mod;
    __device__ __forceinline__ void operator()(const f32x4 (&acc)[2][2][4][2], const Unit& u, int wr, int wc, int fr, int fq) const {
        const int row0 = u.pm * BM + wr * 64 + fr; const int ct = pn_mod ? u.pn % pn_mod : u.pn; const int col0 = ct * BM + wc * 32 + 8 * fq;
        f32x4 bv[2][2];
#pragma unroll
        for (int bj = 0; bj < 2; ++bj)
#pragma unroll
            for (int n = 0; n < 2; ++n) bv[bj][n] = bias ? *(const f32x4*)(bias + col0 + bj * HALF + 4 * n) : (f32x4){0.f, 0.f, 0.f, 0.f};
        const __amdgpu_buffer_rsrc_t rs_ = wt_rsrc(O);
#pragma unroll
        PG8_EPI_LOOP { st_wt16(rs_, (unsigned)((row0 + ai * HALF + m * 16) * ldc + col0 + bj * HALF) * 2u, pack8(acc[ai][bj][m][0] + bv[bj][0], acc[ai][bj][m][1] + bv[bj][1])); }
    }
};
struct EpiMoeUp {
    static constexpr bool PERM = true, AFTER_DRAIN = false;
    bf16_t* H1;
    __device__ __forceinline__ void operator()(const f32x4 (&acc)[2][2][4][2], const Unit& u, int wr, int wc, int fr, int fq) const {
        const int row0 = u.pm * BM + wr * 64 + fr; const int ct = u.pn % (2 * D_EXP / BM); const int col0 = ct * HALF + wc * 32 + 8 * fq;
#pragma unroll
        for (int ai = 0; ai < 2; ++ai)
#pragma unroll
            for (int m = 0; m < 4; ++m) { f32x4 o[2];
#pragma unroll
                for (int n = 0; n < 2; ++n)
#pragma unroll
                    for (int j = 0; j < 4; ++j) { const float a = acc[ai][0][m][n][j], b = acc[ai][1][m][n][j]; o[n][j] = a / (1.0f + __expf(-a)) * b; }
                *(u32x4*)(H1 + (size_t)(row0 + ai * HALF + m * 16) * D_EXP + col0) = pack8(o[0], o[1]); }
    }
};
struct EpiMoeUp8 {
    static constexpr bool PERM = true, AFTER_DRAIN = false;
    unsigned char* H1;
    __device__ __forceinline__ void operator()(const f32x4 (&acc)[2][2][4][2], const Unit& u, int wr, int wc, int fr, int fq) const {
        const int row0 = u.pm * BM + wr * 64 + fr; const int ct = u.pn % (2 * D_EXP / BM); const int col0 = ct * HALF + wc * 32 + 8 * fq;
        constexpr float SA = 1.0f / (FP8_SF * FP8_SW1), SB = FP8_SH / (FP8_SF * FP8_SW1);
#pragma unroll
        for (int ai = 0; ai < 2; ++ai)
#pragma unroll
            for (int m = 0; m < 4; ++m) { f32x4 o[2];
#pragma unroll
                for (int n = 0; n < 2; ++n)
#pragma unroll
                    for (int j = 0; j < 4; ++j) { const float a = acc[ai][0][m][n][j] * SA, b = acc[ai][1][m][n][j] * SB; o[n][j] = a * __builtin_amdgcn_rcpf(1.0f + __expf(-a)) * b; }
                *(f32x2*)(H1 + (size_t)(row0 + ai * HALF + m * 16) * D_EXP + col0) = (f32x2){__uint_as_float(pk8(o[0][0], o[0][1], o[0][2], o[0][3])), __uint_as_float(pk8(o[1][0], o[1][1], o[1][2], o[1][3]))}; }
    }
};
struct EpiScale {
    static constexpr bool PERM = true, AFTER_DRAIN = false;
    bf16_t* O; int ldc; float scale; int pn_mod;
    __device__ __forceinline__ void operator()(const f32x4 (&acc)[2][2][4][2], const Unit& u, int wr, int wc, int fr, int fq) const {
        const int row0 = u.pm * BM + wr * 64 + fr; const int col0 = (u.pn % pn_mod) * BM + wc * 32 + 8 * fq;
        const __amdgpu_buffer_rsrc_t rs_ = wt_rsrc(O);
#pragma unroll
        PG8_EPI_LOOP { st_wt16(rs_, (unsigned)((row0 + ai * HALF + m * 16) * ldc + col0 + bj * HALF) * 2u, pack8(acc[ai][bj][m][0] * scale, acc[ai][bj][m][1] * scale)); }
    }
};
struct EpiInE {
    static constexpr bool PERM = true, AFTER_DRAIN = false;
    bf16_t* P; const float* bias; const float* rope;
    __device__ __forceinline__ void operator()(const f32x4 (&acc)[2][2][4][2], const Unit& u, int wr, int wc, int fr, int fq) const {
        const int row0 = u.pm * BM + wr * 64 + fr; const int col0 = u.pn * BM + wc * 32 + 8 * fq; const bool latent = u.pm * BM < TL;
#pragma unroll
        for (int bj = 0; bj < 2; ++bj) {
            const int c0 = col0 + bj * HALF; const f32x4 b0 = *(const f32x4*)(bias + c0), b1 = *(const f32x4*)(bias + c0 + 4);
            const bool roped = c0 >= EC_Q && c0 < EC_V; const float sc = (c0 >= EC_Q && c0 < EC_K) ? SWA_QSCALE : 1.0f;
            const int part = ((c0 - EC_Q) >> 5) & 1; const int i0 = 8 * (fq & 1);
#pragma unroll
            for (int ai = 0; ai < 2; ++ai)
#pragma unroll
                for (int m = 0; m < 4; ++m) {
                    const int row = row0 + ai * HALF + m * 16; f32x4 v0 = acc[ai][bj][m][0] + b0, v1 = acc[ai][bj][m][1] + b1;
                    if (roped) {
                        f32x4 p0, p1;
#pragma unroll
                        for (int j = 0; j < 4; ++j) { p0[j] = __shfl_xor(v0[j], 32); p1[j] = __shfl_xor(v1[j], 32); }
                        if (latent) { const int s = row % SEQ; const int pos = part == 0 ? s / GRID_W : s % GRID_W; const float* t = rope + (size_t)(pos * (SWA_HD / 4) + i0) * 2;
                            const float sg = fq >= 2 ? 1.0f : -1.0f;
#pragma unroll
                            for (int j = 0; j < 4; ++j) { v0[j] = v0[j] * t[2 * j] + sg * p0[j] * t[2 * j + 1]; v1[j] = v1[j] * t[8 + 2 * j] + sg * p1[j] * t[8 + 2 * j + 1]; } }
                        v0 = v0 * sc; v1 = v1 * sc;
                    }
                    st_wt16(wt_rsrc(P), (unsigned)(row * EPLD + c0) * 2u, pack8(v0, v1));
                    asm volatile("" ::: "memory");
                }
        }
    }
};
struct EpiInO {
    static constexpr bool PERM = true, AFTER_DRAIN = false;
    bf16_t* P; const float* bias; const float* rope; float* SSQ; bf16_t* Kb;
    __device__ __forceinline__ void operator()(const f32x4 (&acc)[2][2][4][2], const Unit& u, int wr, int wc, int fr, int fq) const {
        const int row0 = u.pm * BM + wr * 64 + fr; const int col0 = u.pn * BM + wc * 32 + 8 * fq; const bool latent = u.pm * BM < TL;
        f32x4 bv_[2][2];
#pragma unroll
        for (int bj = 0; bj < 2; ++bj) { const int c0 = col0 + bj * HALF; const bool in = c0 < ODD_IN; const int cc = in ? c0 : 0;
            bv_[bj][0] = *(const f32x4*)(bias + cc); bv_[bj][1] = *(const f32x4*)(bias + cc + 4); if (!in) { bv_[bj][0] = (f32x4){0.f, 0.f, 0.f, 0.f}; bv_[bj][1] = (f32x4){0.f, 0.f, 0.f, 0.f}; } }
        asm volatile("" ::: "memory");
#pragma unroll
        for (int ai = 0; ai < 2; ++ai)
#pragma unroll
            for (int m = 0; m < 4; ++m) {
                const int row = row0 + ai * HALF + m * 16; float ssq[2];
#pragma unroll
                for (int bj = 0; bj < 2; ++bj) {
                    const int c0 = col0 + bj * HALF; f32x4 v0 = acc[ai][bj][m][0], v1 = acc[ai][bj][m][1];
                    v0 = v0 + bv_[bj][0]; v1 = v1 + bv_[bj][1];
                    st_wt16(wt_rsrc(P), (unsigned)(row * OPLD + c0) * 2u, pack8(v0, v1));
                    float s = 0.f;
#pragma unroll
                    for (int j = 0; j < 4; ++j) { const float a = bfr(v0[j]), b = bfr(v1[j]); s += a * a + b * b; }
                    ssq[bj] = s;
                    if (u.pn == 1 && bj == 1 && wc == 0) {
                        f32x4 p0, p1;
#pragma unroll
                        for (int j = 0; j < 4; ++j) { p0[j] = __shfl_xor(v0[j], 16); p1[j] = __shfl_xor(v1[j], 16); }
                        if (latent) { const int s2 = row % SEQ; const int pos = (fq >> 1) == 0 ? s2 / GRID_W : s2 % GRID_W; const float* t = rope + (size_t)(pos * (MLA_ROPE / 4)) * 2;
                            const float sg = (fq & 1) ? 1.0f : -1.0f;
#pragma unroll
                            for (int j = 0; j < 4; ++j) { v0[j] = v0[j] * t[2 * j] + sg * p0[j] * t[2 * j + 1]; v1[j] = v1[j] * t[8 + 2 * j] + sg * p1[j] * t[8 + 2 * j + 1]; } }
                        const u32x4 w = pack8(v0, v1);
#pragma unroll
                        for (int h = 0; h < MLA_H; ++h) *(u32x4*)(Kb + (size_t)row * MLA_H * MLA_QD + h * MLA_QD + MLA_NOPE + 8 * fq) = w;
                    }
                }
                if (u.pn == 0) { float s = ssq[0] + ssq[1]; s += __shfl_xor(s, 16); s += __shfl_xor(s, 32); if (fq == 0) SSQ[(size_t)row * 8 + wc] = s; }
                if (u.pn == 1) { float s = ssq[0]; s += __shfl_xor(s, 16); s += __shfl_xor(s, 32); if (fq == 0) SSQ[(size_t)row * 8 + 4 + wc] = s; }
                asm volatile("" ::: "memory");
            }
    }
};
struct EpiUq {
    static constexpr bool PERM = true, AFTER_DRAIN = false;
    bf16_t* Q; const float* rope; const float* SSQ;
    __device__ __forceinline__ void operator()(const f32x4 (&acc)[2][2][4][2], const Unit& u, int wr, int wc, int fr, int fq) const {
        { int t_ = threadIdx.x; asm volatile("" : "+v"(t_)); const int w_ = t_ >> 6, l_ = t_ & 63; wr = w_ >> 2; wc = w_ & 3; fr = l_ & 15; fq = l_ >> 4; }
        typedef unsigned u32x2 __attribute__((ext_vector_type(2)));
        const int row0 = u.pm * BM + wr * 64 + fr; const int col0 = u.pn * BM + wc * 32 + 8 * fq; const float sg = (fq & 1) ? 1.0f : -1.0f;
#pragma unroll
        for (int ai = 0; ai < 2; ++ai) {
            f32x4 ssq_[4];
#pragma unroll
            for (int m = 0; m < 4; ++m) ssq_[m] = *(const f32x4*)(SSQ + (size_t)(row0 + ai * HALF + m * 16) * 8);
            asm volatile("" ::: "memory");
            float rs_[4];
#pragma unroll
            for (int m = 0; m < 4; ++m) rs_[m] = 1.0f / sqrtf(((ssq_[m][0] + ssq_[m][1]) + (ssq_[m][2] + ssq_[m][3])) / (float)MLA_QR + LN_EPS);
#pragma unroll
            for (int m = 0; m < 4; ++m) {
                const int row = row0 + ai * HALF + m * 16; const float rs = rs_[m];
                const int s2 = row % SEQ; const int pos = (fq >> 1) == 0 ? s2 / GRID_W : s2 % GRID_W; const float* t = rope + (size_t)(pos * (MLA_ROPE / 4)) * 2;
#pragma unroll
                for (int bj = 0; bj < 2; ++bj) {
                    const int c0 = col0 + bj * HALF; const bool pe = ((c0 >> 5) % 3) == 2;
#pragma unroll
                    for (int n = 0; n < 2; ++n) {
                        f32x4 v = acc[ai][bj][m][n] * rs;
                        if (pe) { f32x4 q;
#pragma unroll
                            for (int j = 0; j < 4; ++j) q[j] = __shfl_xor(v[j], 16);
#pragma unroll
                            for (int j = 0; j < 4; ++j) v[j] = v[j] * t[8 * n + 2 * j] + sg * q[j] * t[8 * n + 2 * j + 1]; }
                        v = v * MLA_QSCALE; u32x2 w; w.x = cvt_pk_bf16(v[0], v[1]); w.y = cvt_pk_bf16(v[2], v[3]);
                        *(u32x2*)(Q + (size_t)row * MLA_H * MLA_QD + c0 + 4 * n) = w;
                    }
                }
                asm volatile("" ::: "memory");
            }
        }
    }
};
struct EpiUkv {
    static constexpr bool PERM = true, AFTER_DRAIN = false;
    bf16_t* Kb; bf16_t* V; const float* SSQ;
    __device__ __forceinline__ void operator()(const f32x4 (&acc)[2][2][4][2], const Unit& u, int wr, int wc, int fr, int fq) const {
        { int t_ = threadIdx.x; asm volatile("" : "+v"(t_)); const int w_ = t_ >> 6, l_ = t_ & 63; wr = w_ >> 2; wc = w_ & 3; fr = l_ & 15; fq = l_ >> 4; }
        const int row0 = u.pm * BM + wr * 64 + fr; const int col0 = u.pn * BM + wc * 32 + 8 * fq;
#pragma unroll
        for (int ai = 0; ai < 2; ++ai) {
            f32x4 ssq_[4];
#pragma unroll
            for (int m = 0; m < 4; ++m) ssq_[m] = *(const f32x4*)(SSQ + (size_t)(row0 + ai * HALF + m * 16) * 8 + 4);
            asm volatile("" ::: "memory");
            float rs_[4];
#pragma unroll
            for (int m = 0; m < 4; ++m) rs_[m] = 1.0f / sqrtf(((ssq_[m][0] + ssq_[m][1]) + (ssq_[m][2] + ssq_[m][3])) / (float)MLA_KVR + LN_EPS);
#pragma unroll
            for (int m = 0; m < 4; ++m) {
                const int row = row0 + ai * HALF + m * 16; const float rs = rs_[m];
#pragma unroll
                for (int bj = 0; bj < 2; ++bj) {
                    const int c0 = col0 + bj * HALF; const u32x4 w = pack8(acc[ai][bj][m][0] * rs, acc[ai][bj][m][1] * rs);
                    if (c0 < MLA_H * MLA_NOPE) *(u32x4*)(Kb + (size_t)row * MLA_H * MLA_QD + (c0 / MLA_NOPE) * MLA_QD + c0 % MLA_NOPE) = w;
                    else *(u32x4*)(V + (size_t)row * MLA_H * MLA_V + (c0 - MLA_H * MLA_NOPE)) = w;
                }
                asm volatile("" ::: "memory");
            }
        }
    }
};
struct MoeOrder {
    static constexpr int TABC = N_EXP + 4;
    PG8_LAS const int* tab; const int* slot_tok; int nN, G, v; mutable int s0_, c0_;
    __device__ __forceinline__ void init(const int* cnt_, int nN_, int G_, int c_, PG8_LAS int* tab_, const int* slot_tok_ = nullptr) {
        static_assert(N_EXP <= 64, "one wave scans the tile counts");
        tab = tab_; slot_tok = slot_tok_; nN = nN_; G = G_; v = (G_ % NXCD == 0) ? (c_ % NXCD) * (G_ / NXCD) + c_ / NXCD : c_;
        __syncthreads();
        const int t = threadIdx.x;
        if (t < 64) { const int c = t < N_EXP ? cnt_[t * CS] : 0; int incl = (c + BM - 1) / BM;
#pragma unroll
            for (int d = 1; d < 64; d <<= 1) { const int y = __shfl_up(incl, d, 64); if (t >= d) incl += y; }
            if (t < N_EXP) { tab_[t + 1] = incl; tab_[TABC + t] = c; } if (t == 0) tab_[0] = 0; }
        __syncthreads();
    }
    __device__ __forceinline__ bool next(int i, Unit& u) const {
        const int L = i * G + v; const int rt = L / nN, ct = L % nN;
        if (rt >= __builtin_amdgcn_readfirstlane(tab[N_EXP])) return false;
        int lo = 0, hi = N_EXP;
#pragma unroll
        for (int st = 0; st < 6; ++st) { if (hi - lo > 1) { const int mid = (lo + hi) >> 1; if (rt >= __builtin_amdgcn_readfirstlane(tab[mid])) lo = mid; else hi = mid; } }
        u.pm = rt; u.pn = lo * nN + ct; s0_ = __builtin_amdgcn_readfirstlane(tab[lo]); c0_ = __builtin_amdgcn_readfirstlane(tab[TABC + lo]); return true;
    }
    __device__ __forceinline__ int a_row(const Unit& u, int r) const { int pos = (u.pm - s0_) * BM + r; pos = pos < c0_ ? pos : c0_ - 1; return slot_tok[(size_t)(u.pn / nN) * TT + pos]; }
    __device__ __forceinline__ void a_ready(const Unit&) const {}
    __device__ __forceinline__ void done(const Unit&) const {}
};
}
#endif


#ifndef CPU_SIM
namespace fa {
using bf16x8 = __attribute__((ext_vector_type(8))) short;
using s16x4  = __attribute__((ext_vector_type(4))) short;
using f32x16 = __attribute__((ext_vector_type(16))) float;
using u32x4  = __attribute__((ext_vector_type(4))) unsigned;
constexpr int NW = 8, QBLK = 32, KVBLK = 64, DV = 64;
constexpr int SHM_K = KVBLK * 256, SHM_V = KVBLK * DV * 2;
constexpr int NRING = 4;
constexpr int LDS_V = 0, LDS_K = NRING * SHM_V, LDS_WS = LDS_K + NRING * SHM_K, LDS_TOTAL = LDS_WS + NW * 64 * 4;
static_assert(LDS_TOTAL <= 147456, "attention LDS map");
constexpr float THR2 = 8.0f;
#define FA_KSWZ(row, colB) ((row) * 256 + ((colB) ^ (((row) & 15) << 4)))
#define FA_SBAR() __builtin_amdgcn_sched_barrier(0)
__device__ __forceinline__ int crow(int r, int hi) { return (r & 3) + 8 * (r >> 2) + 4 * hi; }
__device__ __forceinline__ unsigned cvtpk(float lo, float hi) { unsigned r; asm volatile("v_cvt_pk_bf16_f32 %0, %1, %2" : "=v"(r) : "v"(lo), "v"(hi)); return r; }
__device__ __forceinline__ void partialSM(f32x16& p0, f32x16& p1, float& m_reg, float& alpha) {
  float pmax = p0[0];
#pragma unroll
  for (int r = 1; r < 16; ++r) pmax = fmaxf(pmax, p0[r]);
#pragma unroll
  for (int r = 0; r < 16; ++r) pmax = fmaxf(pmax, p1[r]);
  { auto rr = __builtin_amdgcn_permlane32_swap(__float_as_uint(pmax), __float_as_uint(pmax), false, false); pmax = fmaxf(__uint_as_float(rr[0]), __uint_as_float(rr[1])); }
  float mn;
  if (__builtin_expect(__all(pmax - m_reg <= THR2), 1)) { mn = m_reg; alpha = 1.f; }
  else { mn = fmaxf(m_reg, pmax); alpha = __builtin_amdgcn_exp2f(m_reg - mn); m_reg = mn; }
#pragma unroll
  for (int r = 0; r < 16; ++r) p0[r] -= mn;
#pragma unroll
  for (int r = 0; r < 16; ++r) p1[r] -= mn;
#pragma unroll
  for (int r = 0; r < 16; ++r) p0[r] = __builtin_amdgcn_exp2f(p0[r]);
}
__device__ __forceinline__ void finishSM(f32x16& p0, f32x16& p1, float alpha, float& l_reg, bf16x8& pa0, bf16x8& pa1, bf16x8& pa2, bf16x8& pa3) {
#pragma unroll
  for (int r = 0; r < 16; ++r) p1[r] = __builtin_amdgcn_exp2f(p1[r]);
  float ps = 0;
#pragma unroll
  for (int r = 0; r < 16; ++r) ps += p0[r];
#pragma unroll
  for (int r = 0; r < 16; ++r) ps += p1[r];
  { auto rr = __builtin_amdgcn_permlane32_swap(__float_as_uint(ps), __float_as_uint(ps), false, false); ps = __uint_as_float(rr[0]) + __uint_as_float(rr[1]); }
  l_reg = l_reg * alpha + ps;
#define FA_PK4(P, BASE, OUT) do { unsigned a0 = cvtpk(P[BASE + 0], P[BASE + 1]), a1 = cvtpk(P[BASE + 2], P[BASE + 3]);   \
    unsigned b0 = cvtpk(P[BASE + 4], P[BASE + 5]), b1 = cvtpk(P[BASE + 6], P[BASE + 7]);                              \
    auto r0 = __builtin_amdgcn_permlane32_swap(a0, b0, false, false); auto r1 = __builtin_amdgcn_permlane32_swap(a1, b1, false, false); \
    u32x4 w = {r0[0], r1[0], r0[1], r1[1]}; OUT = *reinterpret_cast<bf16x8*>(&w); } while (0)
  FA_PK4(p0, 0, pa0); FA_PK4(p0, 8, pa1); FA_PK4(p1, 0, pa2); FA_PK4(p1, 8, pa3);
#undef FA_PK4
}
__device__ __forceinline__ void finishSM_probe(f32x16& p0, f32x16& p1, float& l_reg, bf16x8& pa0, bf16x8& pa1, bf16x8& pa2, bf16x8& pa3) {
  l_reg += p0[0] + p1[0];
#define FA_PK4(P, BASE, OUT) do { unsigned a0 = cvtpk(P[BASE + 0], P[BASE + 1]), a1 = cvtpk(P[BASE + 2], P[BASE + 3]);   \
    unsigned b0 = cvtpk(P[BASE + 4], P[BASE + 5]), b1 = cvtpk(P[BASE + 6], P[BASE + 7]);                              \
    auto r0 = __builtin_amdgcn_permlane32_swap(a0, b0, false, false); auto r1 = __builtin_amdgcn_permlane32_swap(a1, b1, false, false); \
    u32x4 w = {r0[0], r1[0], r0[1], r1[1]}; OUT = *reinterpret_cast<bf16x8*>(&w); } while (0)
  FA_PK4(p0, 0, pa0); FA_PK4(p0, 8, pa1); FA_PK4(p1, 0, pa2); FA_PK4(p1, 8, pa3);
#undef FA_PK4
}
template <int DQK> __device__ __forceinline__ void qkt(f32x16& p0, f32x16& p1, const FLAS char* Ks, const bf16x8* qr, int r32, int hi) {
  p0 = f32x16{}; p1 = f32x16{};
#pragma unroll
  for (int d0 = 0; d0 < DQK / 16; ++d0) { const int cb = (d0 * 16 + hi * 8) * 2;
    const bf16x8 b0 = *(const FLAS bf16x8*)(Ks + FA_KSWZ(r32, cb));
    const bf16x8 b1 = *(const FLAS bf16x8*)(Ks + FA_KSWZ(32 + r32, cb));
    p0 = __builtin_amdgcn_mfma_f32_32x32x16_bf16(b0, qr[d0], p0, 0, 0, 0);
    p1 = __builtin_amdgcn_mfma_f32_32x32x16_bf16(b1, qr[d0], p1, 0, 0, 0); }
}
__device__ __forceinline__ int v_st(int k, int c) { const int kk = (k & ~0xC) | ((k & 4) << 1) | ((k & 8) >> 1); return ((kk >> 3) * 2 + (c >> 5)) * 512 + ((kk & 7) * 32 + (c & 31)) * 2; }
__device__ __forceinline__ int v_rd_base(int lane) { return ((lane & 3) << 3) | (((lane >> 2) & 3) << 6) | (((lane >> 4) & 1) << 5) | (((lane >> 5) & 1) << 8); }
constexpr int v_rd_off(int d0, int ks, int half) { return d0 * 512 + ks * 2048 + half * 1024; }
template <int OFF> __device__ __forceinline__ s16x4 tr_read(int vb) { s16x4 r; asm volatile("ds_read_b64_tr_b16 %0, %1 offset:%2" : "=&v"(r) : "v"(vb), "i"(OFF) : "memory"); return r; }
template <int D0> __device__ __forceinline__ void pv_one(f32x16& od, int vb, bf16x8 pa0, bf16x8 pa1, bf16x8 pa2, bf16x8 pa3) {
  const s16x4 l0 = tr_read<v_rd_off(D0, 0, 0)>(vb), h0 = tr_read<v_rd_off(D0, 0, 1)>(vb), l1 = tr_read<v_rd_off(D0, 1, 0)>(vb), h1 = tr_read<v_rd_off(D0, 1, 1)>(vb);
  const s16x4 l2 = tr_read<v_rd_off(D0, 2, 0)>(vb), h2 = tr_read<v_rd_off(D0, 2, 1)>(vb), l3 = tr_read<v_rd_off(D0, 3, 0)>(vb), h3 = tr_read<v_rd_off(D0, 3, 1)>(vb);
  asm volatile("s_waitcnt lgkmcnt(0)" ::: "memory"); FA_SBAR();
#define FA_PK(L, H) (bf16x8){L[0], L[1], L[2], L[3], H[0], H[1], H[2], H[3]}
  od = __builtin_amdgcn_mfma_f32_32x32x16_bf16(pa0, FA_PK(l0, h0), od, 0, 0, 0);
  od = __builtin_amdgcn_mfma_f32_32x32x16_bf16(pa1, FA_PK(l1, h1), od, 0, 0, 0);
  od = __builtin_amdgcn_mfma_f32_32x32x16_bf16(pa2, FA_PK(l2, h2), od, 0, 0, 0);
  od = __builtin_amdgcn_mfma_f32_32x32x16_bf16(pa3, FA_PK(l3, h3), od, 0, 0, 0);
#undef FA_PK
}
__device__ __forceinline__ void pv_all(f32x16* o, int vb, bf16x8 pa0, bf16x8 pa1, bf16x8 pa2, bf16x8 pa3) { pv_one<0>(o[0], vb, pa0, pa1, pa2, pa3); pv_one<1>(o[1], vb, pa0, pa1, pa2, pa3); }
struct VFrag { s16x4 f[16]; };
__device__ __forceinline__ void pv_reads(VFrag& v, int vb) {
  v.f[0] = tr_read<v_rd_off(0, 0, 0)>(vb); v.f[1] = tr_read<v_rd_off(0, 0, 1)>(vb); v.f[2] = tr_read<v_rd_off(0, 1, 0)>(vb); v.f[3] = tr_read<v_rd_off(0, 1, 1)>(vb);
  v.f[4] = tr_read<v_rd_off(0, 2, 0)>(vb); v.f[5] = tr_read<v_rd_off(0, 2, 1)>(vb); v.f[6] = tr_read<v_rd_off(0, 3, 0)>(vb); v.f[7] = tr_read<v_rd_off(0, 3, 1)>(vb);
  v.f[8] = tr_read<v_rd_off(1, 0, 0)>(vb); v.f[9] = tr_read<v_rd_off(1, 0, 1)>(vb); v.f[10] = tr_read<v_rd_off(1, 1, 0)>(vb); v.f[11] = tr_read<v_rd_off(1, 1, 1)>(vb);
  v.f[12] = tr_read<v_rd_off(1, 2, 0)>(vb); v.f[13] = tr_read<v_rd_off(1, 2, 1)>(vb); v.f[14] = tr_read<v_rd_off(1, 3, 0)>(vb); v.f[15] = tr_read<v_rd_off(1, 3, 1)>(vb);
}
__device__ __forceinline__ void pv_mfmas(f32x16* o, const VFrag& v, bf16x8 pa0, bf16x8 pa1, bf16x8 pa2, bf16x8 pa3) {
  asm volatile("s_waitcnt lgkmcnt(0)" ::: "memory"); FA_SBAR();
#define FA_PK(L, H) (bf16x8){L[0], L[1], L[2], L[3], H[0], H[1], H[2], H[3]}
  o[0] = __builtin_amdgcn_mfma_f32_32x32x16_bf16(pa0, FA_PK(v.f[0], v.f[1]), o[0], 0, 0, 0); o[1] = __builtin_amdgcn_mfma_f32_32x32x16_bf16(pa0, FA_PK(v.f[8], v.f[9]), o[1], 0, 0, 0);
  o[0] = __builtin_amdgcn_mfma_f32_32x32x16_bf16(pa1, FA_PK(v.f[2], v.f[3]), o[0], 0, 0, 0); o[1] = __builtin_amdgcn_mfma_f32_32x32x16_bf16(pa1, FA_PK(v.f[10], v.f[11]), o[1], 0, 0, 0);
  o[0] = __builtin_amdgcn_mfma_f32_32x32x16_bf16(pa2, FA_PK(v.f[4], v.f[5]), o[0], 0, 0, 0); o[1] = __builtin_amdgcn_mfma_f32_32x32x16_bf16(pa2, FA_PK(v.f[12], v.f[13]), o[1], 0, 0, 0);
  o[0] = __builtin_amdgcn_mfma_f32_32x32x16_bf16(pa3, FA_PK(v.f[6], v.f[7]), o[0], 0, 0, 0); o[1] = __builtin_amdgcn_mfma_f32_32x32x16_bf16(pa3, FA_PK(v.f[14], v.f[15]), o[1], 0, 0, 0);
#undef FA_PK
}

struct AllTiles { __device__ __forceinline__ bool operator()(int, int) const { return true; } };
template <int DQK, class RowOf, class Mask, int VAR = 0, class Act = AllTiles>
__device__ __forceinline__ void attn_unit(const bf16_t* Qb, int ldq, const bf16_t* Kbase, int ldk, const bf16_t* Vbase, int ldv, bf16_t* Ob, int ldo, int NT, const RowOf& rowof, const Mask& mask, float m0, float l0, FLAS char* lds, const Act& act = Act{}) {
  int tid = threadIdx.x; asm volatile("" : "+v"(tid));
  const int wid = tid >> 6, lane = tid & 63, r32 = lane & 31, hi = lane >> 5; const int swid = __builtin_amdgcn_readfirstlane(wid);
  FLAS char* V_lds = lds + LDS_V; FLAS char* K_lds = lds + LDS_K;
  FLAS float* ws = (FLAS float*)(lds + LDS_WS) + wid * 64; FLAS float* li_l = ws; FLAS float* al_l = ws + 32;
  float m_reg = m0, l_reg = l0; f32x16 o[2] = {}; bf16x8 qr[DQK / 16];
  const bf16_t* Qw = Qb + (long)(wid * QBLK + r32) * ldq + hi * 8;
#pragma unroll
  for (int d0 = 0; d0 < DQK / 16; ++d0) qr[d0] = *reinterpret_cast<const bf16x8*>(Qw + d0 * 16);
  constexpr int NCH = DQK / 8;
  unsigned kof[2], vof;
#pragma unroll
  for (int i = 0; i < 2; ++i) { const int r = 8 * wid + 4 * i + (lane >> 4); int c = (lane & 15) ^ (r & 15); if (c >= NCH) c &= 7; kof[i] = (unsigned)(r * ldk * 2 + c * 16); }
  { const int o = lane * 16, kk = 8 * wid + ((o & 511) >> 6), c = 32 * (o >> 9) + ((o & 63) >> 1); const int k = (kk & ~0xC) | ((kk & 4) << 1) | ((kk & 8) >> 1); vof = (unsigned)(k * ldv * 2 + c * 2); }
  const int vb0 = (int)(uintptr_t)V_lds + v_rd_base(lane);
  const int qrow = wid * QBLK + r32;
#define FA_DMA(t, b) do { const long row0_ = rowof(t); const char* kb_ = (const char*)(Kbase + row0_ * ldk); const char* vb_ = (const char*)(Vbase + row0_ * ldv); \
    __builtin_amdgcn_global_load_lds((const unsigned*)(kb_ + kof[0]), (FLAS unsigned*)(K_lds + (b) * SHM_K + swid * 2048), 16, 0, 0); \
    __builtin_amdgcn_global_load_lds((const unsigned*)(kb_ + kof[1]), (FLAS unsigned*)(K_lds + (b) * SHM_K + swid * 2048 + 1024), 16, 0, 0); \
    __builtin_amdgcn_global_load_lds((const unsigned*)(vb_ + vof), (FLAS unsigned*)(V_lds + (b) * SHM_V + swid * 1024), 16, 0, 0); } while (0)
#define FA_RESC(a) do { if (__any((a) < 1.f)) { if (hi == 0) al_l[r32] = (a); asm volatile("s_waitcnt lgkmcnt(0)" ::: "memory"); \
    _Pragma("unroll") for (int d = 0; d < 2; ++d) _Pragma("unroll") for (int r = 0; r < 16; ++r) o[d][r] *= al_l[crow(r, hi)]; } } while (0)
  f32x16 pA0, pA1, pB0, pB1; float alA, alB; bf16x8 pa0, pa1, pa2, pa3; VFrag vf;
#define FA_SYNC() do { if constexpr (!(VAR & 1)) { asm volatile("s_waitcnt lgkmcnt(0)" ::: "memory"); __builtin_amdgcn_s_barrier(); asm volatile("" ::: "memory"); } } while (0)
#define FA_QKT(P0, P1, KS) do { if constexpr (VAR & 4) { _Pragma("unroll") for (int r_ = 0; r_ < 16; ++r_) { P0[r_] = m_reg * (float)r_; P1[r_] = l_reg - (float)r_; } } else qkt<DQK>(P0, P1, KS, qr, r32, hi); } while (0)
#define FA_PART(P0, P1, AL) do { if constexpr (VAR & 2) { AL = 1.f; } else partialSM(P0, P1, m_reg, AL); } while (0)
#define FA_FIN(P0, P1, AL) do { if constexpr (VAR & 2) finishSM_probe(P0, P1, l_reg, pa0, pa1, pa2, pa3); else finishSM(P0, P1, AL, l_reg, pa0, pa1, pa2, pa3); } while (0)
#define FA_PV(VB) do { if constexpr (VAR & 4) { _Pragma("unroll") for (int r_ = 0; r_ < 16; ++r_) { o[0][r_] += __builtin_bit_cast(float, (int)pa0[r_ & 7] << 16); o[1][r_] += __builtin_bit_cast(float, (int)pa2[r_ & 7] << 16); } } else pv_all(o, VB, pa0, pa1, pa2, pa3); } while (0)
#define FA_KAHEAD() do { __builtin_amdgcn_sched_group_barrier(0x100, 4, 0); _Pragma("unroll") for (int i_ = 0; i_ < DQK / 16; ++i_) { \
    __builtin_amdgcn_sched_group_barrier(0x008, 2, 0); if (i_ + 2 < DQK / 16) __builtin_amdgcn_sched_group_barrier(0x100, 2, 0); } } while (0)
#define FA_STEP(J, PC0, PC1, ALC, PP0, PP1, ALP, RK, RV, RW) do { const int j_ = (J); const bool ac_ = act(j_, swid), ap_ = act(j_ - 1, swid); \
    if (j_ + 2 < NT) FA_DMA(j_ + 2, RW); \
    if (ap_) pv_reads(vf, vb0 + (RV) * SHM_V); \
    FA_SBAR(); if (ac_) { FA_QKT(PC0, PC1, K_lds + (RK) * SHM_K); mask(PC0, PC1, j_, qrow, hi); } \
    if (ap_) FA_FIN(PP0, PP1, ALP); if (ac_ && ap_) FA_KAHEAD(); FA_SBAR(); \
    if (ap_) pv_mfmas(o, vf, pa0, pa1, pa2, pa3); if (ac_) FA_PART(PC0, PC1, ALC); else ALC = 1.f; \
    FA_RESC(ALC); \
    if (j_ + 2 < NT) asm volatile("s_waitcnt vmcnt(3)" ::: "memory"); else asm volatile("s_waitcnt vmcnt(0)" ::: "memory"); \
    FA_SYNC(); } while (0)
  FA_DMA(0, 0); FA_DMA(1, 1); asm volatile("s_waitcnt vmcnt(0)" ::: "memory"); FA_SYNC();
  FA_DMA(2, 2);
  if (act(0, swid)) { qkt<DQK>(pA0, pA1, K_lds, qr, r32, hi); mask(pA0, pA1, 0, qrow, hi); partialSM(pA0, pA1, m_reg, alA); } else alA = 1.f;
  int j = 1;
  for (; j + 3 < NT; j += 4) {
    FA_STEP(j,     pB0, pB1, alB, pA0, pA1, alA, 1, 0, 3);
    FA_STEP(j + 1, pA0, pA1, alA, pB0, pB1, alB, 2, 1, 0);
    FA_STEP(j + 2, pB0, pB1, alB, pA0, pA1, alA, 3, 2, 1);
    FA_STEP(j + 3, pA0, pA1, alA, pB0, pB1, alB, 0, 3, 2);
  }
  FA_STEP(j,     pB0, pB1, alB, pA0, pA1, alA, 1, 0, 3);
  FA_STEP(j + 1, pA0, pA1, alA, pB0, pB1, alB, 2, 1, 0);
  FA_STEP(j + 2, pB0, pB1, alB, pA0, pA1, alA, 3, 2, 1);
  if (act(NT - 1, swid)) { FA_FIN(pB0, pB1, alB); FA_SBAR(); FA_PV(vb0 + 3 * SHM_V); }
#undef FA_STEP
#undef FA_KAHEAD
  if (hi == 0) li_l[r32] = l_reg; asm volatile("s_waitcnt lgkmcnt(0)" ::: "memory");
  float rli[16];
#pragma unroll
  for (int r = 0; r < 16; ++r) rli[r] = __builtin_amdgcn_rcpf(li_l[crow(r, hi)]);
  bf16_t* Ow = Ob + (long)(wid * QBLK) * ldo;
#pragma unroll
  for (int r = 0; r < 16; ++r) { const int orow = crow(r, hi);
#pragma unroll
    for (int d0 = 0; d0 < 2; ++d0) Ow[(long)orow * ldo + d0 * 32 + r32] = (bf16_t)cvtpk(o[d0][r] * rli[r], 0.f); }
  __syncthreads();
#undef FA_DMA
#undef FA_RESC
#undef FA_SYNC
#undef FA_QKT
#undef FA_PART
#undef FA_FIN
#undef FA_PV
}
struct NoMask { __device__ __forceinline__ void operator()(f32x16&, f32x16&, int, int, int) const {} };
}
#endif


#ifndef CPU_SIM
struct XcdBarrier;
__device__ __forceinline__ void xcd_barrier(const XcdBarrier& b);
namespace fast {
typedef float f32x4 __attribute__((ext_vector_type(4)));
typedef unsigned u32x2 __attribute__((ext_vector_type(2)));
typedef unsigned u32x4 __attribute__((ext_vector_type(4)));
__device__ __forceinline__ float wave_sum(float v) {
    v += __builtin_bit_cast(float, __builtin_amdgcn_update_dpp(0, __builtin_bit_cast(int, v), 0xB1, 0xF, 0xF, false));
    v += __builtin_bit_cast(float, __builtin_amdgcn_update_dpp(0, __builtin_bit_cast(int, v), 0x4E, 0xF, 0xF, false));
    v += __builtin_bit_cast(float, __builtin_amdgcn_update_dpp(0, __builtin_bit_cast(int, v), 0x141, 0xF, 0xF, false));
    v += __builtin_bit_cast(float, __builtin_amdgcn_update_dpp(0, __builtin_bit_cast(int, v), 0x140, 0xF, 0xF, false));
    v += __builtin_bit_cast(float, __builtin_amdgcn_update_dpp(0, __builtin_bit_cast(int, v), 0x142, 0xA, 0xF, false));
    v += __builtin_bit_cast(float, __builtin_amdgcn_update_dpp(0, __builtin_bit_cast(int, v), 0x143, 0xC, 0xF, false));
    return __builtin_bit_cast(float, __builtin_amdgcn_readlane(__builtin_bit_cast(int, v), 63));
}
__device__ __forceinline__ unsigned pk2(float lo, float hi) { unsigned r; asm("v_cvt_pk_bf16_f32 %0, %1, %2" : "=v"(r) : "v"(lo), "v"(hi)); return r; }
__device__ __forceinline__ bf16_t f2bf_hw(float v) { return (bf16_t)pk2(v, 0.f); }
__device__ __forceinline__ void cvt_item(const float* src, int ld_src, const float* scale, bf16_t* dst, int ldd, int dst_row0, int k0, int n0, FLAS float* scr, int lane) {
#pragma unroll 8
    for (int i = 0; i < 32; ++i) { const int kk = 2 * i + (lane >> 5); float v = src[(size_t)(k0 + kk) * ld_src + n0 + (lane & 31)]; if (scale) v *= scale[k0 + kk]; scr[kk * 33 + (lane & 31)] = v; }
    asm volatile("s_waitcnt lgkmcnt(0)" ::: "memory");
    const int c = lane & 7;
#pragma unroll
    for (int j = 0; j < 4; ++j) { const int n = (lane >> 3) + 8 * j; const FLAS float* s = scr + (8 * c) * 33 + n;
        u32x4 o; o.x = pk2(s[0 * 33], s[1 * 33]); o.y = pk2(s[2 * 33], s[3 * 33]); o.z = pk2(s[4 * 33], s[5 * 33]); o.w = pk2(s[6 * 33], s[7 * 33]);
        *(u32x4*)(dst + (size_t)(dst_row0 + n0 + n) * ldd + k0 + 8 * c) = o; }
    asm volatile("s_waitcnt lgkmcnt(0)" ::: "memory");
}
__device__ __forceinline__ void cvt_item8(const float* src, int ld_src, float mul, unsigned char* dst, int ldd, int dst_row0, int k0, int n0, FLAS float* scr, int lane) {
#pragma unroll 8
    for (int i = 0; i < 32; ++i) { const int kk = 2 * i + (lane >> 5); scr[kk * 33 + (lane & 31)] = src[(size_t)(k0 + kk) * ld_src + n0 + (lane & 31)] * mul; }
    asm volatile("s_waitcnt lgkmcnt(0)" ::: "memory");
    const int c = lane & 3;
#pragma unroll
    for (int j = 0; j < 2; ++j) { const int n = (lane >> 2) + 16 * j; const FLAS float* s = scr + (16 * c) * 33 + n;
        u32x4 o; o.x = pg8::pk8(s[0 * 33], s[1 * 33], s[2 * 33], s[3 * 33]); o.y = pg8::pk8(s[4 * 33], s[5 * 33], s[6 * 33], s[7 * 33]);
        o.z = pg8::pk8(s[8 * 33], s[9 * 33], s[10 * 33], s[11 * 33]); o.w = pg8::pk8(s[12 * 33], s[13 * 33], s[14 * 33], s[15 * 33]);
        *(u32x4*)(dst + (size_t)(dst_row0 + n0 + n) * ldd + k0 + 16 * c) = o; }
    asm volatile("s_waitcnt lgkmcnt(0)" ::: "memory");
}
struct MoeItem { const float* src; unsigned char* dst; int ld_src, ldd, drow, k0, n0; float mul; };
__device__ __forceinline__ void moe_item(const Params& p, int m, MoeItem& it) {
    constexpr int I_W13 = (DM / 64) * (D_EXP / 32), I_W2 = (D_EXP / 64) * (DM / 32), I_EXP = 2 * I_W13 + I_W2;
    const int le = m / I_EXP; int r = m - le * I_EXP;
    if (r < 2 * I_W13) { const int w = r / I_W13; r -= w * I_W13; const int nb = D_EXP / 32, n0 = 32 * (r % nb);
        it.src = (w ? p.moe_w3 : p.moe_w1) + (size_t)le * DM * D_EXP; it.ld_src = D_EXP; it.mul = FP8_SW1; it.dst = (unsigned char*)p.W_up + (size_t)le * 2 * D_EXP * DM; it.ldd = DM;
        it.drow = (n0 / UPG) * UPG + w * UPG + n0; it.k0 = 64 * (r / nb); it.n0 = n0; }
    else { r -= 2 * I_W13; const int nb = DM / 32, n0 = 32 * (r % nb);
        it.src = p.moe_w2 + (size_t)le * D_EXP * DM; it.ld_src = DM; it.mul = FP8_SW2; it.dst = (unsigned char*)p.W_dn + (size_t)le * DM * D_EXP; it.ldd = D_EXP; it.drow = n0; it.k0 = 64 * (r / nb); it.n0 = n0; }
}
__device__ __forceinline__ void moe_item_load(const MoeItem& it, float (&r)[32], int lane) {
    const float* s = it.src + (size_t)(it.k0 + (lane >> 5)) * it.ld_src + it.n0 + (lane & 31);
#pragma unroll
    for (int i = 0; i < 32; ++i) r[i] = s[(size_t)(2 * i) * it.ld_src];
}
__device__ __forceinline__ void moe_item_store(const MoeItem& it, const float (&r)[32], FLAS float* scr, int lane) {
#pragma unroll
    for (int i = 0; i < 32; ++i) scr[(2 * i + (lane >> 5)) * 33 + (lane & 31)] = r[i] * it.mul;
    asm volatile("s_waitcnt lgkmcnt(0)" ::: "memory");
    const int c = lane & 3;
#pragma unroll
    for (int j = 0; j < 2; ++j) { const int n = (lane >> 2) + 16 * j; const FLAS float* s = scr + (16 * c) * 33 + n;
        u32x4 o; o.x = pg8::pk8(s[0 * 33], s[1 * 33], s[2 * 33], s[3 * 33]); o.y = pg8::pk8(s[4 * 33], s[5 * 33], s[6 * 33], s[7 * 33]);
        o.z = pg8::pk8(s[8 * 33], s[9 * 33], s[10 * 33], s[11 * 33]); o.w = pg8::pk8(s[12 * 33], s[13 * 33], s[14 * 33], s[15 * 33]);
        *(u32x4*)(it.dst + (size_t)(it.drow + n) * it.ldd + it.k0 + 16 * c) = o; }
    asm volatile("s_waitcnt lgkmcnt(0)" ::: "memory");
}
__device__ __forceinline__ void moe_stream_range(const Params& p, FLAS float* scr, int lane, int m0, int mend, int stride) {
    float rA[32], rB[32]; MoeItem ia, ib; int m = m0;
    if (m >= mend) return;
    moe_item(p, m, ia); moe_item_load(ia, rA, lane);
    for (;;) {
        const int mb = m + stride; const bool hasB = mb < mend;
        if (hasB) { moe_item(p, mb, ib); moe_item_load(ib, rB, lane); }
        moe_item_store(ia, rA, scr, lane);
        if (!hasB) break;
        const int ma = mb + stride; const bool hasA = ma < mend;
        if (hasA) { moe_item(p, ma, ia); moe_item_load(ia, rA, lane); }
        moe_item_store(ib, rB, scr, lane);
        if (!hasA) break;
        m = ma;
    }
}
constexpr int WS_HEAD = 12;
__device__ __forceinline__ void moe_weights_stream(const Params& p, FLAS unsigned char* lds_raw, int nmod) {
    int t_ = threadIdx.x; asm volatile("" : "+v"(t_)); const int lane = t_ & 63, wave = t_ >> 6; FLAS float* scr = (FLAS float*)lds_raw + wave * (64 * 33);
    constexpr int I_W13 = (DM / 64) * (D_EXP / 32), I_W2 = (D_EXP / 64) * (DM / 32), NM = 2 * N_EXP * (2 * I_W13 + I_W2);
    const int bx = (int)blockIdx.x, G = (int)gridDim.x; const int nfree = G > nmod ? G - nmod : 0; const int head = nfree * 8 * WS_HEAD < NM ? nfree * 8 * WS_HEAD : 0;
    if (head && bx >= nmod) moe_stream_range(p, scr, lane, __builtin_amdgcn_readfirstlane((bx - nmod) * 8 + wave), head, nfree * 8);
    moe_stream_range(p, scr, lane, head + __builtin_amdgcn_readfirstlane(bx * 8 + wave), NM, G * 8);
}
__device__ __forceinline__ void weights_phase(const Params& p, FLAS unsigned char* lds_raw, int part, int wg0) {
    int t_ = threadIdx.x; asm volatile("" : "+v"(t_)); const int lane = t_ & 63, wave = t_ >> 6; FLAS float* scr = (FLAS float*)lds_raw + wave * (64 * 33);
    if ((int)blockIdx.x < wg0) return;
    const int gw = ((int)blockIdx.x - wg0) * 8 + wave, NGW = ((int)gridDim.x - wg0) * 8;
    constexpr int I_EIN = (DM / 64) * (EVEN_IN / 32), I_SQ = (DM / 64) * (DM / 32), I_OIN = (DM / 64) * (ODD_IN / 32), I_UQ = (MLA_QR / 64) * (MLA_H * MLA_QD / 32), I_UK = (MLA_KVR / 64) * (MLA_H * MLA_NOPE / 32);
    constexpr int I_W13 = (DM / 64) * (D_EXP / 32), I_W2 = (D_EXP / 64) * (DM / 32), I_EXP = 2 * I_W13 + I_W2;
    constexpr int NSMALL = I_EIN + 2 * I_SQ + I_OIN + I_UQ + 2 * I_UK, NITEMS = NSMALL + 2 * N_EXP * I_EXP;
    constexpr int NPART0 = NSMALL + N_EXP * I_EXP;
    (void)NITEMS; (void)NPART0;
    for (int it = gw; it < (part ? 0 : NSMALL); it += NGW) {
        int r = it;
        if (r < I_EIN) { const int nb = EVEN_IN / 32; cvt_item(p.e_w_in, EVEN_IN, nullptr, p.W_ein, DM, 0, 64 * (r / nb), 32 * (r % nb), scr, lane); continue; } r -= I_EIN;
        if (r < I_SQ) { const int nb = DM / 32; cvt_item(p.e_w_out, DM, nullptr, p.W_eout, DM, 0, 64 * (r / nb), 32 * (r % nb), scr, lane); continue; } r -= I_SQ;
        if (r < I_SQ) { const int nb = DM / 32; cvt_item(p.o_w_out, DM, nullptr, p.W_oout, DM, 0, 64 * (r / nb), 32 * (r % nb), scr, lane); continue; } r -= I_SQ;
        if (r < I_OIN) { const int nb = ODD_IN / 32; cvt_item(p.o_w_in, ODD_IN, nullptr, p.W_oin, DM, 0, 64 * (r / nb), 32 * (r % nb), scr, lane); continue; } r -= I_OIN;
        if (r < I_UQ) { const int nb = MLA_H * MLA_QD / 32; cvt_item(p.o_w_uq, MLA_H * MLA_QD, p.o_q_norm, p.W_uq, MLA_QR, 0, 64 * (r / nb), 32 * (r % nb), scr, lane); continue; } r -= I_UQ;
        if (r < I_UK) { const int nb = MLA_H * MLA_NOPE / 32; cvt_item(p.o_w_uk, MLA_H * MLA_NOPE, p.o_kv_norm, p.W_ukv, MLA_KVR, 0, 64 * (r / nb), 32 * (r % nb), scr, lane); continue; } r -= I_UK;
        if (r < I_UK) { const int nb = MLA_H * MLA_V / 32; cvt_item(p.o_w_uv, MLA_H * MLA_V, p.o_kv_norm, p.W_ukv, MLA_KVR, MLA_H * MLA_NOPE, 64 * (r / nb), 32 * (r % nb), scr, lane); continue; } r -= I_UK;
        const int le = r / I_EXP; r -= le * I_EXP;
        if (r < 2 * I_W13) { const int w = r / I_W13; r -= w * I_W13; const int nb = D_EXP / 32, n0 = 32 * (r % nb);
            cvt_item8((w ? p.moe_w3 : p.moe_w1) + (size_t)le * DM * D_EXP, D_EXP, FP8_SW1, (unsigned char*)p.W_up + (size_t)le * 2 * D_EXP * DM, DM, (n0 / UPG) * UPG + w * UPG, 64 * (r / nb), n0, scr, lane); continue; }
        r -= 2 * I_W13; { const int nb = DM / 32; cvt_item8(p.moe_w2 + (size_t)le * D_EXP * DM, DM, FP8_SW2, (unsigned char*)p.W_dn + (size_t)le * DM * D_EXP, D_EXP, 0, 64 * (r / nb), 32 * (r % nb), scr, lane); }
    }
    if (part == 0) for (long i = (long)blockIdx.x * 512 + threadIdx.x; i < (long)(OPLD - ODD_IN) * DM / 8; i += (long)gridDim.x * 512) *(u32x4*)(p.W_oin + (size_t)ODD_IN * DM + i * 8) = (u32x4){0u, 0u, 0u, 0u};
}

__device__ __forceinline__ void mod_phase(const Params& p, FLAS unsigned char* lds_raw) {
    FLAS float* sc = (FLAS float*)lds_raw;
    FLAS float* part = sc + (NB + 1) * DM;
    const int tid = threadIdx.x;
    constexpr int NC = 64, NU = 2 * (6 * DM / NC);
    if ((int)blockIdx.x >= NU) return;
    for (int i = tid; i < (NB + 1) * DM; i += 512) { const int cn = i / DM, k = i % DM; const float v = cn < NB ? p.c[cn * DM + k] : p.c_ctx[k]; sc[i] = v / (1.0f + __expf(-v)); }
    __syncthreads();
    for (int u = blockIdx.x; u < NU; u += gridDim.x) {
        const int l = u / (6 * DM / NC), j = (u % (6 * DM / NC)) * NC + (tid & (NC - 1)), kq = tid / NC;
        const float* w = p.w_mod + (size_t)l * DM * 6 * DM + j;
        float acc[NB + 1];
#pragma unroll
        for (int cn = 0; cn <= NB; ++cn) acc[cn] = 0.f;
        for (int k0 = kq * (DM / 8); k0 < (kq + 1) * (DM / 8); k0 += 16) { float wv[16];
#pragma unroll
            for (int i = 0; i < 16; ++i) wv[i] = w[(size_t)(k0 + i) * 6 * DM];
#pragma unroll
            for (int i = 0; i < 16; ++i)
#pragma unroll
                for (int cn = 0; cn <= NB; ++cn) acc[cn] += sc[cn * DM + k0 + i] * wv[i]; }
#pragma unroll
        for (int cn = 0; cn <= NB; ++cn) part[(kq * (NB + 1) + cn) * NC + (tid & (NC - 1))] = acc[cn];
        __syncthreads();
        if (tid < NC) {
#pragma unroll
            for (int cn = 0; cn <= NB; ++cn) { float s = 0.f;
#pragma unroll
                for (int q = 0; q < 8; ++q) s += part[(q * (NB + 1) + cn) * NC + tid];
                p.MOD[((size_t)l * (NB + 1) + cn) * 6 * DM + j] = s + p.b_mod[(size_t)l * 6 * DM + j]; }
        }
        __syncthreads();
    }
}
__device__ __forceinline__ void ld_row_f32(const float* row, int lane, f32x4 (&v)[4]) {
#pragma unroll
    for (int j = 0; j < 4; ++j) v[j] = *(const f32x4*)(row + 256 * j + 4 * lane);
}
__device__ __forceinline__ void ld_row_bf16(const bf16_t* row, int lane, f32x4 (&v)[4]) {
#pragma unroll
    for (int j = 0; j < 4; ++j) { const u32x2 w = *(const u32x2*)(row + 256 * j + 4 * lane); v[j] = (f32x4){__uint_as_float(w.x << 16), __uint_as_float(w.x & 0xffff0000u), __uint_as_float(w.y << 16), __uint_as_float(w.y & 0xffff0000u)}; }
}
__device__ __forceinline__ void st_row_bf16(bf16_t* row, int lane, const f32x4 (&v)[4]) {
#pragma unroll
    for (int j = 0; j < 4; ++j) { u32x2 w; w.x = pk2(v[j][0], v[j][1]); w.y = pk2(v[j][2], v[j][3]); *(u32x2*)(row + 256 * j + 4 * lane) = w; }
}
__device__ __forceinline__ void layer_norm_row(f32x4 (&v)[4], const float* g, const float* b, int lane) {
    float s = 0.f;
#pragma unroll
    for (int j = 0; j < 4; ++j) s += (v[j][0] + v[j][1]) + (v[j][2] + v[j][3]);
    const float mu = wave_sum(s) * (1.0f / DM); float q = 0.f;
#pragma unroll
    for (int j = 0; j < 4; ++j) { v[j] = v[j] - mu; q += (v[j][0] * v[j][0] + v[j][1] * v[j][1]) + (v[j][2] * v[j][2] + v[j][3] * v[j][3]); }
    const float rstd = 1.0f / sqrtf(wave_sum(q) * (1.0f / DM) + LN_EPS);
#pragma unroll
    for (int j = 0; j < 4; ++j) { const f32x4 gg = *(const f32x4*)(g + 256 * j + 4 * lane), bb = *(const f32x4*)(b + 256 * j + 4 * lane); v[j] = v[j] * rstd * gg + bb; }
}
__device__ __forceinline__ void modulate0_phase(const Params& p) {
    int t_ = threadIdx.x; asm volatile("" : "+v"(t_)); const int lane = t_ & 63, gw = blockIdx.x * 8 + (t_ >> 6), NGW = gridDim.x * 8;
    for (int r = gw; r < TT; r += NGW) {
        const float* xin = r < TL ? p.x + (size_t)r * DM : p.ctx + (size_t)(r - TL) * DM; const float* m = p.MOD + (size_t)cond_of_row(r) * 6 * DM;
        f32x4 v[4]; ld_row_f32(xin, lane, v);
#pragma unroll
        for (int j = 0; j < 4; ++j) { const f32x4 sh = *(const f32x4*)(m + 256 * j + 4 * lane), sc = *(const f32x4*)(m + DM + 256 * j + 4 * lane); v[j] = v[j] * (sc + 1.0f) + sh; }
        st_row_bf16(p.ACT + (size_t)r * DM, lane, v);
    }
}
__device__ __forceinline__ void ln1_norm(const Params& p, int l, int r, int lane, f32x4 (&v)[4], const f32x4 (&y)[4]) {
    float* xo = r < TL ? p.out + (size_t)r * DM : p.XC + (size_t)(r - TL) * DM;
    const float* m = p.MOD + ((size_t)l * (NB + 1) + cond_of_row(r)) * 6 * DM;
#pragma unroll
    for (int j = 0; j < 4; ++j) { const f32x4 gt = *(const f32x4*)(m + 2 * DM + 256 * j + 4 * lane); v[j] = v[j] * DN_ALPHA + gt * y[j]; }
    layer_norm_row(v, p.ln_g + (size_t)(l * 2) * DM, p.ln_b + (size_t)(l * 2) * DM, lane);
#pragma unroll
    for (int j = 0; j < 4; ++j) *(f32x4*)(xo + 256 * j + 4 * lane) = v[j];
#pragma unroll
    for (int j = 0; j < 4; ++j) { const f32x4 sh = *(const f32x4*)(m + 3 * DM + 256 * j + 4 * lane), sc = *(const f32x4*)(m + 4 * DM + 256 * j + 4 * lane); v[j] = v[j] * (sc + 1.0f) + sh; }
    { unsigned char* a8 = (unsigned char*)p.ACT + (size_t)r * DM;
#pragma unroll
      for (int j = 0; j < 4; ++j) *(unsigned*)(a8 + 256 * j + 4 * lane) = pg8::pk8(v[j][0] * FP8_SF, v[j][1] * FP8_SF, v[j][2] * FP8_SF, v[j][3] * FP8_SF); }
}
struct RowVecs { f32x4 gt[4], lg[4], lb[4], sh[4], sc[4]; };
__device__ __forceinline__ void ln1_norm_reg(const Params& p, int l, int r, int lane, f32x4 (&v)[4], const f32x4 (&y)[4], const RowVecs& rv) {
    float* xo = r < TL ? p.out + (size_t)r * DM : p.XC + (size_t)(r - TL) * DM;
#pragma unroll
    for (int j = 0; j < 4; ++j) v[j] = v[j] * DN_ALPHA + rv.gt[j] * y[j];
    float s = 0.f;
#pragma unroll
    for (int j = 0; j < 4; ++j) s += (v[j][0] + v[j][1]) + (v[j][2] + v[j][3]);
    const float mu = wave_sum(s) * (1.0f / DM); float q = 0.f;
#pragma unroll
    for (int j = 0; j < 4; ++j) { v[j] = v[j] - mu; q += (v[j][0] * v[j][0] + v[j][1] * v[j][1]) + (v[j][2] * v[j][2] + v[j][3] * v[j][3]); }
    const float rstd = 1.0f / sqrtf(wave_sum(q) * (1.0f / DM) + LN_EPS);
#pragma unroll
    for (int j = 0; j < 4; ++j) v[j] = v[j] * rstd * rv.lg[j] + rv.lb[j];
#pragma unroll
    for (int j = 0; j < 4; ++j) *(f32x4*)(xo + 256 * j + 4 * lane) = v[j];
#pragma unroll
    for (int j = 0; j < 4; ++j) v[j] = v[j] * (rv.sc[j] + 1.0f) + rv.sh[j];
    { unsigned char* a8 = (unsigned char*)p.ACT + (size_t)r * DM;
#pragma unroll
      for (int j = 0; j < 4; ++j) *(unsigned*)(a8 + 256 * j + 4 * lane) = pg8::pk8(v[j][0] * FP8_SF, v[j][1] * FP8_SF, v[j][2] * FP8_SF, v[j][3] * FP8_SF); }
}
__device__ __forceinline__ void route_row(const Params& p, int l, int r, int lane, const float (&lg)[N_GROUPS + N_EXP], FLAS int* lcnt) {
    int gi = 0; float gm = lg[0];
#pragma unroll
    for (int j = 1; j < N_GROUPS; ++j) if (lg[j] > gm) { gm = lg[j]; gi = j; }
    float gs = 0.f;
#pragma unroll
    for (int j = 0; j < N_GROUPS; ++j) gs += expf(lg[j] - gm);
    const float gprob = 1.0f / gs;
    float ev[EPG];
#pragma unroll
    for (int j = 0; j < EPG; ++j) { float e = 0.f;
#pragma unroll
        for (int g2 = 0; g2 < N_GROUPS; ++g2) if (g2 == gi) e = lg[N_GROUPS + g2 * EPG + j];
        ev[j] = e; }
    int i0 = 0; float m0 = ev[0];
#pragma unroll
    for (int j = 1; j < EPG; ++j) if (ev[j] > m0) { m0 = ev[j]; i0 = j; }
    int i1 = -1; float m1 = -3.0e38f;
#pragma unroll
    for (int j = 0; j < EPG; ++j) if (j != i0 && ev[j] > m1) { m1 = ev[j]; i1 = j; }
    const float e1 = expf(m1 - m0), g0 = gprob / (1.0f + e1), g1 = gprob * e1 / (1.0f + e1);
    if (lane == 0) {
        const int ex0 = gi * EPG + i0, ex1 = gi * EPG + i1;
        const int p0 = __hip_atomic_fetch_add(&lcnt[ex0], 1, __ATOMIC_RELAXED, __HIP_MEMORY_SCOPE_WORKGROUP), p1 = __hip_atomic_fetch_add(&lcnt[ex1], 1, __ATOMIC_RELAXED, __HIP_MEMORY_SCOPE_WORKGROUP);
        p.tok_e[2 * r] = ex0; p.tok_e[2 * r + 1] = ex1; p.tok_pos[2 * r] = p0; p.tok_pos[2 * r + 1] = p1; p.tok_gate[2 * r] = g0; p.tok_gate[2 * r + 1] = g1;
    }
}
typedef __attribute__((ext_vector_type(8))) short rt_bf16x8;
typedef __attribute__((ext_vector_type(16))) float rt_f32x16;
__device__ __forceinline__ void ln1_phase(const Params& p, int l, FLAS unsigned char* lds_raw) {
    constexpr int NJ = N_GROUPS + N_EXP, PITCH = DM * 2 + 16;
    constexpr int LDS_AH = 0, LDS_AL = 32 * PITCH, LDS_CP = 0;
    constexpr int CPP = 65;
    static_assert(2 * 32 * PITCH <= 147456 && (8 * 32 * CPP + 32 * (NJ + 1)) * 4 <= 2 * 32 * PITCH, "LN1 LDS map");
    FLAS unsigned char* lds = lds_raw; FLAS int* lcnt = (FLAS int*)(lds_raw + 147456 + 128);
    int tix = threadIdx.x; asm volatile("" : "+v"(tix));
    if (tix < N_EXP) lcnt[tix] = 0;
    const int lane = tix & 63, wave = tix >> 6, r32 = lane & 31, hi = lane >> 5; const int nrows = l == 0 ? TT : TL; const bf16_t* Y = P_of(p);
    const bf16_t* WRH = p.WRH + (size_t)l * 64 * DM; const bf16_t* WRL = p.WRL + (size_t)l * 64 * DM;
    for (int g = blockIdx.x; g < nrows / 32; g += gridDim.x) {
        __syncthreads();
        RowVecs rv;
        { const float* m = p.MOD + ((size_t)l * (NB + 1) + cond_of_row(g * 32)) * 6 * DM; const float* lgp = p.ln_g + (size_t)(l * 2) * DM; const float* lbp = p.ln_b + (size_t)(l * 2) * DM;
#pragma unroll
          for (int j = 0; j < 4; ++j) { const int o = 256 * j + 4 * lane; rv.gt[j] = *(const f32x4*)(m + 2 * DM + o); rv.sh[j] = *(const f32x4*)(m + 3 * DM + o); rv.sc[j] = *(const f32x4*)(m + 4 * DM + o);
              rv.lg[j] = *(const f32x4*)(lgp + o); rv.lb[j] = *(const f32x4*)(lbp + o); } }
#pragma unroll
        for (int i = 0; i < 4; i += 2) {
            const int ra = g * 32 + wave * 4 + i, rb = ra + 1;
            const float* xa = l == 0 ? (ra < TL ? p.x + (size_t)ra * DM : p.ctx + (size_t)(ra - TL) * DM) : p.out + (size_t)ra * DM;
            const float* xb = l == 0 ? (rb < TL ? p.x + (size_t)rb * DM : p.ctx + (size_t)(rb - TL) * DM) : p.out + (size_t)rb * DM;
            f32x4 va[4], ya[4], vb[4], yb[4];
            ld_row_f32(xa, lane, va); ld_row_bf16(Y + (size_t)ra * DM, lane, ya); ld_row_f32(xb, lane, vb); ld_row_bf16(Y + (size_t)rb * DM, lane, yb);
            asm volatile("" ::: "memory");
            ln1_norm_reg(p, l, ra, lane, va, ya, rv); ln1_norm_reg(p, l, rb, lane, vb, yb, rv);
#pragma unroll
            for (int q = 0; q < 2; ++q) { const f32x4 (&v)[4] = q ? vb : va; const int rl = wave * 4 + i + q;
#pragma unroll
                for (int j = 0; j < 4; ++j) { const unsigned h0 = pk2(v[j][0], v[j][1]), h1 = pk2(v[j][2], v[j][3]);
                    const unsigned l0 = pk2(v[j][0] - __uint_as_float(h0 << 16), v[j][1] - __uint_as_float(h0 & 0xffff0000u)), l1 = pk2(v[j][2] - __uint_as_float(h1 << 16), v[j][3] - __uint_as_float(h1 & 0xffff0000u));
                    *(FLAS u32x2*)(lds + LDS_AH + rl * PITCH + (256 * j + 4 * lane) * 2) = (u32x2){h0, h1}; *(FLAS u32x2*)(lds + LDS_AL + rl * PITCH + (256 * j + 4 * lane) * 2) = (u32x2){l0, l1}; } }
        }
        __syncthreads();
        rt_bf16x8 BH0[8], BH1[8], BL0[8], BL1[8];
#pragma unroll
        for (int s2 = 0; s2 < 8; ++s2) { const int k0 = wave * 128 + s2 * 16 + 8 * hi;
            BH0[s2] = *(const rt_bf16x8*)(WRH + (size_t)r32 * DM + k0); BH1[s2] = *(const rt_bf16x8*)(WRH + (size_t)(32 + r32) * DM + k0);
            BL0[s2] = *(const rt_bf16x8*)(WRL + (size_t)r32 * DM + k0); BL1[s2] = *(const rt_bf16x8*)(WRL + (size_t)(32 + r32) * DM + k0); }
        asm volatile("" ::: "memory");
        rt_f32x16 C0 = {}, C1 = {};
#pragma unroll
        for (int s2 = 0; s2 < 8; ++s2) { const int k0 = wave * 128 + s2 * 16 + 8 * hi;
            const rt_bf16x8 ah = *(const FLAS rt_bf16x8*)(lds + LDS_AH + r32 * PITCH + k0 * 2), al = *(const FLAS rt_bf16x8*)(lds + LDS_AL + r32 * PITCH + k0 * 2);
            const rt_bf16x8 bh0 = BH0[s2], bh1 = BH1[s2], bl0 = BL0[s2], bl1 = BL1[s2];
            C0 = __builtin_amdgcn_mfma_f32_32x32x16_bf16(ah, bh0, C0, 0, 0, 0); C0 = __builtin_amdgcn_mfma_f32_32x32x16_bf16(al, bh0, C0, 0, 0, 0); C0 = __builtin_amdgcn_mfma_f32_32x32x16_bf16(ah, bl0, C0, 0, 0, 0);
            C1 = __builtin_amdgcn_mfma_f32_32x32x16_bf16(ah, bh1, C1, 0, 0, 0); C1 = __builtin_amdgcn_mfma_f32_32x32x16_bf16(al, bh1, C1, 0, 0, 0); C1 = __builtin_amdgcn_mfma_f32_32x32x16_bf16(ah, bl1, C1, 0, 0, 0); }
        __syncthreads();
        { FLAS float* Cp = (FLAS float*)(lds + LDS_CP) + wave * (32 * CPP);
#pragma unroll
          for (int r = 0; r < 16; ++r) { const int row = (r & 3) + 8 * (r >> 2) + 4 * hi; Cp[row * CPP + r32] = C0[r]; Cp[row * CPP + 32 + r32] = C1[r]; } }
        __syncthreads();
        { FLAS float* LG = (FLAS float*)(lds + LDS_CP) + 8 * 32 * CPP;
          for (int o = tix; o < 32 * NJ; o += 512) { const int row = o / NJ, j = o - row * NJ; const FLAS float* c = (const FLAS float*)(lds + LDS_CP) + row * CPP + j;
              const float bj = j < N_GROUPS ? p.moe_bg[l * N_GROUPS + j] : p.moe_br[l * N_EXP + j - N_GROUPS];
              float t8[8];
#pragma unroll
              for (int w = 0; w < 8; ++w) t8[w] = c[w * (32 * CPP)];
              asm volatile("" ::: "memory");
              LG[row * (NJ + 1) + j] = (((t8[0] + t8[1]) + (t8[2] + t8[3])) + ((t8[4] + t8[5]) + (t8[6] + t8[7]))) + bj; } }
        __syncthreads();
        if (tix < 32) { const FLAS float* LG = (const FLAS float*)(lds + LDS_CP) + 8 * 32 * CPP + tix * (NJ + 1); float lg[NJ];
#pragma unroll
            for (int j = 0; j < NJ; ++j) lg[j] = LG[j];
            asm volatile("" ::: "memory");
            route_row(p, l, g * 32 + tix, 0, lg, lcnt); }
    }
    __syncthreads();
    if (tix < N_EXP) { const int c = lcnt[tix]; lcnt[tix] = c ? atomicAdd(&p.cnt[(l * N_EXP + tix) * CS], c) : 0; }
    __syncthreads();
    for (int g = blockIdx.x; g < nrows / 32; g += gridDim.x) if (tix < 32) { const int r = g * 32 + tix; const int e0 = p.tok_e[2 * r], e1 = p.tok_e[2 * r + 1]; const int q0 = p.tok_pos[2 * r] + lcnt[e0], q1 = p.tok_pos[2 * r + 1] + lcnt[e1];
        p.tok_pos[2 * r] = q0; p.tok_pos[2 * r + 1] = q1; p.slot_tok[(size_t)e0 * TT + q0] = r; p.slot_tok[(size_t)e1 * TT + q1] = r; }
    __syncthreads();
}
__device__ __forceinline__ void scatter_phase(const Params& p, int l) {
    const int ntok = l == 0 ? TT : TL;
    int t_ = threadIdx.x; asm volatile("" : "+v"(t_)); const int lane = t_ & 63, gw = blockIdx.x * 8 + (t_ >> 6), NGW = gridDim.x * 8; const int* cnt = p.cnt + l * N_EXP * CS;
    bf16_t* XS = (bf16_t*)(p.M + M_XS);
    int ps = lane < N_EXP ? (cnt[lane * CS] + MOE_PAD - 1) / MOE_PAD * MOE_PAD : 0;
#pragma unroll
    for (int o = 1; o < N_EXP; o <<= 1) { const int t = __shfl_up(ps, o); if (lane >= o) ps += t; }
    ps = __shfl_up(ps, 1); if (lane == 0) ps = 0;
    for (int a0 = gw; a0 < 2 * ntok; a0 += 4 * NGW) {
        int aa[4], row[4]; u32x4 v0[4], v1[4];
#pragma unroll
        for (int i = 0; i < 4; ++i) { aa[i] = a0 + i * NGW; const int ac = aa[i] < 2 * ntok ? aa[i] : a0; row[i] = __shfl(ps, p.tok_e[ac]) + p.tok_pos[ac];
            const bf16_t* s = p.ACT + (size_t)(ac >> 1) * DM; v0[i] = *(const u32x4*)(s + 8 * lane); v1[i] = *(const u32x4*)(s + 512 + 8 * lane); }
#pragma unroll
        for (int i = 0; i < 4; ++i) if (aa[i] < 2 * ntok) { if (lane == 0) p.tok_row[aa[i]] = row[i]; bf16_t* d = XS + (size_t)row[i] * DM; *(u32x4*)(d + 8 * lane) = v0[i]; *(u32x4*)(d + 512 + 8 * lane) = v1[i]; }
    }
}
__device__ __forceinline__ void ln2_row_finish(const Params& p, int l, int r, int lane, f32x4 (&v)[4], const f32x4 (&y0)[4], const f32x4 (&y1)[4], float g0, float g1) {
    float* xo = r < TL ? p.out + (size_t)r * DM : p.XC + (size_t)(r - TL) * DM;
    const float* m = p.MOD + ((size_t)l * (NB + 1) + cond_of_row(r)) * 6 * DM;
#pragma unroll
    for (int j = 0; j < 4; ++j) { const f32x4 gt = *(const f32x4*)(m + 5 * DM + 256 * j + 4 * lane); v[j] = v[j] * DN_ALPHA + gt * (y0[j] * g0 + y1[j] * g1); }
    layer_norm_row(v, p.ln_g + (size_t)(l * 2 + 1) * DM, p.ln_b + (size_t)(l * 2 + 1) * DM, lane);
#pragma unroll
    for (int j = 0; j < 4; ++j) *(f32x4*)(xo + 256 * j + 4 * lane) = v[j];
    if (l == 0) { const float* m1 = p.MOD + ((size_t)(NB + 1) + cond_of_row(r)) * 6 * DM;
#pragma unroll
        for (int j = 0; j < 4; ++j) { const f32x4 sh = *(const f32x4*)(m1 + 256 * j + 4 * lane), sc = *(const f32x4*)(m1 + DM + 256 * j + 4 * lane); v[j] = v[j] * (sc + 1.0f) + sh; }
        st_row_bf16(p.ACT + (size_t)r * DM, lane, v); }
}
__device__ __forceinline__ void ln2_phase(const Params& p, int l) {
    int t_ = threadIdx.x; asm volatile("" : "+v"(t_)); const int lane = t_ & 63, gw = blockIdx.x * 8 + (t_ >> 6), NGW = gridDim.x * 8; const int nrows = l == 0 ? TT : TL;
    const bf16_t* YS = (const bf16_t*)(p.M + M_XS);
    const int* cnt = p.cnt + l * N_EXP * CS; int ps = lane < N_EXP ? (cnt[lane * CS] + MOE_PAD - 1) / MOE_PAD * MOE_PAD : 0;
#pragma unroll
    for (int o = 1; o < N_EXP; o <<= 1) { const int t = __shfl_up(ps, o); if (lane >= o) ps += t; }
    ps = __shfl_up(ps, 1); if (lane == 0) ps = 0;
    for (int r = gw; r < nrows; r += 2 * NGW) {
        const int r2 = r + NGW < nrows ? r + NGW : r;
        const float* xa = r < TL ? p.out + (size_t)r * DM : p.XC + (size_t)(r - TL) * DM; const float* xb = r2 < TL ? p.out + (size_t)r2 * DM : p.XC + (size_t)(r2 - TL) * DM;
        const int ra0 = __shfl(ps, p.tok_e[2 * r]) + p.tok_pos[2 * r], ra1 = __shfl(ps, p.tok_e[2 * r + 1]) + p.tok_pos[2 * r + 1], rb0 = __shfl(ps, p.tok_e[2 * r2]) + p.tok_pos[2 * r2], rb1 = __shfl(ps, p.tok_e[2 * r2 + 1]) + p.tok_pos[2 * r2 + 1];
        const float ga0 = p.tok_gate[2 * r], ga1 = p.tok_gate[2 * r + 1], gb0 = p.tok_gate[2 * r2], gb1 = p.tok_gate[2 * r2 + 1];
        f32x4 va[4], ya0[4], ya1[4], vb[4], yb0[4], yb1[4];
        ld_row_f32(xa, lane, va); ld_row_f32(xb, lane, vb);
        ld_row_bf16(YS + (size_t)ra0 * DM, lane, ya0); ld_row_bf16(YS + (size_t)ra1 * DM, lane, ya1); ld_row_bf16(YS + (size_t)rb0 * DM, lane, yb0); ld_row_bf16(YS + (size_t)rb1 * DM, lane, yb1);
        ln2_row_finish(p, l, r, lane, va, ya0, ya1, ga0, ga1);
        if (r2 != r) ln2_row_finish(p, l, r2, lane, vb, yb0, yb1, gb0, gb1);
    }
}
}
#endif


#ifndef CPU_SIM
#define LAS __attribute__((address_space(3)))
#define XB_TMO      128
#define XB_XCNT(j)  (256  + 64 * (j))
#define XB_XSUB(j)  (1280 + 64 * (j))
#define XB_XGEN(j)  (2304 + 64 * (j))
#define XB_TOP      3328
#define XB_TOPGEN   3392
#define XCD_BAR_WORDS 3456
#define XB_SPIN_CAP (1u << 26)

__device__ __forceinline__ unsigned xb_ld(unsigned* p)              { return __hip_atomic_load(p, __ATOMIC_RELAXED, __HIP_MEMORY_SCOPE_AGENT); }
__device__ __forceinline__ unsigned xb_add(unsigned* p, unsigned v) { return __hip_atomic_fetch_add(p, v, __ATOMIC_RELAXED, __HIP_MEMORY_SCOPE_AGENT); }
__device__ __forceinline__ unsigned xb_xcc_id() { return (unsigned)__builtin_amdgcn_s_getreg((3 << 11) | 20) & 0xFu; }
#define XB_SPIN(cond, bar) do { unsigned _sp = 0; while (cond) { __builtin_amdgcn_s_sleep(1); \
    if ((++_sp & 255u) == 0u) { if (xb_ld(&(bar)[XB_TMO])) break; if (_sp > XB_SPIN_CAP) { atomicAdd(&(bar)[XB_TMO], 1u); break; } } } } while (0)

struct XcdBarrier {
    unsigned* bar; unsigned x;
    volatile LAS unsigned* st;
};

__device__ __forceinline__ XcdBarrier xcd_barrier_post(unsigned* bar, volatile LAS unsigned* st) {
    XcdBarrier b; b.bar = bar; b.x = xb_xcc_id(); b.st = st;
    if (threadIdx.x == 0) (void)xb_add(&bar[XB_XCNT(b.x)], 1u);
    return b;
}
__device__ __forceinline__ void xcd_barrier_complete(unsigned* bar, unsigned x, unsigned& nloc, unsigned& nx) {
    const unsigned G = gridDim.x * gridDim.y * gridDim.z;
    unsigned sum, cnt, mine, sp = 0u;
    for (;;) {
        sum = 0u; cnt = 0u; mine = 0u;
#pragma unroll
        for (unsigned j = 0; j < 16; ++j) { const unsigned c = xb_ld(&bar[XB_XCNT(j)]); sum += c; cnt += (c > 0u) ? 1u : 0u; mine = (j == x) ? c : mine; }
        if (sum == G) break;
        __builtin_amdgcn_s_sleep(1);
        if ((++sp & 255u) == 0u) { if (xb_ld(&bar[XB_TMO])) break; if (sp > XB_SPIN_CAP) { atomicAdd(&bar[XB_TMO], 1u); break; } }
    }
    nloc = mine > 0u ? mine : 1u; nx = cnt > 0u ? cnt : 1u;
}

__device__ __forceinline__ void xcd_barrier(const XcdBarrier& b) {
    asm volatile("s_waitcnt vmcnt(0)" ::: "memory");
    __syncthreads();
    if (threadIdx.x == 0) {
        unsigned* bar = b.bar;
        __builtin_amdgcn_s_waitcnt(0);
        unsigned nloc = b.st[0], nx = b.st[1];
        if (nloc == 0u) { xcd_barrier_complete(bar, b.x, nloc, nx); b.st[0] = nloc; b.st[1] = nx; }
        const unsigned old = xb_add(&bar[XB_XSUB(b.x)], 1u);
        const unsigned gen = old / nloc;
        if (old + 1u == (gen + 1u) * nloc) {
            __builtin_amdgcn_fence(__ATOMIC_RELEASE, "agent");
            asm volatile("s_waitcnt vmcnt(0)" ::: "memory");
            const unsigned og = xb_add(&bar[XB_TOP], 1u);
            const unsigned tg = og / nx;
            if (og + 1u == (tg + 1u) * nx) xb_add(&bar[XB_TOPGEN], 1u);
            else XB_SPIN(xb_ld(&bar[XB_TOPGEN]) == tg, bar);
            __builtin_amdgcn_fence(__ATOMIC_ACQUIRE, "agent");
            xb_add(&bar[XB_XGEN(b.x)], 1u);
            asm volatile("s_waitcnt vmcnt(0)" ::: "memory");
        } else {
            XB_SPIN(xb_ld(&bar[XB_XGEN(b.x)]) == gen, bar);
            __builtin_amdgcn_fence(__ATOMIC_ACQUIRE, "agent");
            asm volatile("s_waitcnt vmcnt(0)" ::: "memory");
        }
    }
    __syncthreads();
}
#endif


#ifndef CPU_SIM
namespace lru {
using bf16x8 = __attribute__((ext_vector_type(8))) short;
using f32x16 = __attribute__((ext_vector_type(16))) float;
typedef float f32x4 __attribute__((ext_vector_type(4)));
typedef unsigned u32x4 __attribute__((ext_vector_type(4)));
__device__ __forceinline__ float gelu_fast(float v) { const float z = 1.5957691216057308f * (v + 0.044715f * v * v * v); return v * __builtin_amdgcn_rcpf(1.0f + __expf(-z)); }
template <int PASS> __device__ __forceinline__ void lru_phase(const Params& p, FLAS unsigned char* lds_raw) {
    static_assert(LRU_BD == 64 && LRU_NBLK == 8 && LRU_CH == 32, "one wave per 64-channel block, 32-token chunks");
    const int tid = threadIdx.x, wave = tid >> 6, lane = tid & 63, r32 = lane & 31, hi = lane >> 5;
    FLAS unsigned* Wl = (FLAS unsigned*)lds_raw + wave * (LRU_CH * 64);
    const bf16_t* P = P_of(p); const int c = wave * 64 + lane;
    const float cw0 = p.e_conv_w[c], cw1 = p.e_conv_w[LRU_W + c], cw2 = p.e_conv_w[2 * LRU_W + c], cw3 = p.e_conv_w[3 * LRU_W + c], cb = p.e_conv_b[c];
    float* SUM = (float*)(p.M + M_SUM); const float* HIN = (const float*)(p.M + M_HIN); unsigned* GW = (unsigned*)(p.M + M_GW);
    for (int u = blockIdx.x; u < NB * LRU_NV; u += gridDim.x) {
        int b, row0, lo, hi_, v0, v1; lru_chunk_geom(u, b, row0, lo, hi_, v0, v1);
        bf16x8 af[4];
#pragma unroll
        for (int s = 0; s < 4; ++s) {
            const int ch0 = wave * 64 + 16 * s + 8 * hi; f32x4 a0 = *(const f32x4*)(p.e_conv_b + ch0), a1 = *(const f32x4*)(p.e_conv_b + ch0 + 4);
            u32x4 wr_[4]; f32x4 w0_[4], w1_[4];
#pragma unroll
            for (int tau = 0; tau < 4; ++tau) { const int rr = row0 + r32 + tau - 1; const int rc = rr < lo ? lo : (rr >= hi_ ? hi_ - 1 : rr);
                wr_[tau] = *(const u32x4*)(P + (size_t)rc * EPLD + EC_U + ch0); w0_[tau] = *(const f32x4*)(p.e_conv_w + tau * LRU_W + ch0); w1_[tau] = *(const f32x4*)(p.e_conv_w + tau * LRU_W + ch0 + 4); }
            asm volatile("" ::: "memory");
#pragma unroll
            for (int tau = 0; tau < 4; ++tau) { const int rr = row0 + r32 + tau - 1; const bool ok = rr >= lo && rr < hi_;
                u32x4 w = wr_[tau]; if (!ok) w = (u32x4){0u, 0u, 0u, 0u};
                const f32x4 w0 = w0_[tau], w1 = w1_[tau];
                a0 += w0 * (f32x4){__uint_as_float(w.x << 16), __uint_as_float(w.x & 0xffff0000u), __uint_as_float(w.y << 16), __uint_as_float(w.y & 0xffff0000u)};
                a1 += w1 * (f32x4){__uint_as_float(w.z << 16), __uint_as_float(w.z & 0xffff0000u), __uint_as_float(w.w << 16), __uint_as_float(w.w & 0xffff0000u)}; }
            u32x4 o; o.x = fast::pk2(a0[0], a0[1]); o.y = fast::pk2(a0[2], a0[3]); o.z = fast::pk2(a1[0], a1[1]); o.w = fast::pk2(a1[2], a1[3]); af[s] = *reinterpret_cast<bf16x8*>(&o);
        }
        float ucv[LRU_CH];
        { bf16_t ur_[LRU_CH + 3];
#pragma unroll
          for (int t = 0; t < LRU_CH + 3; ++t) { const int rr = row0 + t - 1; ur_[t] = P[(size_t)(rr < lo ? lo : (rr >= hi_ ? hi_ - 1 : rr)) * EPLD + EC_U + c]; }
          asm volatile("" ::: "memory");
          float um1 = row0 - 1 < lo ? 0.f : bf2f(ur_[0]), u0 = bf2f(ur_[1]), u1 = bf2f(ur_[2]);
#pragma unroll
          for (int t = 0; t < LRU_CH; ++t) { const int rr = row0 + t + 2; float u2 = rr >= hi_ ? 0.f : bf2f(ur_[t + 3]);
              ucv[t] = cb + cw0 * um1 + cw1 * u0 + cw2 * u1 + cw3 * u2; um1 = u0; u0 = u1; u1 = u2; } }
        float hf[LRU_CH];
#pragma unroll
        for (int d = 0; d < 2; ++d) {
            f32x16 C[4]; bf16x8 bw_[4][4];
#pragma unroll
            for (int nt = 0; nt < 4; ++nt)
#pragma unroll
                for (int s = 0; s < 4; ++s) bw_[nt][s] = *reinterpret_cast<const bf16x8*>(p.LRUW + ((((size_t)(d * LRU_NBLK + wave) * 2 + (nt >> 1)) * 64 + (nt & 1) * 32 + r32) * 64 + 16 * s + 8 * hi));
            asm volatile("" ::: "memory");
#pragma unroll
            for (int nt = 0; nt < 4; ++nt) { C[nt] = f32x16{};
#pragma unroll
                for (int s = 0; s < 4; ++s) C[nt] = __builtin_amdgcn_mfma_f32_32x32x16_bf16(af[s], bw_[nt][s], C[nt], 0, 0, 0); }
#pragma unroll
            for (int j = 0; j < 2; ++j) { const float* cc = p.LRUC + (size_t)(d * LRU_W + wave * 64 + 32 * j + r32) * 3; const float ba = cc[0], bxv = cc[1], sp = cc[2];
#pragma unroll
                for (int r = 0; r < 16; ++r) { const int tok = (r & 3) + 8 * (r >> 2) + 4 * hi;
                    const float rg = __builtin_amdgcn_rcpf(1.0f + __expf(-(C[j][r] + ba))), ig = __builtin_amdgcn_rcpf(1.0f + __expf(-(C[2 + j][r] + bxv)));
                    const float la = -LRU_C * rg * sp, a = __expf(la), bq = __builtin_amdgcn_sqrtf(fmaxf(1.0f - a * a, 0.f)) * ig;
                    Wl[tok * 64 + 32 * j + r32] = fast::pk2(la, bq); } }
            const int v = d ? v1 : v0; const size_t sidx = (((size_t)b * 2 + d) * LRU_NV + v) * LRU_W + c;
            float h = PASS == 2 ? HIN[sidx] : 0.f, lsum = 0.f;
            unsigned wq_[LRU_CH];
#pragma unroll
            for (int t = 0; t < LRU_CH; ++t) wq_[t] = Wl[t * 64 + lane];
            asm volatile("" ::: "memory");
#pragma unroll
            for (int tt = 0; tt < LRU_CH; ++tt) { const int t = d ? LRU_CH - 1 - tt : tt; const unsigned w = wq_[t];
                const float la = __uint_as_float(w << 16), bq = __uint_as_float(w & 0xffff0000u);
                h = __expf(la) * h + bq * ucv[t]; lsum += la;
                if (PASS == 1) GW[((size_t)d * TT + row0 + t) * LRU_W + c] = w;
                if (PASS == 2) { if (d == 0) hf[t] = h; else p.ACT[(size_t)(row0 + t) * DM + c] = f2bf((hf[t] + h) * gelu_fast(bf2f(P[(size_t)(row0 + t) * EPLD + EC_G + c]))); } }
            if (PASS == 1) { SUM[2 * sidx] = __expf(lsum); SUM[2 * sidx + 1] = h; }
        }
    }
}


__device__ __forceinline__ void lru_pass2_light(const Params& p) {
    const int tid = threadIdx.x, wave = tid >> 6, lane = tid & 63; const int c = wave * 64 + lane;
    const float cw0 = p.e_conv_w[c], cw1 = p.e_conv_w[LRU_W + c], cw2 = p.e_conv_w[2 * LRU_W + c], cw3 = p.e_conv_w[3 * LRU_W + c], cb = p.e_conv_b[c];
    const float* HIN = (const float*)(p.M + M_HIN);
    const unsigned oc4 = (unsigned)c * 4u, oc2 = (unsigned)c * 2u;
    for (int u = blockIdx.x; u < NB * LRU_NV; u += gridDim.x) {
        int b, row0, lo, hi_, v0, v1; lru_chunk_geom(u, b, row0, lo, hi_, v0, v1);
        const unsigned char* gw0 = p.M + M_GW + (size_t)row0 * LRU_W * 4; const unsigned char* gw1 = gw0 + (size_t)TT * LRU_W * 4;
        const unsigned char* pg = p.M + M_P + ((size_t)row0 * EPLD + EC_G) * 2; const unsigned char* pu = p.M + M_P + ((size_t)row0 * EPLD + EC_U) * 2;
        unsigned w0[LRU_CH], w1[LRU_CH]; bf16_t gv[LRU_CH], uu[LRU_CH + 3];
#pragma unroll
        for (int t = 0; t < LRU_CH; ++t) { w0[t] = *(const unsigned*)(gw0 + (size_t)t * LRU_W * 4 + oc4); w1[t] = *(const unsigned*)(gw1 + (size_t)t * LRU_W * 4 + oc4); gv[t] = *(const bf16_t*)(pg + (size_t)t * EPLD * 2 + oc2); }
#pragma unroll
        for (int t = -1; t < LRU_CH + 2; ++t) { const int rr = row0 + t; const int tc = rr < lo ? lo - row0 : (rr >= hi_ ? hi_ - 1 - row0 : t); uu[t + 1] = *(const bf16_t*)(pu + (long)tc * EPLD * 2 + oc2); }
        float hf = HIN[(((size_t)b * 2 + 0) * LRU_NV + v0) * LRU_W + c], hb = HIN[(((size_t)b * 2 + 1) * LRU_NV + v1) * LRU_W + c];
        float ucv[LRU_CH];
#pragma unroll
        for (int t = 0; t < LRU_CH; ++t) { const float um1 = (row0 + t - 1 >= lo) ? bf2f(uu[t]) : 0.f, u0 = bf2f(uu[t + 1]), u1 = (row0 + t + 1 < hi_) ? bf2f(uu[t + 2]) : 0.f, u2 = (row0 + t + 2 < hi_) ? bf2f(uu[t + 3]) : 0.f;
            ucv[t] = cb + cw0 * um1 + cw1 * u0 + cw2 * u1 + cw3 * u2; }
        float hfv[LRU_CH];
#pragma unroll
        for (int t = 0; t < LRU_CH; ++t) { hf = __expf(__uint_as_float(w0[t] << 16)) * hf + __uint_as_float(w0[t] & 0xffff0000u) * ucv[t]; hfv[t] = hf; }
        bf16_t* orow = p.ACT + (size_t)row0 * DM + c;
#pragma unroll
        for (int tt = 0; tt < LRU_CH; ++tt) { const int t = LRU_CH - 1 - tt; hb = __expf(__uint_as_float(w1[t] << 16)) * hb + __uint_as_float(w1[t] & 0xffff0000u) * ucv[t];
            orow[(size_t)t * DM] = fast::f2bf_hw((hfv[t] + hb) * gelu_fast(bf2f(gv[t]))); }
    }
}
__device__ __forceinline__ void lru_carry_phase(const Params& p, FLAS unsigned char* lds_raw) {
    typedef float f32x2 __attribute__((ext_vector_type(2)));
    FLAS f32x2* S = (FLAS f32x2*)lds_raw;
    const f32x2* SUM = (const f32x2*)(p.M + M_SUM); float* HIN = (float*)(p.M + M_HIN); const int tid = threadIdx.x;
    static_assert(LRU_NV * 64 * 8 <= 147456, "carry image fits LDS");
    for (int u = blockIdx.x; u < NB * 2 * (LRU_W / 64); u += gridDim.x) {
        const int bd = u / (LRU_W / 64), c0 = (u % (LRU_W / 64)) * 64;
        static_assert(LRU_NV % 8 == 0 && (LRU_NV * 64) % (512 * 11) == 0, "carry batching");
        __syncthreads();
#pragma unroll 11
        for (int i = tid; i < LRU_NV * 64; i += 512) S[i] = SUM[((size_t)bd * LRU_NV + (i >> 6)) * LRU_W + c0 + (i & 63)];
        __syncthreads();
        if (tid < 64) { float h = 0.f;
            for (int v0 = 0; v0 < LRU_NV; v0 += 8) { f32x2 ab[8];
#pragma unroll
                for (int i = 0; i < 8; ++i) ab[i] = S[(v0 + i) * 64 + tid];
                asm volatile("" ::: "memory");
#pragma unroll
                for (int i = 0; i < 8; ++i) { S[(v0 + i) * 64 + tid].x = h; h = ab[i].x * h + ab[i].y; } } }
        __syncthreads();
#pragma unroll 11
        for (int i = tid; i < LRU_NV * 64; i += 512) HIN[((size_t)bd * LRU_NV + (i >> 6)) * LRU_W + c0 + (i & 63)] = S[i].x;
    }
    __syncthreads();
}
}
#endif


#ifndef CPU_SIM
namespace conf {
typedef float f32x4 __attribute__((ext_vector_type(4)));
typedef unsigned u32x4 __attribute__((ext_vector_type(4)));
constexpr int TCH = 64, HALO = (CONF_K - 1) / 2, NROW = TCH + CONF_K - 1;
constexpr int LDS_G = 0, LDS_W = NROW * CONF_CH * 2, LDS_END = LDS_W + CONF_K * CONF_CH * 2;
__device__ __forceinline__ void up8(const u32x4 w, f32x4& lo, f32x4& hi) {
    lo = (f32x4){__uint_as_float(w.x << 16), __uint_as_float(w.x & 0xffff0000u), __uint_as_float(w.y << 16), __uint_as_float(w.y & 0xffff0000u)};
    hi = (f32x4){__uint_as_float(w.z << 16), __uint_as_float(w.z & 0xffff0000u), __uint_as_float(w.w << 16), __uint_as_float(w.w & 0xffff0000u)}; }
__device__ __forceinline__ void conf_phase(const Params& p, FLAS unsigned char* lds_raw) {
    static_assert(CONF_CH == 512 && LDS_END <= 147456, "lane = 8 channels");
    const int tid = threadIdx.x, wave = tid >> 6, lane = tid & 63;
    FLAS unsigned char* lds = (FLAS unsigned char*)lds_raw; const bf16_t* P = P_of(p);
    if ((int)blockIdx.x >= NB * (SEQ / TCH)) return;
    for (int i = tid; i < CONF_K * CONF_CH / 4; i += 512) { const f32x4 w = *(const f32x4*)(p.o_dw_w + 4 * i); *(FLAS unsigned long long*)(lds + LDS_W + 8 * i) = (unsigned long long)fast::pk2(w[0], w[1]) | ((unsigned long long)fast::pk2(w[2], w[3]) << 32); }
    const f32x4 cb0 = *(const f32x4*)(p.o_dw_b + 8 * lane), cb1 = *(const f32x4*)(p.o_dw_b + 8 * lane + 4);
    for (int u = blockIdx.x; u < NB * (SEQ / TCH); u += gridDim.x) {
        const int b = u / (SEQ / TCH), t0 = (u % (SEQ / TCH)) * TCH;
        __syncthreads();
        for (int i0 = tid; i0 < NROW * (CONF_CH / 8); i0 += 4 * 512) {
            u32x4 av_[4], gv_[4];
#pragma unroll
            for (int q = 0; q < 4; ++q) { const int i = i0 + 512 * q < NROW * (CONF_CH / 8) ? i0 + 512 * q : i0; const int rr = i / (CONF_CH / 8), ch = (i % (CONF_CH / 8)) * 8, t = t0 - HALO + rr; const int tc = t < 0 ? 0 : (t >= SEQ ? SEQ - 1 : t);
                const bf16_t* row = P + (size_t)(b * SEQ + tc) * OPLD; av_[q] = *(const u32x4*)(row + OC_A + ch); gv_[q] = *(const u32x4*)(row + OC_G + ch); }
            asm volatile("" ::: "memory");
#pragma unroll
            for (int q = 0; q < 4; ++q) { const int i = i0 + 512 * q; if (i < NROW * (CONF_CH / 8)) {
                const int rr = i / (CONF_CH / 8), ch = (i % (CONF_CH / 8)) * 8, t = t0 - HALO + rr; const bool ok = t >= 0 && t < SEQ;
                f32x4 a0, a1, g0, g1; up8(av_[q], a0, a1); up8(gv_[q], g0, g1);
#pragma unroll
                for (int j = 0; j < 4; ++j) { a0[j] = a0[j] * __builtin_amdgcn_rcpf(1.0f + __expf(-g0[j])); a1[j] = a1[j] * __builtin_amdgcn_rcpf(1.0f + __expf(-g1[j])); }
                u32x4 o; o.x = fast::pk2(a0[0], a0[1]); o.y = fast::pk2(a0[2], a0[3]); o.z = fast::pk2(a1[0], a1[1]); o.w = fast::pk2(a1[2], a1[3]); if (!ok) o = (u32x4){0u, 0u, 0u, 0u};
                *(FLAS u32x4*)(lds + LDS_G + (size_t)(rr * CONF_CH + ch) * 2) = o; } }
        }
        __syncthreads();
        static_assert(TCH / 8 == 8, "eight tokens per wave");
        f32x4 a0_[8], a1_[8]; const int tb = wave * (TCH / 8);
#pragma unroll
        for (int tk = 0; tk < 8; ++tk) { a0_[tk] = cb0; a1_[tk] = cb1; }
        f32x4 gw0_[8], gw1_[8];
#pragma unroll
        for (int q = 0; q < 8; ++q) up8(*(const FLAS u32x4*)(lds + LDS_G + (size_t)((tb + q) * CONF_CH + 8 * lane) * 2), gw0_[q], gw1_[q]);
#pragma unroll
        for (int j = 0; j < CONF_K; ++j) { f32x4 w0, w1; up8(*(const FLAS u32x4*)(lds + LDS_W + (size_t)(j * CONF_CH + 8 * lane) * 2), w0, w1);
#pragma unroll
            for (int tk = 0; tk < 8; ++tk) { a0_[tk] += gw0_[(tk + j) & 7] * w0; a1_[tk] += gw1_[(tk + j) & 7] * w1; }
            if (j + 1 < CONF_K) up8(*(const FLAS u32x4*)(lds + LDS_G + (size_t)((tb + j + 8) * CONF_CH + 8 * lane) * 2), gw0_[j & 7], gw1_[j & 7]); }
        const f32x4 lg0 = *(const f32x4*)(p.o_cln_g + 8 * lane), lg1 = *(const f32x4*)(p.o_cln_g + 8 * lane + 4), lb0 = *(const f32x4*)(p.o_cln_b + 8 * lane), lb1 = *(const f32x4*)(p.o_cln_b + 8 * lane + 4);
#pragma unroll
        for (int tk = 0; tk < 8; ++tk) {
            const int tl = tb + tk; f32x4 s0 = a0_[tk], s1 = a1_[tk];
            float sm = (s0[0] + s0[1]) + (s0[2] + s0[3]) + (s1[0] + s1[1]) + (s1[2] + s1[3]);
            const float mu = fast::wave_sum(sm) * (1.0f / CONF_CH); s0 = s0 - mu; s1 = s1 - mu;
            float q = (s0[0] * s0[0] + s0[1] * s0[1]) + (s0[2] * s0[2] + s0[3] * s0[3]) + (s1[0] * s1[0] + s1[1] * s1[1]) + (s1[2] * s1[2] + s1[3] * s1[3]);
            const float rstd = 1.0f / sqrtf(fast::wave_sum(q) * (1.0f / CONF_CH) + LN_EPS);
            s0 = s0 * rstd * lg0 + lb0; s1 = s1 * rstd * lg1 + lb1;
#pragma unroll
            for (int j = 0; j < 4; ++j) { s0[j] = s0[j] * __builtin_amdgcn_rcpf(1.0f + __expf(-s0[j])); s1[j] = s1[j] * __builtin_amdgcn_rcpf(1.0f + __expf(-s1[j])); }
            u32x4 o; o.x = fast::pk2(s0[0], s0[1]); o.y = fast::pk2(s0[2], s0[3]); o.z = fast::pk2(s1[0], s1[1]); o.w = fast::pk2(s1[2], s1[3]);
            *(u32x4*)(p.ACT + (size_t)(b * SEQ + t0 + tl) * DM + MLA_H * MLA_V + 8 * lane) = o;
        }
    }
    __syncthreads();
}
}
#endif

enum Phase { PH_PROLOGUE = 0, PH_L0_MODULATE, PH_L0_INPROJ, PH_L0_ROPE, PH_L0_CARRY, PH_L0_MIX, PH_L0_OUTPROJ, PH_L0_LN1, PH_L0_SCATTER, PH_L0_MOE1, PH_L0_MOE2, PH_L0_LN2,
             PH_L1_INPROJ, PH_L1_POST, PH_L1_UP, PH_L1_ATTN, PH_L1_OUTPROJ, PH_L1_LN1, PH_L1_SCATTER, PH_L1_MOE1, PH_L1_MOE2, PH_L1_LN2, N_PHASES };
DEV void run_phase(const Params& p, int ph, long gtid, long gsize) {
    switch (ph) {
    case PH_PROLOGUE: ph_mod(p, gtid, gsize); ph_weights_naive(p, gtid, gsize); break;
    case PH_L0_MODULATE: ph_modulate0(p, gtid, gsize); break;
    case PH_L0_INPROJ: gemm_naive(p.ACT, DM, p.W_ein, DM, TT, EVEN_IN, EpiInE_naive{&p}, gtid, gsize); break;
    case PH_L0_ROPE: ph_rope_swa(p, gtid, gsize); ph_lru_naive<1>(p, gtid, gsize); break;
    case PH_L0_CARRY: ph_lru_carry(p, gtid, gsize); break;
    case PH_L0_MIX: ph_lru_naive<2>(p, gtid, gsize); ph_swa(p, gtid, gsize); ph_ctxattn(p, gtid, gsize); break;
    case PH_L0_OUTPROJ: gemm_naive(p.ACT, DM, p.W_eout, DM, TT, DM, EpiOut_naive{P_of(p), p.e_b_out}, gtid, gsize); break;
    case PH_L0_LN1: ph_ln1(p, 0, gtid, gsize); break;
    case PH_L0_SCATTER: ph_scatter(p, 0, gtid, gsize); break;
    case PH_L0_MOE1: ph_moe1_naive(p, 0, gtid, gsize); break;
    case PH_L0_MOE2: ph_moe2_naive(p, 0, gtid, gsize); break;
    case PH_L0_LN2: ph_ln2(p, 0, gtid, gsize); break;
    case PH_L1_INPROJ: gemm_naive(p.ACT, DM, p.W_oin, DM, TT, OPLD, EpiInO_naive{&p}, gtid, gsize); break;
    case PH_L1_POST: ph_l1_post_inproj(p, gtid, gsize); ph_conf_conv(p, gtid, gsize); break;
    case PH_L1_UP: ph_uq_naive(p, gtid, gsize);
                   gemm_naive(P_of(p) + OC_CKV, OPLD, p.W_ukv, MLA_KVR, TT, MLA_H * (MLA_NOPE + MLA_V), EpiUkv_naive{&p}, gtid, gsize);
                   ph_conf_ln(p, gtid, gsize); break;
    case PH_L1_ATTN: ph_mla_attn(p, gtid, gsize); break;
    case PH_L1_OUTPROJ: gemm_naive(p.ACT, DM, p.W_oout, DM, TL, DM, EpiOut_naive{P_of(p), p.o_b_out}, gtid, gsize); break;
    case PH_L1_LN1: ph_ln1(p, 1, gtid, gsize); break;
    case PH_L1_SCATTER: ph_scatter(p, 1, gtid, gsize); break;
    case PH_L1_MOE1: ph_moe1_naive(p, 1, gtid, gsize); break;
    case PH_L1_MOE2: ph_moe2_naive(p, 1, gtid, gsize); break;
    case PH_L1_LN2: ph_ln2(p, 1, gtid, gsize); break;
    default: break;
    }
}

static size_t fill_params(Params& p, void* const* d_in, void* d_out, void* d_ws) {
    const float* const* in = (const float* const*)d_in;
    int k = 0;
    p.x = in[k++]; p.c = in[k++]; p.ctx = in[k++]; p.c_ctx = in[k++]; p.w_mod = in[k++]; p.b_mod = in[k++]; p.ln_g = in[k++]; p.ln_b = in[k++];
    p.e_w_in = in[k++]; p.e_b_in = in[k++]; p.e_conv_w = in[k++]; p.e_conv_b = in[k++]; p.e_wa = in[k++]; p.e_ba = in[k++]; p.e_wx = in[k++]; p.e_bx = in[k++];
    p.e_lam = in[k++]; p.e_sink = in[k++]; p.e_w_out = in[k++]; p.e_b_out = in[k++];
    p.o_w_in = in[k++]; p.o_b_in = in[k++]; p.o_q_norm = in[k++]; p.o_kv_norm = in[k++]; p.o_w_uq = in[k++]; p.o_w_uk = in[k++]; p.o_w_uv = in[k++];
    p.o_dw_w = in[k++]; p.o_dw_b = in[k++]; p.o_cln_g = in[k++]; p.o_cln_b = in[k++]; p.o_w_out = in[k++]; p.o_b_out = in[k++];
    p.moe_wg = in[k++]; p.moe_bg = in[k++]; p.moe_wr = in[k++]; p.moe_br = in[k++]; p.moe_w1 = in[k++]; p.moe_w3 = in[k++]; p.moe_w2 = in[k++];
    p.out = (float*)d_out;
    char* w = (char*)d_ws; size_t off = 0;
    auto take = [&](size_t bytes) { char* r = w + off; off += (bytes + 255) & ~(size_t)255; return r; };
    p.bar = (unsigned*)take(16384);
    p.LRUW = (bf16_t*)take((size_t)2 * LRU_NBLK * 2 * LRU_BD * LRU_BD * 2); p.LRUC = (float*)take((size_t)2 * LRU_W * 3 * 4);
    p.WTR = (float*)take((size_t)2 * (N_GROUPS + N_EXP) * DM * 4);
    p.WRH = (bf16_t*)take((size_t)2 * 64 * DM * 2); p.WRL = (bf16_t*)take((size_t)2 * 64 * DM * 2);
    p.MOD = (float*)take((size_t)2 * (NB + 1) * 6 * DM * 4);
    p.XC = (float*)take((size_t)TC * DM * 4);
    p.ROPE_SWA = (float*)take((size_t)128 * (SWA_HD / 4) * 2 * 4);
    p.ROPE_MLA = (float*)take((size_t)128 * (MLA_ROPE / 4) * 2 * 4);
    p.SSQ = (float*)take((size_t)TT * 8 * 4);
    p.cnt = (int*)take(2 * N_EXP * CS * 4);
    p.tok_e = (int*)take((size_t)TT * 2 * 4); p.tok_pos = (int*)take((size_t)TT * 2 * 4); p.tok_gate = (float*)take((size_t)TT * 2 * 4); p.tok_row = (int*)take((size_t)TT * 2 * 4); p.slot_tok = (int*)take((size_t)N_EXP * TT * 4);
    p.W_ein = (bf16_t*)take((size_t)EVEN_IN * DM * 2); p.W_eout = (bf16_t*)take((size_t)DM * DM * 2);
    p.W_oin = (bf16_t*)take((size_t)OPLD * DM * 2); p.W_oout = (bf16_t*)take((size_t)DM * DM * 2);
    p.W_uq = (bf16_t*)take((size_t)MLA_H * MLA_QD * MLA_QR * 2); p.W_ukv = (bf16_t*)take((size_t)MLA_H * (MLA_NOPE + MLA_V) * MLA_KVR * 2);
    p.W_up = (bf16_t*)take((size_t)2 * N_EXP * 2 * D_EXP * DM * 2); p.W_dn = (bf16_t*)take((size_t)2 * N_EXP * DM * D_EXP * 2);
    p.ACT = (bf16_t*)take((size_t)TT * DM * 2);
    p.M = (unsigned char*)take(M_BYTES);
    return off;
}

#ifndef CPU_SIM
constexpr int LDS_MAIN = 147456, LDS_BYTES = LDS_MAIN + 256;
#ifndef ENG_MASK
#define ENG_MASK 0xffffffffu
#endif
__global__ void __launch_bounds__(512, 2) mega(Params p) {
    extern __shared__ __attribute__((aligned(16))) unsigned char lds_raw[];
    PG8_LAS unsigned char* lds = (PG8_LAS unsigned char*)lds_raw;
    cg::grid_group grid = cg::this_grid();
    volatile LAS unsigned* bar_st = (volatile LAS unsigned*)(lds + LDS_MAIN);
    if (threadIdx.x < 2) bar_st[threadIdx.x] = 0u;
    __syncthreads();
    (void)xcd_barrier_post(p.bar, bar_st);
    const int G = (int)gridDim.x, bx = (int)blockIdx.x;
#define gtid ((long)((int)blockIdx.x * 512 + (int)threadIdx.x))
#define gsize ((long)((int)gridDim.x * 512))
#ifndef REP_PHASE
#define REP_PHASE -1
#endif
#ifndef ATT_VAR
#define ATT_VAR 0
#endif
#ifndef TS_PHASE
#define TS_PHASE -1
#endif
#define TS_SLOT ((volatile LAS unsigned long long*)((LAS unsigned char*)lds + LDS_MAIN + 64))
#define TS_ME ({ unsigned t_ = threadIdx.x; asm volatile("" : "+v"(t_)); t_ == 0u && blockIdx.x == 0u; })
#define TS_BEGIN(k) do { if ((k) == TS_PHASE && TS_ME) TS_SLOT[0] = __builtin_amdgcn_s_memrealtime(); } while (0)
#define TS_END(k) do { if ((k) == TS_PHASE && TS_ME) TS_SLOT[1] = __builtin_amdgcn_s_memrealtime() - TS_SLOT[0]; } while (0)
#define IN(k) (p.ph_lo <= (k) && (k) <= p.ph_hi)
#define SYNC(k) do { if ((k) < p.ph_hi) { XcdBarrier b_; b_.bar = p.bar; b_.x = xb_xcc_id(); b_.st = (volatile LAS unsigned*)((LAS unsigned char*)lds + LDS_MAIN); xcd_barrier(b_); } } while (0)
#define NAIVE(k) do { if (IN(k)) { run_phase(p, (k), gtid, gsize); SYNC(k); } } while (0)
    if (IN(PH_PROLOGUE)) { TS_BEGIN(PH_PROLOGUE); ph_misc(p, gtid, gsize); fast::mod_phase(p, lds); fast::weights_phase(p, lds, 0, 0); fast::moe_weights_stream(p, lds, 2 * (6 * DM / 64));
        SYNC(PH_PROLOGUE);  TS_END(PH_PROLOGUE); }
    if (REP_PHASE == PH_PROLOGUE && IN(PH_PROLOGUE)) { ph_misc(p, gtid, gsize); fast::mod_phase(p, lds); fast::weights_phase(p, lds, 0, 0); fast::moe_weights_stream(p, lds, 2 * (6 * DM / 64));
        SYNC(PH_PROLOGUE); }
    if (IN(PH_L0_MODULATE)) { TS_BEGIN(PH_L0_MODULATE); fast::modulate0_phase(p);
        SYNC(PH_L0_MODULATE);  TS_END(PH_L0_MODULATE); }
    if (REP_PHASE == PH_L0_MODULATE && IN(PH_L0_MODULATE)) { fast::modulate0_phase(p);
        SYNC(PH_L0_MODULATE); }
    if (IN(PH_L0_INPROJ)) { TS_BEGIN(PH_L0_INPROJ);
        pg8::Gemm g{p.ACT, p.W_ein, TT, EVEN_IN, DM, DM}; pg8::StaticOrder S; S.init(TT, EVEN_IN, G, bx);
        pg8::EpiInE E{P_of(p), p.e_b_in, p.ROPE_SWA};
        pg8::gemm_phase<pg8::EpiInE, pg8::StaticOrder, true, true>(lds, g, S, E); SYNC(PH_L0_INPROJ);
     TS_END(PH_L0_INPROJ); }
    if (REP_PHASE == PH_L0_INPROJ && IN(PH_L0_INPROJ)) {
        pg8::Gemm g{p.ACT, p.W_ein, TT, EVEN_IN, DM, DM}; pg8::StaticOrder S; S.init(TT, EVEN_IN, G, bx);
        pg8::EpiInE E{P_of(p), p.e_b_in, p.ROPE_SWA};
        pg8::gemm_phase<pg8::EpiInE, pg8::StaticOrder, true, true>(lds, g, S, E); SYNC(PH_L0_INPROJ);
    }
    if (IN(PH_L0_ROPE)) { TS_BEGIN(PH_L0_ROPE); lru::lru_phase<1>(p, lds); SYNC(PH_L0_ROPE);  TS_END(PH_L0_ROPE); }
    if (REP_PHASE == PH_L0_ROPE && IN(PH_L0_ROPE)) { lru::lru_phase<1>(p, lds); SYNC(PH_L0_ROPE); }
    if (IN(PH_L0_CARRY)) { TS_BEGIN(PH_L0_CARRY);
        lru::lru_carry_phase(p, lds);
        const bf16_t* P = P_of(p);
        for (int u = bx; u < NB * SWA_H * (SEQ / 256); u += G) {
            const int c = u % 256, i = u / 256, bh = (c % 8) + 8 * i, qb = c / 8, b = bh / SWA_H, h = bh % SWA_H, kv = h / (SWA_H / SWA_KV), q0 = qb * 256;
            auto rowof = [=](int t) -> long { if (t >= 8) return (long)TL + b * CTX + 64 * (t - 8); int k0 = q0 - 128 + 64 * t; k0 = k0 < 0 ? 0 : (k0 > SEQ - 64 ? SEQ - 64 : k0); return (long)b * SEQ + k0; };
            auto mask = [=](fa::f32x16& p0, fa::f32x16& p1, int t, int qrow, int hi) { if (t < 8) { const int d0 = (q0 - 128 + 64 * t + 4 * hi) - (q0 + qrow);
#pragma unroll
                for (int r = 0; r < 16; ++r) { const int d = d0 + (r & 3) + 8 * (r >> 2); const int kp = d + q0 + qrow;
                    if (d < -WINDOW || d > WINDOW || kp < 0 || kp >= SEQ) p0[r] = -1e30f;
                    if (d + 32 < -WINDOW || d + 32 > WINDOW || kp + 32 < 0 || kp + 32 >= SEQ) p1[r] = -1e30f; } } };
            auto act = [](int t, int w) -> bool { return t >= 8 || (64 * t <= 32 * w + 31 + 2 * WINDOW && 64 * t + 63 >= 32 * w); };
            fa::attn_unit<SWA_HD, decltype(rowof), decltype(mask), 0, decltype(act)>(P + (size_t)(b * SEQ + q0) * EPLD + EC_Q + h * SWA_HD, EPLD, P + EC_K + kv * SWA_HD, EPLD, P + EC_V + kv * SWA_HD, EPLD,
                                  p.ACT + (size_t)(b * SEQ + q0) * DM + LRU_W + h * SWA_HD, DM, 12, rowof, mask, p.e_sink[h] * LOG2E, 1.0f, (FLAS char*)lds, act);
        }
        for (int u = bx; u < NB * SWA_H; u += G) {
            const int b = u / SWA_H, h = u % SWA_H, kv = h / (SWA_H / SWA_KV);
            auto rowof = [=](int t) -> long { return (long)TL + b * CTX + 64 * t; };
            fa::attn_unit<SWA_HD>(P + (size_t)(TL + b * CTX) * EPLD + EC_Q + h * SWA_HD, EPLD, P + EC_K + kv * SWA_HD, EPLD, P + EC_V + kv * SWA_HD, EPLD,
                                  p.ACT + (size_t)(TL + b * CTX) * DM + LRU_W + h * SWA_HD, DM, 4, rowof, fa::NoMask{}, p.e_sink[h] * LOG2E, 1.0f, (FLAS char*)lds);
        }
        SYNC(PH_L0_CARRY);
     TS_END(PH_L0_CARRY); }
    if (REP_PHASE == PH_L0_CARRY && IN(PH_L0_CARRY)) {
        lru::lru_carry_phase(p, lds);
        const bf16_t* P = P_of(p);
        for (int u = bx; u < NB * SWA_H * (SEQ / 256); u += G) {
            const int c = u % 256, i = u / 256, bh = (c % 8) + 8 * i, qb = c / 8, b = bh / SWA_H, h = bh % SWA_H, kv = h / (SWA_H / SWA_KV), q0 = qb * 256;
            auto rowof = [=](int t) -> long { if (t >= 8) return (long)TL + b * CTX + 64 * (t - 8); int k0 = q0 - 128 + 64 * t; k0 = k0 < 0 ? 0 : (k0 > SEQ - 64 ? SEQ - 64 : k0); return (long)b * SEQ + k0; };
            auto mask = [=](fa::f32x16& p0, fa::f32x16& p1, int t, int qrow, int hi) { if (t < 8) { const int d0 = (q0 - 128 + 64 * t + 4 * hi) - (q0 + qrow);
#pragma unroll
                for (int r = 0; r < 16; ++r) { const int d = d0 + (r & 3) + 8 * (r >> 2); const int kp = d + q0 + qrow;
                    if (d < -WINDOW || d > WINDOW || kp < 0 || kp >= SEQ) p0[r] = -1e30f;
                    if (d + 32 < -WINDOW || d + 32 > WINDOW || kp + 32 < 0 || kp + 32 >= SEQ) p1[r] = -1e30f; } } };
            auto act = [](int t, int w) -> bool { return t >= 8 || (64 * t <= 32 * w + 31 + 2 * WINDOW && 64 * t + 63 >= 32 * w); };
            fa::attn_unit<SWA_HD, decltype(rowof), decltype(mask), 0, decltype(act)>(P + (size_t)(b * SEQ + q0) * EPLD + EC_Q + h * SWA_HD, EPLD, P + EC_K + kv * SWA_HD, EPLD, P + EC_V + kv * SWA_HD, EPLD,
                                  p.ACT + (size_t)(b * SEQ + q0) * DM + LRU_W + h * SWA_HD, DM, 12, rowof, mask, p.e_sink[h] * LOG2E, 1.0f, (FLAS char*)lds, act);
        }
        for (int u = bx; u < NB * SWA_H; u += G) {
            const int b = u / SWA_H, h = u % SWA_H, kv = h / (SWA_H / SWA_KV);
            auto rowof = [=](int t) -> long { return (long)TL + b * CTX + 64 * t; };
            fa::attn_unit<SWA_HD>(P + (size_t)(TL + b * CTX) * EPLD + EC_Q + h * SWA_HD, EPLD, P + EC_K + kv * SWA_HD, EPLD, P + EC_V + kv * SWA_HD, EPLD,
                                  p.ACT + (size_t)(TL + b * CTX) * DM + LRU_W + h * SWA_HD, DM, 4, rowof, fa::NoMask{}, p.e_sink[h] * LOG2E, 1.0f, (FLAS char*)lds);
        }
        SYNC(PH_L0_CARRY);
    }
    if (IN(PH_L0_MIX)) { TS_BEGIN(PH_L0_MIX); lru::lru_pass2_light(p); SYNC(PH_L0_MIX);  TS_END(PH_L0_MIX); }
    if (REP_PHASE == PH_L0_MIX && IN(PH_L0_MIX)) { lru::lru_pass2_light(p); SYNC(PH_L0_MIX); }
    if (IN(PH_L0_OUTPROJ)) { TS_BEGIN(PH_L0_OUTPROJ);
        pg8::Gemm g{p.ACT, p.W_eout, TT, DM, DM, DM}; pg8::StaticOrder S; S.init(TT, DM, G, bx);
        pg8::EpiPlain E{P_of(p), DM, p.e_b_out, 0};
        pg8::gemm_phase<pg8::EpiPlain, pg8::StaticOrder, true, true>(lds, g, S, E);
        SYNC(PH_L0_OUTPROJ);
     TS_END(PH_L0_OUTPROJ); }
    if (REP_PHASE == PH_L0_OUTPROJ && IN(PH_L0_OUTPROJ)) {
        pg8::Gemm g{p.ACT, p.W_eout, TT, DM, DM, DM}; pg8::StaticOrder S; S.init(TT, DM, G, bx);
        pg8::EpiPlain E{P_of(p), DM, p.e_b_out, 0};
        pg8::gemm_phase<pg8::EpiPlain, pg8::StaticOrder, true, true>(lds, g, S, E);
        SYNC(PH_L0_OUTPROJ);
    }
    if (IN(PH_L0_LN1)) { TS_BEGIN(PH_L0_LN1); fast::ln1_phase(p, 0, lds); SYNC(PH_L0_LN1);  TS_END(PH_L0_LN1); }
    if (REP_PHASE == PH_L0_LN1 && IN(PH_L0_LN1)) { fast::ln1_phase(p, 0, lds); SYNC(PH_L0_LN1); }
    if (IN(PH_L0_SCATTER)) { TS_BEGIN(PH_L0_SCATTER);    TS_END(PH_L0_SCATTER); }
    if (REP_PHASE == PH_L0_SCATTER && IN(PH_L0_SCATTER)) {   }
    if (IN(PH_L0_MOE1)) { TS_BEGIN(PH_L0_MOE1);
        pg8::Gemm g{p.ACT, p.W_up, CR_MAX, 2 * D_EXP, DM / 2, DM / 2}; pg8::MoeOrder S; S.init(p.cnt, 2 * D_EXP / pg8::BM, G, bx, (PG8_LAS int*)(lds + pg8::STAGE_BYTES), p.slot_tok);
        pg8::EpiMoeUp8 E{(unsigned char*)(p.M + M_H1)};
        pg8::gemm_phase<pg8::EpiMoeUp8, pg8::MoeOrder, true, true, true, true>(lds, g, S, E); SYNC(PH_L0_MOE1);
     TS_END(PH_L0_MOE1); }
    if (REP_PHASE == PH_L0_MOE1 && IN(PH_L0_MOE1)) {
        pg8::Gemm g{p.ACT, p.W_up, CR_MAX, 2 * D_EXP, DM / 2, DM / 2}; pg8::MoeOrder S; S.init(p.cnt, 2 * D_EXP / pg8::BM, G, bx, (PG8_LAS int*)(lds + pg8::STAGE_BYTES), p.slot_tok);
        pg8::EpiMoeUp8 E{(unsigned char*)(p.M + M_H1)};
        pg8::gemm_phase<pg8::EpiMoeUp8, pg8::MoeOrder, true, true, true, true>(lds, g, S, E); SYNC(PH_L0_MOE1);
    }
    if (IN(PH_L0_MOE2)) { TS_BEGIN(PH_L0_MOE2);
        pg8::Gemm g{(const bf16_t*)(p.M + M_H1), p.W_dn, CR_MAX, DM, D_EXP / 2, D_EXP / 2}; pg8::MoeOrder S; S.init(p.cnt, DM / pg8::BM, G, bx, (PG8_LAS int*)(lds + pg8::STAGE_BYTES));
        pg8::EpiScale E{(bf16_t*)(p.M + M_XS), DM, 1.0f / (FP8_SH * FP8_SW2), DM / pg8::BM};
        pg8::gemm_phase<pg8::EpiScale, pg8::MoeOrder, true, true, false, true>(lds, g, S, E); SYNC(PH_L0_MOE2);
     TS_END(PH_L0_MOE2); }
    if (REP_PHASE == PH_L0_MOE2 && IN(PH_L0_MOE2)) {
        pg8::Gemm g{(const bf16_t*)(p.M + M_H1), p.W_dn, CR_MAX, DM, D_EXP / 2, D_EXP / 2}; pg8::MoeOrder S; S.init(p.cnt, DM / pg8::BM, G, bx, (PG8_LAS int*)(lds + pg8::STAGE_BYTES));
        pg8::EpiScale E{(bf16_t*)(p.M + M_XS), DM, 1.0f / (FP8_SH * FP8_SW2), DM / pg8::BM};
        pg8::gemm_phase<pg8::EpiScale, pg8::MoeOrder, true, true, false, true>(lds, g, S, E); SYNC(PH_L0_MOE2);
    }
    if (IN(PH_L0_LN2)) { TS_BEGIN(PH_L0_LN2); fast::ln2_phase(p, 0); SYNC(PH_L0_LN2);  TS_END(PH_L0_LN2); }
    if (REP_PHASE == PH_L0_LN2 && IN(PH_L0_LN2)) { fast::ln2_phase(p, 0); SYNC(PH_L0_LN2); }
    if (IN(PH_L1_INPROJ)) { TS_BEGIN(PH_L1_INPROJ);
        pg8::Gemm g{p.ACT, p.W_oin, TT, OPLD, DM, DM}; pg8::StaticOrder S; S.init(TT, OPLD, G, bx);
        pg8::EpiInO E{P_of(p), p.o_b_in, p.ROPE_MLA, p.SSQ, (bf16_t*)(p.M + M_K)};
        pg8::gemm_phase<pg8::EpiInO, pg8::StaticOrder, true, true>(lds, g, S, E); SYNC(PH_L1_INPROJ);
     TS_END(PH_L1_INPROJ); }
    if (REP_PHASE == PH_L1_INPROJ && IN(PH_L1_INPROJ)) {
        pg8::Gemm g{p.ACT, p.W_oin, TT, OPLD, DM, DM}; pg8::StaticOrder S; S.init(TT, OPLD, G, bx);
        pg8::EpiInO E{P_of(p), p.o_b_in, p.ROPE_MLA, p.SSQ, (bf16_t*)(p.M + M_K)};
        pg8::gemm_phase<pg8::EpiInO, pg8::StaticOrder, true, true>(lds, g, S, E); SYNC(PH_L1_INPROJ);
    }
    if (IN(PH_L1_UP)) { TS_BEGIN(PH_L1_UP);
        conf::conf_phase(p, lds);
#ifndef DBG_NO_UQ
        { pg8::Gemm g{P_of(p), p.W_uq, TL, MLA_H * MLA_QD, MLA_QR, OPLD}; pg8::StaticOrder S; S.init(TL, MLA_H * MLA_QD, G, bx);
          pg8::EpiUq E{(bf16_t*)(p.M + M_Q), p.ROPE_MLA, p.SSQ};
          pg8::gemm_phase<pg8::EpiUq, pg8::StaticOrder, true, true>(lds, g, S, E); }
#endif
#ifndef DBG_NO_UKV
        { pg8::Gemm g{P_of(p) + OC_CKV, p.W_ukv, TT, MLA_H * (MLA_NOPE + MLA_V), MLA_KVR, OPLD}; pg8::StaticOrder S; S.init(TT, MLA_H * (MLA_NOPE + MLA_V), G, bx);
          pg8::EpiUkv E{(bf16_t*)(p.M + M_K), (bf16_t*)(p.M + M_V), p.SSQ};
          pg8::gemm_phase<pg8::EpiUkv, pg8::StaticOrder, true, true>(lds, g, S, E); }
#endif
        SYNC(PH_L1_UP);
     TS_END(PH_L1_UP); }
    if (REP_PHASE == PH_L1_UP && IN(PH_L1_UP)) {
        conf::conf_phase(p, lds);
#ifndef DBG_NO_UQ
        { pg8::Gemm g{P_of(p), p.W_uq, TL, MLA_H * MLA_QD, MLA_QR, OPLD}; pg8::StaticOrder S; S.init(TL, MLA_H * MLA_QD, G, bx);
          pg8::EpiUq E{(bf16_t*)(p.M + M_Q), p.ROPE_MLA, p.SSQ};
          pg8::gemm_phase<pg8::EpiUq, pg8::StaticOrder, true, true>(lds, g, S, E); }
#endif
#ifndef DBG_NO_UKV
        { pg8::Gemm g{P_of(p) + OC_CKV, p.W_ukv, TT, MLA_H * (MLA_NOPE + MLA_V), MLA_KVR, OPLD}; pg8::StaticOrder S; S.init(TT, MLA_H * (MLA_NOPE + MLA_V), G, bx);
          pg8::EpiUkv E{(bf16_t*)(p.M + M_K), (bf16_t*)(p.M + M_V), p.SSQ};
          pg8::gemm_phase<pg8::EpiUkv, pg8::StaticOrder, true, true>(lds, g, S, E); }
#endif
        SYNC(PH_L1_UP);
    }
    if (IN(PH_L1_ATTN)) { TS_BEGIN(PH_L1_ATTN);
        const bf16_t* Q = (const bf16_t*)(p.M + M_Q); const bf16_t* Kb = (const bf16_t*)(p.M + M_K); const bf16_t* V = (const bf16_t*)(p.M + M_V);
        for (int u = bx; u < NB * MLA_H * (SEQ / 256); u += G) {
            const int c = u % 256, i = u / 256, bh = (c % 8) + 8 * i, qb = c / 8, b = bh / MLA_H, h = bh % MLA_H, q0 = qb * 256;
            auto rowof = [=](int t) -> long { return t < CTX / 64 ? (long)TL + b * CTX + 64 * t : (long)b * SEQ + 64 * (t - CTX / 64); };
            fa::attn_unit<MLA_QD>(Q + (size_t)(b * SEQ + q0) * MLA_H * MLA_QD + h * MLA_QD, MLA_H * MLA_QD, Kb + h * MLA_QD, MLA_H * MLA_QD, V + h * MLA_V, MLA_H * MLA_V,
                                  p.ACT + (size_t)(b * SEQ + q0) * DM + h * MLA_V, DM, (CTX + SEQ) / 64, rowof, fa::NoMask{}, -1e30f, 0.0f, (FLAS char*)lds);
        }
        SYNC(PH_L1_ATTN);
     TS_END(PH_L1_ATTN); }
    if (REP_PHASE == PH_L1_ATTN && IN(PH_L1_ATTN)) {
        const bf16_t* Q = (const bf16_t*)(p.M + M_Q); const bf16_t* Kb = (const bf16_t*)(p.M + M_K); const bf16_t* V = (const bf16_t*)(p.M + M_V);
        for (int u = bx; u < NB * MLA_H * (SEQ / 256); u += G) {
            const int c = u % 256, i = u / 256, bh = (c % 8) + 8 * i, qb = c / 8, b = bh / MLA_H, h = bh % MLA_H, q0 = qb * 256;
            auto rowof = [=](int t) -> long { return t < CTX / 64 ? (long)TL + b * CTX + 64 * t : (long)b * SEQ + 64 * (t - CTX / 64); };
            fa::attn_unit<MLA_QD, decltype(rowof), fa::NoMask, ATT_VAR>(Q + (size_t)(b * SEQ + q0) * MLA_H * MLA_QD + h * MLA_QD, MLA_H * MLA_QD, Kb + h * MLA_QD, MLA_H * MLA_QD, V + h * MLA_V, MLA_H * MLA_V,
                                  (bf16_t*)P_of(p), 64, (CTX + SEQ) / 64, rowof, fa::NoMask{}, -1e30f, 0.0f, (FLAS char*)lds);
        }
        SYNC(PH_L1_ATTN);
    }
    if (IN(PH_L1_OUTPROJ)) { TS_BEGIN(PH_L1_OUTPROJ);
        pg8::Gemm g{p.ACT, p.W_oout, TL, DM, DM, DM}; pg8::StaticOrder S; S.init(TL, DM, G, bx);
        pg8::EpiPlain E{P_of(p), DM, p.o_b_out, 0};
        pg8::gemm_phase<pg8::EpiPlain, pg8::StaticOrder, true, true>(lds, g, S, E); SYNC(PH_L1_OUTPROJ);
     TS_END(PH_L1_OUTPROJ); }
    if (REP_PHASE == PH_L1_OUTPROJ && IN(PH_L1_OUTPROJ)) {
        pg8::Gemm g{p.ACT, p.W_oout, TL, DM, DM, DM}; pg8::StaticOrder S; S.init(TL, DM, G, bx);
        pg8::EpiPlain E{P_of(p), DM, p.o_b_out, 0};
        pg8::gemm_phase<pg8::EpiPlain, pg8::StaticOrder, true, true>(lds, g, S, E); SYNC(PH_L1_OUTPROJ);
    }
    if (IN(PH_L1_LN1)) { TS_BEGIN(PH_L1_LN1); fast::ln1_phase(p, 1, lds); SYNC(PH_L1_LN1);  TS_END(PH_L1_LN1); }
    if (REP_PHASE == PH_L1_LN1 && IN(PH_L1_LN1)) { fast::ln1_phase(p, 1, lds); SYNC(PH_L1_LN1); }
    if (IN(PH_L1_SCATTER)) { TS_BEGIN(PH_L1_SCATTER);    TS_END(PH_L1_SCATTER); }
    if (REP_PHASE == PH_L1_SCATTER && IN(PH_L1_SCATTER)) {   }
    if (IN(PH_L1_MOE1)) { TS_BEGIN(PH_L1_MOE1);
        pg8::Gemm g{p.ACT, p.W_up + (size_t)N_EXP * 2 * D_EXP * DM / 2, CR_MAX, 2 * D_EXP, DM / 2, DM / 2}; pg8::MoeOrder S; S.init(p.cnt + N_EXP * CS, 2 * D_EXP / pg8::BM, G, bx, (PG8_LAS int*)(lds + pg8::STAGE_BYTES), p.slot_tok);
        pg8::EpiMoeUp8 E{(unsigned char*)(p.M + M_H1)};
        pg8::gemm_phase<pg8::EpiMoeUp8, pg8::MoeOrder, true, true, true, true>(lds, g, S, E); SYNC(PH_L1_MOE1);
     TS_END(PH_L1_MOE1); }
    if (REP_PHASE == PH_L1_MOE1 && IN(PH_L1_MOE1)) {
        pg8::Gemm g{p.ACT, p.W_up + (size_t)N_EXP * 2 * D_EXP * DM / 2, CR_MAX, 2 * D_EXP, DM / 2, DM / 2}; pg8::MoeOrder S; S.init(p.cnt + N_EXP * CS, 2 * D_EXP / pg8::BM, G, bx, (PG8_LAS int*)(lds + pg8::STAGE_BYTES), p.slot_tok);
        pg8::EpiMoeUp8 E{(unsigned char*)(p.M + M_H1)};
        pg8::gemm_phase<pg8::EpiMoeUp8, pg8::MoeOrder, true, true, true, true>(lds, g, S, E); SYNC(PH_L1_MOE1);
    }
    if (IN(PH_L1_MOE2)) { TS_BEGIN(PH_L1_MOE2);
        pg8::Gemm g{(const bf16_t*)(p.M + M_H1), p.W_dn + (size_t)N_EXP * DM * D_EXP / 2, CR_MAX, DM, D_EXP / 2, D_EXP / 2}; pg8::MoeOrder S; S.init(p.cnt + N_EXP * CS, DM / pg8::BM, G, bx, (PG8_LAS int*)(lds + pg8::STAGE_BYTES));
        pg8::EpiScale E{(bf16_t*)(p.M + M_XS), DM, 1.0f / (FP8_SH * FP8_SW2), DM / pg8::BM};
        pg8::gemm_phase<pg8::EpiScale, pg8::MoeOrder, true, true, false, true>(lds, g, S, E); SYNC(PH_L1_MOE2);
     TS_END(PH_L1_MOE2); }
    if (REP_PHASE == PH_L1_MOE2 && IN(PH_L1_MOE2)) {
        pg8::Gemm g{(const bf16_t*)(p.M + M_H1), p.W_dn + (size_t)N_EXP * DM * D_EXP / 2, CR_MAX, DM, D_EXP / 2, D_EXP / 2}; pg8::MoeOrder S; S.init(p.cnt + N_EXP * CS, DM / pg8::BM, G, bx, (PG8_LAS int*)(lds + pg8::STAGE_BYTES));
        pg8::EpiScale E{(bf16_t*)(p.M + M_XS), DM, 1.0f / (FP8_SH * FP8_SW2), DM / pg8::BM};
        pg8::gemm_phase<pg8::EpiScale, pg8::MoeOrder, true, true, false, true>(lds, g, S, E); SYNC(PH_L1_MOE2);
    }
    if (IN(PH_L1_LN2)) { TS_BEGIN(PH_L1_LN2); fast::ln2_phase(p, 1);
        SYNC(PH_L1_LN2);  TS_END(PH_L1_LN2); }
    if (REP_PHASE == PH_L1_LN2 && IN(PH_L1_LN2)) { fast::ln2_phase(p, 1);
        SYNC(PH_L1_LN2); }
    if (TS_PHASE >= 0 && TS_ME) { const unsigned long long t0 = __builtin_amdgcn_s_memrealtime(); const unsigned long long dt4 = 4ull * TS_SLOT[1]; while (__builtin_amdgcn_s_memrealtime() - t0 < dt4) __builtin_amdgcn_s_sleep(8); }
#undef gtid
#undef gsize
}

extern "C" void kernel_launch(void* const* d_in, const int* in_sizes, int n_in, void* d_out, int out_size, void* d_ws, size_t ws_size, hipStream_t stream) {
    static int grid_blocks = 0;
    if (!grid_blocks) {
        int dev = 0, cus = 0, per_cu = 0;
        (void)hipGetDevice(&dev);
        (void)hipDeviceGetAttribute(&cus, hipDeviceAttributeMultiprocessorCount, dev);
        (void)hipFuncSetAttribute((const void*)mega, hipFuncAttributeMaxDynamicSharedMemorySize, LDS_BYTES);
        (void)hipOccupancyMaxActiveBlocksPerMultiprocessor(&per_cu, mega, 512, LDS_BYTES);
        if (per_cu < 1) { fprintf(stderr, "occupancy query says %d blocks per CU\n", per_cu); per_cu = 1; }
        grid_blocks = cus;
    }
    Params p{};
    const size_t need = fill_params(p, d_in, d_out, d_ws);
    if (need > ws_size) { fprintf(stderr, "workspace too small: need %zu have %zu\n", need, ws_size); return; }
    p.ph_lo = 0; p.ph_hi = N_PHASES - 1;
    (void)hipMemsetAsync(p.bar, 0, 16384, stream);
    void* args[] = {&p};
    hipError_t e = hipLaunchCooperativeKernel((void*)mega, dim3(grid_blocks), dim3(512), args, LDS_BYTES, stream);
    if (e != hipSuccess) fprintf(stderr, "cooperative launch failed: %s (grid %d)\n", hipGetErrorString(e), grid_blocks);
}
#endif
```

```cpp
#ifndef CPU_SIM
#include <hip/hip_runtime.h>
#include <hip/hip_cooperative_groups.h>
#include <cstdio>
namespace cg = cooperative_groups;
#define DEV __device__ __forceinline__
#else
#define DEV inline
#endif
#include <cstdint>
#include <cmath>

#ifdef SIM_SMALL
constexpr int DM = 192, NB = 2, SEQ = 512, CTX = 64, GRID_W = 64;
constexpr int LRU_W = 64, LRU_NBLK = 8, SWA_H = 8, SWA_KV = 2, SWA_HD = 16, WINDOW = 128;
constexpr int MLA_H = 8, MLA_QR = 32, MLA_KVR = 16, MLA_NOPE = 16, MLA_ROPE = 8, MLA_V = 16;
constexpr int CONF_CH = 64, CONF_K = 31, N_GROUPS = 4, EPG = 8, D_EXP = 32;
constexpr int MOE_PAD = 4;
constexpr int OPLD = 224;
#else
constexpr int DM = 1024, NB = 4, SEQ = 8192, CTX = 256, GRID_W = 64;
constexpr int LRU_W = 512, LRU_NBLK = 8, SWA_H = 8, SWA_KV = 2, SWA_HD = 64, WINDOW = 128;
constexpr int MLA_H = 8, MLA_QR = 256, MLA_KVR = 128, MLA_NOPE = 64, MLA_ROPE = 32, MLA_V = 64;
constexpr int CONF_CH = 512, CONF_K = 31, N_GROUPS = 4, EPG = 8, D_EXP = 512;
constexpr int MOE_PAD = 256;
constexpr int OPLD = 1536;
#endif
constexpr int LRU_BD = LRU_W / LRU_NBLK;
constexpr int SWA_Q = SWA_H * SWA_HD, SWA_KVW = SWA_KV * SWA_HD;
constexpr int EVEN_IN = 2 * LRU_W + SWA_Q + 2 * SWA_KVW, EVEN_MIX = LRU_W + SWA_Q;
constexpr int MLA_QD = MLA_NOPE + MLA_ROPE;
constexpr int ODD_IN = MLA_QR + MLA_KVR + MLA_ROPE + 2 * CONF_CH, ODD_MIX = MLA_H * MLA_V + CONF_CH;
constexpr int N_EXP = N_GROUPS * EPG;
constexpr int TL = NB * SEQ, TC = NB * CTX, TT = TL + TC;
constexpr int EPLD = EVEN_IN;
constexpr int CR_MAX = ((2 * TT + N_EXP * (MOE_PAD - 1)) / MOE_PAD + 1) * MOE_PAD;
constexpr int CS = 32;
constexpr float LN_EPS = 1e-6f, LRU_C = 8.0f;
constexpr float DN_ALPHA = 1.41421356237309515f;
constexpr float LOG2E = 1.4426950408889634f;
static_assert(EVEN_MIX == DM && ODD_MIX == DM && OPLD >= ODD_IN, "mixer widths");
constexpr int EC_G = 0, EC_U = LRU_W, EC_Q = 2 * LRU_W, EC_K = EC_Q + SWA_Q, EC_V = EC_K + SWA_KVW;
constexpr int OC_CKV = MLA_QR, OC_KPE = MLA_QR + MLA_KVR, OC_A = OC_KPE + MLA_ROPE, OC_G = OC_A + CONF_CH;

typedef unsigned short bf16_t;
DEV bf16_t f2bf(float f) { unsigned u; __builtin_memcpy(&u, &f, 4); u = (u + 0x7fffu + ((u >> 16) & 1u)) >> 16; return (bf16_t)u; }
DEV float bf2f(bf16_t h) { unsigned u = ((unsigned)h) << 16; float f; __builtin_memcpy(&f, &u, 4); return f; }
struct alignas(16) U128 { unsigned a, b, c, d; };

struct Params {
    const float *x, *c, *ctx, *c_ctx, *w_mod, *b_mod, *ln_g, *ln_b;
    const float *e_w_in, *e_b_in, *e_conv_w, *e_conv_b, *e_wa, *e_ba, *e_wx, *e_bx, *e_lam, *e_sink, *e_w_out, *e_b_out;
    const float *o_w_in, *o_b_in, *o_q_norm, *o_kv_norm, *o_w_uq, *o_w_uk, *o_w_uv, *o_dw_w, *o_dw_b, *o_cln_g, *o_cln_b, *o_w_out, *o_b_out;
    const float *moe_wg, *moe_bg, *moe_wr, *moe_br, *moe_w1, *moe_w3, *moe_w2;
    float* out;
    float* MOD;
    float* XC;
    float* ROPE_SWA;
    float* ROPE_MLA;
    float* SSQ;
    bf16_t* ACT;
    unsigned char* M;
    bf16_t *W_ein, *W_eout, *W_oin, *W_oout, *W_uq, *W_ukv, *W_up, *W_dn;
    int* cnt;
    int* tok_e;
    int* tok_pos;
    float* tok_gate;
    int* tok_row;
    int* slot_tok;
    unsigned* bar;
    bf16_t* LRUW;
    float* LRUC;
    float* WTR;
    bf16_t* WRH;
    bf16_t* WRL;
    int ph_lo, ph_hi;
};
constexpr size_t M_P = 0;
constexpr size_t M_P_END = (size_t)TT * EPLD * 2;
constexpr size_t M_UC = M_P_END;
constexpr size_t M_REC = M_UC + (size_t)TT * LRU_W * 4;
constexpr int LRU_CH = 32, LRU_NV = (SEQ + CTX) / LRU_CH;
constexpr size_t M_GW = M_UC;
constexpr size_t M_SUM = M_REC + (size_t)TT * LRU_W * 4;
constexpr size_t M_HIN = M_SUM + (size_t)NB * 2 * LRU_NV * LRU_W * 8;
constexpr size_t M_L0_END = M_HIN + (size_t)NB * 2 * LRU_NV * LRU_W * 4;
constexpr size_t M_Q = M_P_END;
constexpr size_t M_K = M_Q + (size_t)TL * MLA_H * MLA_QD * 2;
constexpr size_t M_V = M_K + (size_t)TT * MLA_H * MLA_QD * 2;
constexpr size_t M_CV = M_V + (size_t)TT * MLA_H * MLA_V * 2;
constexpr size_t M_L1_END = M_CV + (size_t)TL * CONF_CH * 2;
constexpr float FP8_SF = 4.0f, FP8_SW1 = 128.0f, FP8_SH = 4.0f, FP8_SW2 = 64.0f, FP8_SY = 16.0f;
constexpr size_t M_XS = 0;
constexpr size_t M_H1 = (size_t)CR_MAX * DM * 2;
constexpr size_t M_MOE_END = M_H1 + (size_t)CR_MAX * D_EXP * 2;
constexpr size_t cmax3(size_t a, size_t b, size_t c) { return a > b ? (a > c ? a : c) : (b > c ? b : c); }
constexpr size_t M_BYTES = cmax3(M_L0_END, M_L1_END, M_MOE_END);

DEV float sigmoidf_(float v) { return 1.0f / (1.0f + expf(-v)); }
DEV float siluf_(float v) { return v * sigmoidf_(v); }
DEV float geluf_(float v) { return 0.5f * v * (1.0f + tanhf(0.7978845608028654f * (v + 0.044715f * v * v * v))); }
DEV float softplusf_(float v) { return v > 20.f ? v : log1pf(expf(v)); }
DEV int cond_of_row(int r) { return r < TL ? r / SEQ : NB; }
DEV bf16_t* P_of(const Params& p) { return (bf16_t*)(p.M + M_P); }

DEV void ph_misc_body(const Params& p, long gtid, long gsize);
DEV void ph_misc(const Params& p, long gtid, long gsize) { ph_misc_body(p, gtid, gsize); }
DEV void ph_mod(const Params& p, long gtid, long gsize) {
    const long total = 2L * (NB + 1) * 6 * DM;
    for (long i = gtid; i < total; i += gsize) {
        const int j = (int)(i % (6 * DM)); const int cn = (int)((i / (6 * DM)) % (NB + 1)); const int l = (int)(i / ((long)6 * DM * (NB + 1)));
        const float* cond = cn < NB ? p.c + (size_t)cn * DM : p.c_ctx;
        const float* w = p.w_mod + (size_t)l * DM * 6 * DM;
        float acc = p.b_mod[(size_t)l * 6 * DM + j];
        for (int k = 0; k < DM; ++k) acc += siluf_(cond[k]) * w[(size_t)k * 6 * DM + j];
        p.MOD[i] = acc;
    }
    ph_misc(p, gtid, gsize);
}
DEV void ph_misc_body(const Params& p, long gtid, long gsize) {
    constexpr long N1 = 2L * 64 * DM, N3 = (long)2 * LRU_NBLK * 2 * LRU_BD * LRU_BD, N4 = 2L * LRU_W;
    { const bool h1 = gtid < N1, h3 = gtid < N3, h4 = gtid < N4; float w1 = 0.f, w3 = 0.f, a4 = 0.f, b4 = 0.f, c4 = 0.f;
      if (h1) { const long i = gtid; const int d = (int)(i % DM), j = (int)((i / DM) % 64), l = (int)(i / ((long)DM * 64));
          if (j < N_GROUPS) w1 = p.moe_wg[((size_t)l * DM + d) * N_GROUPS + j]; else if (j < N_GROUPS + N_EXP) w1 = p.moe_wr[((size_t)l * DM + d) * N_EXP + (j - N_GROUPS)]; }
      if (h3) { const long i = gtid; const int k = (int)(i % LRU_BD), n = (int)((i / LRU_BD) % LRU_BD), m = (int)((i / (LRU_BD * LRU_BD)) % 2), db = (int)(i / (2 * LRU_BD * LRU_BD));
          w3 = (m ? p.e_wx : p.e_wa)[((size_t)db * LRU_BD + k) * LRU_BD + n]; }
      if (h4) { a4 = p.e_ba[gtid]; b4 = p.e_bx[gtid]; c4 = p.e_lam[gtid]; }
      asm volatile("" ::: "memory");
      if (h1) { const bf16_t h = f2bf(w1); p.WRH[gtid] = h; p.WRL[gtid] = f2bf(w1 - bf2f(h)); }
      if (h3) p.LRUW[gtid] = f2bf(w3);
      if (h4) { p.LRUC[3 * gtid] = a4; p.LRUC[3 * gtid + 1] = b4; p.LRUC[3 * gtid + 2] = softplusf_(-c4); } }
    for (long i = gtid + gsize; i < N1; i += gsize) { const int d = (int)(i % DM), j = (int)((i / DM) % 64), l = (int)(i / ((long)DM * 64)); float w = 0.f;
        if (j < N_GROUPS) w = p.moe_wg[((size_t)l * DM + d) * N_GROUPS + j]; else if (j < N_GROUPS + N_EXP) w = p.moe_wr[((size_t)l * DM + d) * N_EXP + (j - N_GROUPS)];
        const bf16_t h = f2bf(w); p.WRH[i] = h; p.WRL[i] = f2bf(w - bf2f(h)); }
    for (long i = gtid + gsize; i < N3; i += gsize) {
        const int k = (int)(i % LRU_BD), n = (int)((i / LRU_BD) % LRU_BD), m = (int)((i / (LRU_BD * LRU_BD)) % 2), db = (int)(i / (2 * LRU_BD * LRU_BD));
        p.LRUW[i] = f2bf((m ? p.e_wx : p.e_wa)[((size_t)db * LRU_BD + k) * LRU_BD + n]); }
    for (long i = gtid + gsize; i < N4; i += gsize) { p.LRUC[3 * i] = p.e_ba[i]; p.LRUC[3 * i + 1] = p.e_bx[i]; p.LRUC[3 * i + 2] = softplusf_(-p.e_lam[i]); }
    for (long i = gtid; i < 2 * N_EXP * CS; i += gsize) p.cnt[i] = 0;
    for (long i = gsize - 1 - gtid; i < 128L * (SWA_HD / 4); i += gsize) { const int pos = (int)(i / (SWA_HD / 4)), k = (int)(i % (SWA_HD / 4)); const float ang = (float)pos * powf(10000.0f, -(float)k / (float)(SWA_HD / 4)); p.ROPE_SWA[2 * i] = cosf(ang); p.ROPE_SWA[2 * i + 1] = sinf(ang); }
    for (long i = gsize - 1 - gtid; i < 128L * (MLA_ROPE / 4); i += gsize) { const int pos = (int)(i / (MLA_ROPE / 4)), k = (int)(i % (MLA_ROPE / 4)); const float ang = (float)pos * powf(10000.0f, -(float)k / (float)(MLA_ROPE / 4)); p.ROPE_MLA[2 * i] = cosf(ang); p.ROPE_MLA[2 * i + 1] = sinf(ang); }
}
DEV void cvt_T(const float* src, int K, int Nsrc, int N, const float* scale, bf16_t* dst, long gtid, long gsize) {
    for (long i = gtid; i < (long)N * K; i += gsize) { const int k = (int)(i % K), n = (int)(i / K); dst[i] = n < Nsrc ? f2bf(src[(size_t)k * Nsrc + n] * (scale ? scale[k] : 1.0f)) : (bf16_t)0; }
}
constexpr int UPG = D_EXP < 128 ? D_EXP : 128;
DEV void cvt_up(const float* w1, const float* w3, bf16_t* dst, long gtid, long gsize) {
    for (long i = gtid; i < (long)N_EXP * 2 * D_EXP * DM; i += gsize) {
        const int k = (int)(i % DM); const int vr = (int)((i / DM) % (2 * D_EXP)); const int e = (int)(i / ((long)DM * 2 * D_EXP));
        const int grp = vr / (2 * UPG), w = (vr / UPG) & 1, j = grp * UPG + vr % UPG;
        const float* src = w ? w3 : w1; dst[i] = f2bf(src[((size_t)e * DM + k) * D_EXP + j]);
    }
}
DEV void ph_weights_small_naive(const Params& p, long gtid, long gsize) {
    cvt_T(p.e_w_in, DM, EVEN_IN, EVEN_IN, nullptr, p.W_ein, gtid, gsize);
    cvt_T(p.e_w_out, DM, DM, DM, nullptr, p.W_eout, gtid, gsize);
    cvt_T(p.o_w_in, DM, ODD_IN, OPLD, nullptr, p.W_oin, gtid, gsize);
    cvt_T(p.o_w_out, DM, DM, DM, nullptr, p.W_oout, gtid, gsize);
    cvt_T(p.o_w_uq, MLA_QR, MLA_H * MLA_QD, MLA_H * MLA_QD, p.o_q_norm, p.W_uq, gtid, gsize);
    cvt_T(p.o_w_uk, MLA_KVR, MLA_H * MLA_NOPE, MLA_H * MLA_NOPE, p.o_kv_norm, p.W_ukv, gtid, gsize);
    cvt_T(p.o_w_uv, MLA_KVR, MLA_H * MLA_V, MLA_H * MLA_V, p.o_kv_norm, p.W_ukv + (size_t)MLA_H * MLA_NOPE * MLA_KVR, gtid, gsize);
}
DEV void ph_weights_naive(const Params& p, long gtid, long gsize) {
    cvt_T(p.e_w_in, DM, EVEN_IN, EVEN_IN, nullptr, p.W_ein, gtid, gsize);
    cvt_T(p.e_w_out, DM, DM, DM, nullptr, p.W_eout, gtid, gsize);
    cvt_T(p.o_w_in, DM, ODD_IN, OPLD, nullptr, p.W_oin, gtid, gsize);
    cvt_T(p.o_w_out, DM, DM, DM, nullptr, p.W_oout, gtid, gsize);
    cvt_T(p.o_w_uq, MLA_QR, MLA_H * MLA_QD, MLA_H * MLA_QD, p.o_q_norm, p.W_uq, gtid, gsize);
    cvt_T(p.o_w_uk, MLA_KVR, MLA_H * MLA_NOPE, MLA_H * MLA_NOPE, p.o_kv_norm, p.W_ukv, gtid, gsize);
    cvt_T(p.o_w_uv, MLA_KVR, MLA_H * MLA_V, MLA_H * MLA_V, p.o_kv_norm, p.W_ukv + (size_t)MLA_H * MLA_NOPE * MLA_KVR, gtid, gsize);
    for (int l = 0; l < 2; ++l) {
        cvt_up(p.moe_w1 + (size_t)l * N_EXP * DM * D_EXP, p.moe_w3 + (size_t)l * N_EXP * DM * D_EXP, p.W_up + (size_t)l * N_EXP * 2 * D_EXP * DM, gtid, gsize);
        for (int e = 0; e < N_EXP; ++e) cvt_T(p.moe_w2 + ((size_t)l * N_EXP + e) * D_EXP * DM, D_EXP, DM, DM, nullptr, p.W_dn + ((size_t)l * N_EXP + e) * DM * D_EXP, gtid, gsize);
    }
}
DEV void ph_modulate0(const Params& p, long gtid, long gsize) {
    const long total = (long)TT * DM;
    for (long i = gtid; i < total; i += gsize) {
        const int r = (int)(i / DM), d = (int)(i % DM);
        const float* xin = r < TL ? p.x + (size_t)r * DM : p.ctx + (size_t)(r - TL) * DM;
        const float* m = p.MOD + ((size_t)cond_of_row(r)) * 6 * DM;
        p.ACT[i] = f2bf(xin[d] * (1.0f + m[DM + d]) + m[d]);
    }
}
template <class Epi>
DEV void gemm_naive(const bf16_t* A, int lda, const bf16_t* Bt, int K, int M, int N, const Epi& E, long gtid, long gsize) {
    const long total = (long)(M / 4) * N;
    for (long i = gtid; i < total; i += gsize) {
        const int n = (int)(i % N); const int mm = (int)(i / N) * 4;
        float acc[4] = {0.f, 0.f, 0.f, 0.f};
        for (int k = 0; k < K; ++k) { const float b = bf2f(Bt[(size_t)n * K + k]);
#pragma unroll
            for (int a = 0; a < 4; ++a) acc[a] += bf2f(A[(size_t)(mm + a) * lda + k]) * b; }
#pragma unroll
        for (int a = 0; a < 4; ++a) E(mm + a, n, acc[a]);
    }
}
constexpr float SWA_QSCALE = LOG2E / (SWA_HD == 64 ? 8.0f : 4.0f);
struct EpiInE_naive { const Params* p; DEV void operator()(int m, int n, float acc) const { P_of(*p)[(size_t)m * EPLD + n] = f2bf(acc + p->e_b_in[n]); } };
DEV void ph_rope_swa(const Params& p, long gtid, long gsize) {
    bf16_t* P = P_of(p); constexpr int half = SWA_HD / 4, NH = SWA_H + SWA_KV;
    const long total = (long)TT * NH * 2 * half;
    for (long i = gtid; i < total; i += gsize) {
        const int pi = (int)(i % half); const int part = (int)((i / half) % 2); const int hh = (int)((i / (2 * half)) % NH); const int r = (int)(i / ((long)2 * half * NH));
        bf16_t* v = P + (size_t)r * EPLD + EC_Q + hh * SWA_HD + part * (SWA_HD / 2);
        float cs = 1.f, sn = 0.f;
        if (r < TL) { const int s = r % SEQ; const int pos = part == 0 ? s / GRID_W : s % GRID_W; cs = p.ROPE_SWA[2 * (pos * half + pi)]; sn = p.ROPE_SWA[2 * (pos * half + pi) + 1]; }
        const float sc = hh < SWA_H ? SWA_QSCALE : 1.0f;
        const float x1 = bf2f(v[pi]), x2 = bf2f(v[half + pi]);
        v[pi] = f2bf((x1 * cs - x2 * sn) * sc); v[half + pi] = f2bf((x1 * sn + x2 * cs) * sc);
    }
}
DEV void seq_bounds(int r, int& lo, int& hi) { if (r < TL) { lo = (r / SEQ) * SEQ; hi = lo + SEQ; } else { lo = TL + ((r - TL) / CTX) * CTX; hi = lo + CTX; } }
DEV void ph_conv4(const Params& p, long gtid, long gsize) {
    float* UC = (float*)(p.M + M_UC); const bf16_t* P = P_of(p);
    for (long i = gtid; i < (long)TT * LRU_W; i += gsize) {
        const int r = (int)(i / LRU_W), c = (int)(i % LRU_W); int lo, hi; seq_bounds(r, lo, hi);
        float acc = p.e_conv_b[c];
#pragma unroll
        for (int j = 0; j < 4; ++j) { const int rr = r + j - 1; if (rr >= lo && rr < hi) acc += p.e_conv_w[j * LRU_W + c] * bf2f(P[(size_t)rr * EPLD + EC_U + c]); }
        UC[i] = acc;
    }
}
DEV void lru_gate(const Params& p, const float* UC, int row, int d, int c, float& a, float& b) {
    const int blk = c / LRU_BD, cd = c % LRU_BD;
    const float* wa = p.e_wa + ((size_t)(d * LRU_NBLK + blk) * LRU_BD) * LRU_BD + cd;
    const float* wx = p.e_wx + ((size_t)(d * LRU_NBLK + blk) * LRU_BD) * LRU_BD + cd;
    const float* u = UC + (size_t)row * LRU_W + blk * LRU_BD;
    float ra = p.e_ba[d * LRU_W + c], ri = p.e_bx[d * LRU_W + c];
    for (int k = 0; k < LRU_BD; ++k) { ra += u[k] * wa[(size_t)k * LRU_BD]; ri += u[k] * wx[(size_t)k * LRU_BD]; }
    const float r = sigmoidf_(ra), ii = sigmoidf_(ri);
    const float log_a = -LRU_C * r * softplusf_(-p.e_lam[d * LRU_W + c]);
    a = expf(log_a); b = sqrtf(-expm1f(2.0f * log_a)) * (ii * UC[(size_t)row * LRU_W + c]);
}
DEV void ph_scan(const Params& p, long gtid, long gsize) {
    const float* UC = (const float*)(p.M + M_UC); float* REC = (float*)(p.M + M_REC); const bf16_t* P = P_of(p); bf16_t* MIX = p.ACT;
    for (long i = gtid; i < (long)NB * LRU_W; i += gsize) {
        const int b = (int)(i / LRU_W), c = (int)(i % LRU_W);
        float h = 0.f, a, bb;
        for (int s = 0; s < CTX; ++s) { const int row = TL + b * CTX + s; lru_gate(p, UC, row, 0, c, a, bb); h = a * h + bb; REC[(size_t)row * LRU_W + c] = h; }
        for (int s = 0; s < SEQ; ++s) { const int row = b * SEQ + s; lru_gate(p, UC, row, 0, c, a, bb); h = a * h + bb; REC[(size_t)row * LRU_W + c] = h; }
        h = 0.f;
        for (int s = CTX - 1; s >= 0; --s) { const int row = TL + b * CTX + s; lru_gate(p, UC, row, 1, c, a, bb); h = a * h + bb; MIX[(size_t)row * DM + c] = f2bf((REC[(size_t)row * LRU_W + c] + h) * geluf_(bf2f(P[(size_t)row * EPLD + EC_G + c]))); }
        for (int s = SEQ - 1; s >= 0; --s) { const int row = b * SEQ + s; lru_gate(p, UC, row, 1, c, a, bb); h = a * h + bb; MIX[(size_t)row * DM + c] = f2bf((REC[(size_t)row * LRU_W + c] + h) * geluf_(bf2f(P[(size_t)row * EPLD + EC_G + c]))); }
    }
}

DEV void lru_chunk_geom(int u, int& b, int& row0, int& seq_lo, int& seq_hi, int& v0, int& v1) {
    b = u / LRU_NV; const int ci = u % LRU_NV; constexpr int NC = CTX / LRU_CH, NL = SEQ / LRU_CH;
    if (ci < NC) { seq_lo = TL + b * CTX; seq_hi = seq_lo + CTX; row0 = seq_lo + ci * LRU_CH; v0 = ci; v1 = NC - 1 - ci; }
    else { const int rc = ci - NC; seq_lo = b * SEQ; seq_hi = seq_lo + SEQ; row0 = seq_lo + rc * LRU_CH; v0 = NC + rc; v1 = NC + (NL - 1 - rc); }
}
DEV float lru_conv(const Params& p, const bf16_t* P, int row, int c, int lo, int hi) {
    float acc = p.e_conv_b[c];
#pragma unroll
    for (int j = 0; j < 4; ++j) { const int rr = row + j - 1; if (rr >= lo && rr < hi) acc += p.e_conv_w[j * LRU_W + c] * bf2f(P[(size_t)rr * EPLD + EC_U + c]); }
    return acc;
}
DEV void lru_gate2(const Params& p, const bf16_t* P, int row, int d, int c, int lo, int hi, float& la, float& bq) {
    const int blk = c / LRU_BD, cd = c % LRU_BD;
    const bf16_t* wa = p.LRUW + (((size_t)(d * LRU_NBLK + blk) * 2 + 0) * LRU_BD + cd) * LRU_BD; const bf16_t* wx = p.LRUW + (((size_t)(d * LRU_NBLK + blk) * 2 + 1) * LRU_BD + cd) * LRU_BD;
    float ra = 0.f, ri = 0.f;
    for (int k = 0; k < LRU_BD; ++k) { const float u = bf2f(f2bf(lru_conv(p, P, row, blk * LRU_BD + k, lo, hi))); ra += u * bf2f(wa[k]); ri += u * bf2f(wx[k]); }
    const float* cc = p.LRUC + (size_t)(d * LRU_W + c) * 3;
    const float r = sigmoidf_(ra + cc[0]), ii = sigmoidf_(ri + cc[1]);
    const float log_a = -LRU_C * r * cc[2]; const float a = expf(log_a);
    la = bf2f(f2bf(log_a)); bq = bf2f(f2bf(sqrtf(fmaxf(1.0f - a * a, 0.f)) * ii));
}
template <int PASS> DEV void ph_lru_naive(const Params& p, long gtid, long gsize) {
    const bf16_t* P = P_of(p); float* SUM = (float*)(p.M + M_SUM); const float* HIN = (const float*)(p.M + M_HIN); bf16_t* MIX = p.ACT;
    for (long i = gtid; i < (long)NB * LRU_NV * LRU_W; i += gsize) {
        const int c = (int)(i % LRU_W), u = (int)(i / LRU_W); int b, row0, lo, hi, v0, v1; lru_chunk_geom(u, b, row0, lo, hi, v0, v1);
        float hf[LRU_CH];
        for (int d = 0; d < 2; ++d) {
            const int v = d ? v1 : v0; const size_t sidx = (((size_t)b * 2 + d) * LRU_NV + v) * LRU_W + c;
            float h = PASS == 2 ? HIN[sidx] : 0.f, lsum = 0.f;
            for (int tt = 0; tt < LRU_CH; ++tt) { const int t = d ? LRU_CH - 1 - tt : tt; float la, bq; lru_gate2(p, P, row0 + t, d, c, lo, hi, la, bq);
                const float uc = lru_conv(p, P, row0 + t, c, lo, hi); h = expf(la) * h + bq * uc; lsum += la;
                if (PASS == 2) { if (d == 0) hf[t] = h; else MIX[(size_t)(row0 + t) * DM + c] = f2bf((hf[t] + h) * geluf_(bf2f(P[(size_t)(row0 + t) * EPLD + EC_G + c]))); } }
            if (PASS == 1) { SUM[2 * sidx] = expf(lsum); SUM[2 * sidx + 1] = h; }
        }
    }
}
DEV void ph_lru_carry(const Params& p, long gtid, long gsize) {
    const float* SUM = (const float*)(p.M + M_SUM); float* HIN = (float*)(p.M + M_HIN);
    for (long i = gtid; i < (long)NB * 2 * LRU_W; i += gsize) {
        const int c = (int)(i % LRU_W); const long bd = i / LRU_W; float h = 0.f;
        for (int v = 0; v < LRU_NV; ++v) { const size_t sidx = ((size_t)bd * LRU_NV + v) * LRU_W + c; HIN[sidx] = h; h = SUM[2 * sidx] * h + SUM[2 * sidx + 1]; }
    }
}
DEV void ph_swa(const Params& p, long gtid, long gsize) {
    const bf16_t* P = P_of(p); bf16_t* MIX = p.ACT;
    for (long i = gtid; i < (long)TL * SWA_H; i += gsize) {
        const int r = (int)(i % TL), h = (int)(i / TL), kv = h / (SWA_H / SWA_KV), b = r / SEQ, s = r % SEQ;
        float q[SWA_HD], o[SWA_HD];
#pragma unroll
        for (int d = 0; d < SWA_HD; ++d) { q[d] = bf2f(P[(size_t)r * EPLD + EC_Q + h * SWA_HD + d]); o[d] = 0.f; }
        float m = p.e_sink[h] * LOG2E, l = 1.0f;
        const int klo = s - WINDOW < 0 ? 0 : s - WINDOW, khi = s + WINDOW >= SEQ ? SEQ - 1 : s + WINDOW;
        const int nwin = khi - klo + 1;
        for (int kk = 0; kk < nwin + CTX; ++kk) {
            const int kr = kk < nwin ? b * SEQ + klo + kk : TL + b * CTX + (kk - nwin);
            const bf16_t* kp = P + (size_t)kr * EPLD + EC_K + kv * SWA_HD; const bf16_t* vp = P + (size_t)kr * EPLD + EC_V + kv * SWA_HD;
            float sc = 0.f;
#pragma unroll
            for (int d = 0; d < SWA_HD; ++d) sc += q[d] * bf2f(kp[d]);
            const float mn = fmaxf(m, sc), f = exp2f(m - mn), pe = exp2f(sc - mn);
            l = l * f + pe; m = mn;
#pragma unroll
            for (int d = 0; d < SWA_HD; ++d) o[d] = o[d] * f + pe * bf2f(vp[d]);
        }
        const float il = 1.0f / l;
#pragma unroll
        for (int d = 0; d < SWA_HD; ++d) MIX[(size_t)r * DM + LRU_W + h * SWA_HD + d] = f2bf(o[d] * il);
    }
}
DEV void ph_ctxattn(const Params& p, long gtid, long gsize) {
    const bf16_t* P = P_of(p); bf16_t* MIX = p.ACT;
    for (long i = gtid; i < (long)TC * SWA_H; i += gsize) {
        const int rc = (int)(i % TC), h = (int)(i / TC), kv = h / (SWA_H / SWA_KV), b = rc / CTX, r = TL + rc;
        float q[SWA_HD], o[SWA_HD];
#pragma unroll
        for (int d = 0; d < SWA_HD; ++d) { q[d] = bf2f(P[(size_t)r * EPLD + EC_Q + h * SWA_HD + d]); o[d] = 0.f; }
        float m = p.e_sink[h] * LOG2E, l = 1.0f;
        for (int kk = 0; kk < CTX; ++kk) {
            const int kr = TL + b * CTX + kk;
            const bf16_t* kp = P + (size_t)kr * EPLD + EC_K + kv * SWA_HD; const bf16_t* vp = P + (size_t)kr * EPLD + EC_V + kv * SWA_HD;
            float sc = 0.f;
#pragma unroll
            for (int d = 0; d < SWA_HD; ++d) sc += q[d] * bf2f(kp[d]);
            const float mn = fmaxf(m, sc), f = exp2f(m - mn), pe = exp2f(sc - mn);
            l = l * f + pe; m = mn;
#pragma unroll
            for (int d = 0; d < SWA_HD; ++d) o[d] = o[d] * f + pe * bf2f(vp[d]);
        }
        const float il = 1.0f / l;
#pragma unroll
        for (int d = 0; d < SWA_HD; ++d) MIX[(size_t)r * DM + LRU_W + h * SWA_HD + d] = f2bf(o[d] * il);
    }
}
struct EpiOut_naive { bf16_t* Y; const float* bias; DEV void operator()(int m, int n, float acc) const { Y[(size_t)m * DM + n] = f2bf(acc + bias[n]); } };
DEV void ph_ln1(const Params& p, int l, long gtid, long gsize) {
    const bf16_t* Y = P_of(p); bf16_t* F = p.ACT;
    const int nrows = l == 0 ? TT : TL;
    for (long r = gtid; r < nrows; r += gsize) {
        const float* xin = l == 0 ? (r < TL ? p.x + (size_t)r * DM : p.ctx + (size_t)(r - TL) * DM) : p.out + (size_t)r * DM;
        float* xo = r < TL ? p.out + (size_t)r * DM : p.XC + (size_t)(r - TL) * DM;
        const float* m = p.MOD + ((size_t)l * (NB + 1) + cond_of_row((int)r)) * 6 * DM;
        const float* g = p.ln_g + (size_t)(l * 2 + 0) * DM; const float* bb = p.ln_b + (size_t)(l * 2 + 0) * DM;
        const bf16_t* y = Y + (size_t)r * DM;
        float s = 0.f;
        for (int d = 0; d < DM; ++d) s += DN_ALPHA * xin[d] + m[2 * DM + d] * bf2f(y[d]);
        const float mu = s / DM; float q = 0.f;
        for (int d = 0; d < DM; ++d) { const float v = DN_ALPHA * xin[d] + m[2 * DM + d] * bf2f(y[d]) - mu; q += v * v; }
        const float rstd = 1.0f / sqrtf(q / DM + LN_EPS);
        float lg[N_GROUPS], le[N_EXP];
#pragma unroll
        for (int j = 0; j < N_GROUPS; ++j) lg[j] = p.moe_bg[l * N_GROUPS + j];
#pragma unroll
        for (int j = 0; j < N_EXP; ++j) le[j] = p.moe_br[l * N_EXP + j];
        const float* wg = p.moe_wg + (size_t)l * DM * N_GROUPS; const float* wr = p.moe_wr + (size_t)l * DM * N_EXP;
        for (int d = 0; d < DM; ++d) {
            const float v = (DN_ALPHA * xin[d] + m[2 * DM + d] * bf2f(y[d]) - mu) * rstd * g[d] + bb[d];
            const float f = v * (1.0f + m[4 * DM + d]) + m[3 * DM + d];
            xo[d] = v; F[(size_t)r * DM + d] = f2bf(f);
#pragma unroll
            for (int j = 0; j < N_GROUPS; ++j) lg[j] += f * wg[d * N_GROUPS + j];
#pragma unroll
            for (int j = 0; j < N_EXP; ++j) le[j] += f * wr[d * N_EXP + j];
        }
        int gi = 0; float gm = lg[0];
#pragma unroll
        for (int j = 1; j < N_GROUPS; ++j) if (lg[j] > gm) { gm = lg[j]; gi = j; }
        float gs = 0.f;
#pragma unroll
        for (int j = 0; j < N_GROUPS; ++j) gs += expf(lg[j] - gm);
        const float gprob = 1.0f / gs;
        float ev[EPG];
#pragma unroll
        for (int j = 0; j < EPG; ++j) { float v = 0.f;
#pragma unroll
            for (int g2 = 0; g2 < N_GROUPS; ++g2) if (g2 == gi) v = le[g2 * EPG + j];
            ev[j] = v; }
        int i0 = 0; float m0 = ev[0];
#pragma unroll
        for (int j = 1; j < EPG; ++j) if (ev[j] > m0) { m0 = ev[j]; i0 = j; }
        int i1 = -1; float m1 = -3.0e38f;
#pragma unroll
        for (int j = 0; j < EPG; ++j) if (j != i0 && ev[j] > m1) { m1 = ev[j]; i1 = j; }
        const float e1 = expf(m1 - m0), g0 = gprob / (1.0f + e1), g1 = gprob * e1 / (1.0f + e1);
        const int ex0 = gi * EPG + i0, ex1 = gi * EPG + i1;
        const int p0 = atomicAdd(&p.cnt[(l * N_EXP + ex0) * CS], 1);
        const int p1 = atomicAdd(&p.cnt[(l * N_EXP + ex1) * CS], 1);
        p.tok_e[2 * r] = ex0; p.tok_e[2 * r + 1] = ex1; p.tok_pos[2 * r] = p0; p.tok_pos[2 * r + 1] = p1; p.tok_gate[2 * r] = g0; p.tok_gate[2 * r + 1] = g1;
    }
}
DEV int moe_pstart(const int* cnt, int e) { int s = 0; for (int j = 0; j < e; ++j) s += (cnt[j * CS] + MOE_PAD - 1) / MOE_PAD * MOE_PAD; return s; }
DEV void ph_scatter(const Params& p, int l, long gtid, long gsize) {
    const int ntok = l == 0 ? TT : TL; const int* cnt = p.cnt + l * N_EXP * CS; bf16_t* XS = (bf16_t*)(p.M + M_XS);
    constexpr int CH = DM / 8;
    for (long i = gtid; i < (long)ntok * 2 * CH; i += gsize) {
        const int ch = (int)(i % CH), a = (int)(i / CH);
        const int row = moe_pstart(cnt, p.tok_e[a]) + p.tok_pos[a];
        if (ch == 0) p.tok_row[a] = row;
        const U128 v = *(const U128*)(p.ACT + (size_t)(a >> 1) * DM + ch * 8);
        *(U128*)(XS + (size_t)row * DM + ch * 8) = v;
    }
}
DEV void ph_moe1_naive(const Params& p, int l, long gtid, long gsize) {
    const int* cnt = p.cnt + l * N_EXP * CS; const bf16_t* XS = (const bf16_t*)(p.M + M_XS); bf16_t* H1 = (bf16_t*)(p.M + M_H1);
    for (long i = gtid; i < (long)CR_MAX * D_EXP; i += gsize) {
        const int j = (int)(i % D_EXP), row = (int)(i / D_EXP);
        int e = -1, s = 0; for (int k = 0; k < N_EXP; ++k) { if (row >= s && row < s + cnt[k * CS]) e = k; s += (cnt[k * CS] + MOE_PAD - 1) / MOE_PAD * MOE_PAD; }
        if (e < 0) continue;
        const bf16_t* Wb = p.W_up + ((size_t)(l * N_EXP + e) * 2 * D_EXP) * DM;
        const int grp = j / UPG, jj = j % UPG;
        const bf16_t* w1 = Wb + (size_t)(grp * 2 * UPG + jj) * DM; const bf16_t* w3 = Wb + (size_t)(grp * 2 * UPG + UPG + jj) * DM; const bf16_t* a = XS + (size_t)row * DM;
        float a1 = 0.f, a3 = 0.f;
        for (int k = 0; k < DM; ++k) { const float av = bf2f(a[k]); a1 += av * bf2f(w1[k]); a3 += av * bf2f(w3[k]); }
        H1[(size_t)row * D_EXP + j] = f2bf(siluf_(a1) * a3);
    }
}
DEV void ph_moe2_naive(const Params& p, int l, long gtid, long gsize) {
    const int* cnt = p.cnt + l * N_EXP * CS; const bf16_t* H1 = (const bf16_t*)(p.M + M_H1); bf16_t* YS = (bf16_t*)(p.M + M_XS);
    for (long i = gtid; i < (long)CR_MAX * DM; i += gsize) {
        const int n = (int)(i % DM), row = (int)(i / DM);
        int e = -1, s = 0; for (int k = 0; k < N_EXP; ++k) { if (row >= s && row < s + cnt[k * CS]) e = k; s += (cnt[k * CS] + MOE_PAD - 1) / MOE_PAD * MOE_PAD; }
        if (e < 0) continue;
        const bf16_t* w = p.W_dn + ((size_t)(l * N_EXP + e) * DM + n) * D_EXP; const bf16_t* a = H1 + (size_t)row * D_EXP;
        float acc = 0.f;
        for (int k = 0; k < D_EXP; ++k) acc += bf2f(a[k]) * bf2f(w[k]);
        YS[(size_t)row * DM + n] = f2bf(acc);
    }
}
DEV void ph_ln2(const Params& p, int l, long gtid, long gsize) {
    const bf16_t* YS = (const bf16_t*)(p.M + M_XS); const int nrows = l == 0 ? TT : TL;
    for (long r = gtid; r < nrows; r += gsize) {
        float* xo = r < TL ? p.out + (size_t)r * DM : p.XC + (size_t)(r - TL) * DM;
        const float* m = p.MOD + ((size_t)l * (NB + 1) + cond_of_row((int)r)) * 6 * DM;
        const float* g = p.ln_g + (size_t)(l * 2 + 1) * DM; const float* bb = p.ln_b + (size_t)(l * 2 + 1) * DM;
        const bf16_t* y0 = YS + (size_t)p.tok_row[2 * r] * DM; const bf16_t* y1 = YS + (size_t)p.tok_row[2 * r + 1] * DM;
        const float g0 = p.tok_gate[2 * r], g1 = p.tok_gate[2 * r + 1];
        float s = 0.f;
        for (int d = 0; d < DM; ++d) s += DN_ALPHA * xo[d] + m[5 * DM + d] * (g0 * bf2f(y0[d]) + g1 * bf2f(y1[d]));
        const float mu = s / DM; float q = 0.f;
        for (int d = 0; d < DM; ++d) { const float v = DN_ALPHA * xo[d] + m[5 * DM + d] * (g0 * bf2f(y0[d]) + g1 * bf2f(y1[d])) - mu; q += v * v; }
        const float rstd = 1.0f / sqrtf(q / DM + LN_EPS);
        const float* m1 = p.MOD + ((size_t)1 * (NB + 1) + cond_of_row((int)r)) * 6 * DM;
        for (int d = 0; d < DM; ++d) {
            const float v = (DN_ALPHA * xo[d] + m[5 * DM + d] * (g0 * bf2f(y0[d]) + g1 * bf2f(y1[d])) - mu) * rstd * g[d] + bb[d];
            xo[d] = v;
            if (l == 0) p.ACT[(size_t)r * DM + d] = f2bf(v * (1.0f + m1[DM + d]) + m1[d]);
        }
    }
}
struct EpiInO_naive { const Params* p; DEV void operator()(int m, int n, float acc) const { if (n < ODD_IN) P_of(*p)[(size_t)m * OPLD + n] = f2bf(acc + p->o_b_in[n]); } };
DEV void ph_l1_post_inproj(const Params& p, long gtid, long gsize) {
    const bf16_t* P = P_of(p); bf16_t* Kb = (bf16_t*)(p.M + M_K);
    for (long r = gtid; r < TT; r += gsize) {
        const bf16_t* row = P + (size_t)r * OPLD;
        float s = 0.f; for (int d = 0; d < MLA_QR; ++d) { const float v = bf2f(row[d]); s += v * v; }
        p.SSQ[r * 8 + 0] = s; p.SSQ[r * 8 + 1] = 0.f; p.SSQ[r * 8 + 2] = 0.f; p.SSQ[r * 8 + 3] = 0.f;
        s = 0.f; for (int d = 0; d < MLA_KVR; ++d) { const float v = bf2f(row[OC_CKV + d]); s += v * v; }
        p.SSQ[r * 8 + 4] = s; p.SSQ[r * 8 + 5] = 0.f; p.SSQ[r * 8 + 6] = 0.f; p.SSQ[r * 8 + 7] = 0.f;
        constexpr int half = MLA_ROPE / 4;
        for (int part = 0; part < 2; ++part) for (int pi = 0; pi < half; ++pi) {
            float cs = 1.f, sn = 0.f;
            if (r < TL) { const int sq = (int)(r % SEQ); const int pos = part == 0 ? sq / GRID_W : sq % GRID_W; cs = p.ROPE_MLA[2 * (pos * half + pi)]; sn = p.ROPE_MLA[2 * (pos * half + pi) + 1]; }
            const float x1 = bf2f(row[OC_KPE + part * (MLA_ROPE / 2) + pi]), x2 = bf2f(row[OC_KPE + part * (MLA_ROPE / 2) + half + pi]);
            const bf16_t o1 = f2bf(x1 * cs - x2 * sn), o2 = f2bf(x1 * sn + x2 * cs);
            for (int h = 0; h < MLA_H; ++h) { bf16_t* kd = Kb + (size_t)r * MLA_H * MLA_QD + h * MLA_QD + MLA_NOPE + part * (MLA_ROPE / 2); kd[pi] = o1; kd[half + pi] = o2; }
        }
    }
}
constexpr float MLA_QSCALE = LOG2E * (MLA_QD == 96 ? 0.10206207261596577f : 0.20412414523193154f);
DEV float rs_from_ssq(const float* s4, int n) { return 1.0f / sqrtf(((s4[0] + s4[1]) + (s4[2] + s4[3])) / (float)n + LN_EPS); }
DEV void ph_uq_naive(const Params& p, long gtid, long gsize) {
    const bf16_t* P = P_of(p); bf16_t* Q = (bf16_t*)(p.M + M_Q); constexpr int half = MLA_ROPE / 4;
    for (long i = gtid; i < (long)TL * MLA_H; i += gsize) {
        const int r = (int)(i / MLA_H), h = (int)(i % MLA_H); const float rs = rs_from_ssq(p.SSQ + (size_t)r * 8, MLA_QR);
        float q[MLA_QD];
        for (int d = 0; d < MLA_QD; ++d) { float acc = 0.f; const bf16_t* w = p.W_uq + (size_t)(h * MLA_QD + d) * MLA_QR; for (int k = 0; k < MLA_QR; ++k) acc += bf2f(P[(size_t)r * OPLD + k]) * bf2f(w[k]); q[d] = acc * rs; }
        const int sq = r % SEQ;
        for (int part = 0; part < 2; ++part) for (int pi = 0; pi < half; ++pi) {
            const int pos = part == 0 ? sq / GRID_W : sq % GRID_W; const float cs = p.ROPE_MLA[2 * (pos * half + pi)], sn = p.ROPE_MLA[2 * (pos * half + pi) + 1];
            float& x1 = q[MLA_NOPE + part * (MLA_ROPE / 2) + pi]; float& x2 = q[MLA_NOPE + part * (MLA_ROPE / 2) + half + pi];
            const float a = x1 * cs - x2 * sn, b = x1 * sn + x2 * cs; x1 = a; x2 = b;
        }
        for (int d = 0; d < MLA_QD; ++d) Q[(size_t)r * MLA_H * MLA_QD + h * MLA_QD + d] = f2bf(q[d] * MLA_QSCALE);
    }
}
struct EpiUkv_naive { const Params* p; DEV void operator()(int m, int n, float acc) const {
    const float v = acc * rs_from_ssq(p->SSQ + (size_t)m * 8 + 4, MLA_KVR);
    if (n < MLA_H * MLA_NOPE) ((bf16_t*)(p->M + M_K))[(size_t)m * MLA_H * MLA_QD + (n / MLA_NOPE) * MLA_QD + n % MLA_NOPE] = f2bf(v);
    else ((bf16_t*)(p->M + M_V))[(size_t)m * MLA_H * MLA_V + (n - MLA_H * MLA_NOPE)] = f2bf(v); } };
DEV void ph_conf_conv(const Params& p, long gtid, long gsize) {
    const bf16_t* P = P_of(p); bf16_t* CV = (bf16_t*)(p.M + M_CV);
    for (long i = gtid; i < (long)TL * CONF_CH; i += gsize) {
        const int r = (int)(i / CONF_CH), c = (int)(i % CONF_CH); const int lo = (r / SEQ) * SEQ, hi = lo + SEQ;
        float acc = p.o_dw_b[c];
        for (int j = 0; j < CONF_K; ++j) { const int rr = r + j - (CONF_K - 1) / 2; if (rr >= lo && rr < hi) { const bf16_t* row = P + (size_t)rr * OPLD; acc += p.o_dw_w[j * CONF_CH + c] * bf2f(row[OC_A + c]) * sigmoidf_(bf2f(row[OC_G + c])); } }
        CV[i] = f2bf(acc);
    }
}
DEV void ph_conf_ln(const Params& p, long gtid, long gsize) {
    const bf16_t* CV = (const bf16_t*)(p.M + M_CV); bf16_t* MIX = p.ACT;
    for (long r = gtid; r < TL; r += gsize) {
        const bf16_t* v = CV + (size_t)r * CONF_CH; float s = 0.f;
        for (int d = 0; d < CONF_CH; ++d) s += bf2f(v[d]);
        const float mu = s / CONF_CH; float q = 0.f;
        for (int d = 0; d < CONF_CH; ++d) q += (bf2f(v[d]) - mu) * (bf2f(v[d]) - mu);
        const float rstd = 1.0f / sqrtf(q / CONF_CH + LN_EPS);
        for (int d = 0; d < CONF_CH; ++d) MIX[(size_t)r * DM + MLA_H * MLA_V + d] = f2bf(siluf_((bf2f(v[d]) - mu) * rstd * p.o_cln_g[d] + p.o_cln_b[d]));
    }
}
DEV void ph_mla_attn(const Params& p, long gtid, long gsize) {
    const bf16_t* Q = (const bf16_t*)(p.M + M_Q); const bf16_t* Kb = (const bf16_t*)(p.M + M_K); const bf16_t* V = (const bf16_t*)(p.M + M_V); bf16_t* MIX = p.ACT;
    for (long i = gtid; i < (long)TL * MLA_H; i += gsize) {
        const int r = (int)(i % TL), h = (int)(i / TL), b = r / SEQ;
        float q[MLA_QD], o[MLA_V];
#pragma unroll
        for (int d = 0; d < MLA_QD; ++d) q[d] = bf2f(Q[(size_t)r * MLA_H * MLA_QD + h * MLA_QD + d]);
#pragma unroll
        for (int d = 0; d < MLA_V; ++d) o[d] = 0.f;
        float m = -3.0e38f, l = 0.f;
        for (int kk = 0; kk < CTX + SEQ; ++kk) {
            const int kr = kk < CTX ? TL + b * CTX + kk : b * SEQ + (kk - CTX);
            const bf16_t* kp = Kb + (size_t)kr * MLA_H * MLA_QD + h * MLA_QD; const bf16_t* vp = V + (size_t)kr * MLA_H * MLA_V + h * MLA_V;
            float sc = 0.f;
#pragma unroll
            for (int d = 0; d < MLA_QD; ++d) sc += q[d] * bf2f(kp[d]);
            const float mn = fmaxf(m, sc), f = exp2f(m - mn), pe = exp2f(sc - mn);
            l = l * f + pe; m = mn;
#pragma unroll
            for (int d = 0; d < MLA_V; ++d) o[d] = o[d] * f + pe * bf2f(vp[d]);
        }
        const float il = 1.0f / l;
#pragma unroll
        for (int d = 0; d < MLA_V; ++d) MIX[(size_t)r * DM + h * MLA_V + d] = f2bf(o[d] * il);
    }
}


#ifndef CPU_SIM
#define FLAS __attribute__((address_space(3)))
#endif
#ifndef CPU_SIM
namespace pg8 {
#define PG8_LAS __attribute__((address_space(3)))
typedef short bf16x8 __attribute__((ext_vector_type(8)));
typedef float f32x4 __attribute__((ext_vector_type(4)));
typedef unsigned u32x4 __attribute__((ext_vector_type(4)));
constexpr int BM = 256, BK = 64, HALF = 128, HTB = HALF * BK * 2  , STAGE_BYTES = 8 * HTB, NXCD = 8, WGM = 8;

__host__ __device__ __forceinline__ int lds_byte(int r, int c) { const int st = (r >> 4) * 2 + (c >> 5), rr = r & 15, cc = c & 31, ob = rr * 64 + cc * 2; return st * 1024 + (ob ^ (((ob >> 9) & 1) << 5)); }
__host__ __device__ __forceinline__ void stage_rc(int b, int& R, int& C) { const int st = b / 1024, sb = b % 1024, swz = sb ^ (((sb >> 9) & 1) << 5); R = (st >> 1) * 16 + swz / 64; C = (st & 1) * 32 + (swz % 64) / 2; }
__host__ __device__ __forceinline__ int perm32(int rho) { const int n = rho >> 4, i = rho & 15; return 8 * (i >> 2) + 4 * n + (i & 3); }

struct Unit { int pm, pn; };
struct Gemm { const bf16_t* A; const bf16_t* Bt; int M, N, K, lda; };

struct StaticOrder {
    int nM, nN, nwg, G, c;
    __host__ __device__ void init(int M, int N, int G_, int c_) { nM = M / BM; nN = N / BM; nwg = nM * nN; G = G_; c = c_; }
    __host__ __device__ bool next(int i, Unit& u) const {
        const long L = (long)i * G + c; if (L >= nwg) return false;
        int wgid = (int)L; { const int q = nwg / NXCD, r = nwg % NXCD, xcd = wgid % NXCD, off = wgid / NXCD; wgid = (xcd < r ? xcd * (q + 1) : r * (q + 1) + (xcd - r) * q) + off; }
        const int nig = WGM * nN, gid = wgid / nig, fm = gid * WGM, gsz = (nM - fm) < WGM ? (nM - fm) : WGM;
        u.pm = fm + ((wgid % nig) % gsz); u.pn = (wgid % nig) / gsz; return true;
    }
    __device__ __forceinline__ void a_ready(const Unit&) const {}
    __device__ __forceinline__ void done(const Unit&) const {}
};
__device__ __forceinline__ unsigned cvt_pk_bf16(float lo, float hi) { unsigned r; asm volatile("v_cvt_pk_bf16_f32 %0, %1, %2" : "=v"(r) : "v"(lo), "v"(hi)); return r; }
__device__ __forceinline__ float xchg32(float v) { const unsigned u = __float_as_uint(v); auto r = __builtin_amdgcn_permlane32_swap(u, u, false, false); return __uint_as_float((threadIdx.x & 32) ? r[0] : r[1]); }
__device__ __forceinline__ float xchg16(float v) { const unsigned u = __float_as_uint(v); auto r = __builtin_amdgcn_permlane16_swap(u, u, false, false); return __uint_as_float((threadIdx.x & 16) ? r[0] : r[1]); }
typedef float f32x2 __attribute__((ext_vector_type(2)));
typedef int i32x4 __attribute__((ext_vector_type(4)));
typedef int i32x8 __attribute__((ext_vector_type(8)));
__device__ __forceinline__ i32x8 cat8(const bf16x8 a, const bf16x8 b) { return __builtin_shufflevector(__builtin_bit_cast(i32x4, a), __builtin_bit_cast(i32x4, b), 0, 1, 2, 3, 4, 5, 6, 7); }
__device__ __forceinline__ void mfma8(f32x4& c, const i32x8 a, const i32x8 b) { asm volatile("v_mfma_f32_16x16x128_f8f6f4 %0, %1, %2, %0" : "+v"(c) : "v"(a), "v"(b)); }
__device__ __forceinline__ void mfma8_drain() { asm volatile("s_nop 15\n\ts_nop 15\n\ts_nop 15" ::: "memory"); }
__device__ __forceinline__ unsigned pk8(float a, float b, float c, float d) {
    a = __builtin_amdgcn_fmed3f(a, -448.f, 448.f); b = __builtin_amdgcn_fmed3f(b, -448.f, 448.f); c = __builtin_amdgcn_fmed3f(c, -448.f, 448.f); d = __builtin_amdgcn_fmed3f(d, -448.f, 448.f);
    int v = __builtin_amdgcn_cvt_pk_fp8_f32(a, b, 0, false); v = __builtin_amdgcn_cvt_pk_fp8_f32(c, d, v, true); return (unsigned)v; }
template <class Epi, class Sched, bool ALIGN_EPI = false, bool SP2 = false, bool GATHER = false, bool FP8 = false>
__device__ __forceinline__ void gemm_phase(PG8_LAS unsigned char* lds, const Gemm g, const Sched& S, const Epi& E) {
    static_assert(!GATHER || SP2, "gathered A rows are wired into the SP2 loop only");
    const int tid = threadIdx.x, wid = __builtin_amdgcn_readfirstlane(tid >> 6), lane = tid & 63, wr = wid >> 2, wc = wid & 3, fr = lane & 15, fq = lane >> 4;
    const int K = g.K, nt = K / BK;
    unsigned voffA[2], voffB[2];
#pragma unroll
    for (int i = 0; i < 2; ++i) { int R, C; stage_rc(tid * 16 + i * 8192, R, C); const int Rb = Epi::PERM ? ((R & ~31) + perm32(R & 31)) : R;
        voffA[i] = (unsigned)(R * g.lda + C) * 2u; voffB[i] = (unsigned)(Rb * K + C) * 2u; }
    const size_t kstep = (size_t)(BK * 2);
    const size_t hstepB = (size_t)HALF * K * 2, hstepA = (size_t)HALF * g.lda * 2;
    const size_t tstepA = GATHER ? 0 : 2 * hstepA, tstepB = 2 * hstepB;
    const unsigned ldsw = (unsigned)wid * 1024u;
    const int aoff = lds_byte(wr * 64 + fr, fq * 8), boff = lds_byte(wc * 32 + fr, fq * 8);
#define PG8_SA(b, h) (((b) * 2 + (h)) * HTB)
#define PG8_SB(b, h) ((4 + (b) * 2 + (h)) * HTB)
#define PG8_STAGE(bufoff, gbase, voff) do { _Pragma("unroll") for (int _i = 0; _i < 2; ++_i) \
        __builtin_amdgcn_global_load_lds((const unsigned*)((const char*)(gbase) + (voff)[_i]), (PG8_LAS unsigned*)(lds + (bufoff) + ldsw + _i * 8192), 16, 0, 0); } while (0)
#define PG8_LDA(dst, b, h) do { _Pragma("unroll") for (int m = 0; m < 4; ++m) _Pragma("unroll") for (int k = 0; k < 2; ++k) dst[m][k] = *(const PG8_LAS bf16x8*)(lds + PG8_SA(b, h) + aoff + m * 2048 + k * 1024); } while (0)
#define PG8_LDB(dst, b, h) do { _Pragma("unroll") for (int n = 0; n < 2; ++n) _Pragma("unroll") for (int k = 0; k < 2; ++k) dst[n][k] = *(const PG8_LAS bf16x8*)(lds + PG8_SB(b, h) + boff + n * 2048 + k * 1024); } while (0)
#define PG8_MMA(ai, bj, At, Bt) do { __builtin_amdgcn_s_setprio(1); if constexpr (FP8) { _Pragma("unroll") for (int m = 0; m < 4; ++m) _Pragma("unroll") for (int n = 0; n < 2; ++n) \
        mfma8(acc[ai][bj][m][n], cat8(Bt[n][0], Bt[n][1]), cat8(At[m][0], At[m][1])); } else { \
        _Pragma("unroll") for (int m = 0; m < 4; ++m) _Pragma("unroll") for (int n = 0; n < 2; ++n) _Pragma("unroll") for (int k = 0; k < 2; ++k) \
        acc[ai][bj][m][n] = __builtin_amdgcn_mfma_f32_16x16x32_bf16(Bt[n][k], At[m][k], acc[ai][bj][m][n], 0, 0, 0); } __builtin_amdgcn_s_setprio(0); } while (0)
#define PG8_WAIT_V(n) asm volatile("s_waitcnt vmcnt(" #n ")" ::: "memory")
#define PG8_WAIT_L(n) asm volatile("s_waitcnt lgkmcnt(" #n ")" ::: "memory")
#define PG8_BAR __builtin_amdgcn_s_barrier()
#define PG8_SCHED __builtin_amdgcn_sched_barrier(0)
    Unit cur, nxt; int ui = 0;
    if (!S.next(0, cur)) return;
    unsigned vA[2][2], vN[2][2];
    if constexpr (GATHER) {
#pragma unroll
        for (int h = 0; h < 2; ++h)
#pragma unroll
            for (int i = 0; i < 2; ++i) { int R, C; stage_rc(tid * 16 + i * 8192, R, C); vA[h][i] = (unsigned)(S.a_row(cur, h * HALF + R) * g.lda + C) * 2u; vN[h][i] = vA[h][i]; }
    }
#define PG8_STAGE_A(bufoff, gbase, h, nx) do { if constexpr (GATHER) { const unsigned v2_[2] = {(nx) ? vN[h][0] : vA[h][0], (nx) ? vN[h][1] : vA[h][1]}; PG8_STAGE(bufoff, gbase, v2_); } \
        else { PG8_STAGE(bufoff, (gbase) + ((h) ? hstepA : 0), voffA); } } while (0)
    f32x4 acc[2][2][4][2];
#pragma unroll
    for (int a = 0; a < 2; ++a)
#pragma unroll
        for (int b = 0; b < 2; ++b)
#pragma unroll
            for (int m = 0; m < 4; ++m)
#pragma unroll
                for (int n = 0; n < 2; ++n) acc[a][b][m][n] = (f32x4){0.f, 0.f, 0.f, 0.f};
    bf16x8 At[4][2], B0[2][2], B1[2][2];
    const char* cA = (const char*)g.A + (size_t)cur.pm * tstepA; const char* cB = (const char*)g.Bt + (size_t)cur.pn * tstepB;
    S.a_ready(cur);
    if constexpr (SP2) {
        PG8_STAGE(PG8_SB(0, 0), cB, voffB); PG8_STAGE(PG8_SB(0, 1), cB + hstepB, voffB); PG8_STAGE_A(PG8_SA(0, 0), cA, 0, false); PG8_STAGE_A(PG8_SA(0, 1), cA, 1, false);
        if (wr == 1) PG8_BAR;
        PG8_WAIT_V(2); PG8_BAR;
        PG8_STAGE(PG8_SB(1, 0), cB + kstep, voffB); PG8_STAGE_A(PG8_SA(1, 0), cA + kstep, 0, false); PG8_STAGE(PG8_SB(1, 1), cB + hstepB + kstep, voffB);
        PG8_WAIT_V(6); PG8_BAR;
    } else {
        PG8_STAGE(PG8_SB(0, 0), cB, voffB); PG8_STAGE(PG8_SA(0, 0), cA, voffA); PG8_STAGE(PG8_SB(0, 1), cB + hstepB, voffB); PG8_STAGE(PG8_SA(0, 1), cA + hstepA, voffA);
        if (wr == 1) PG8_BAR;
        PG8_WAIT_V(4); PG8_BAR;
        PG8_STAGE(PG8_SB(1, 0), cB + kstep, voffB); PG8_STAGE(PG8_SA(1, 0), cA + kstep, voffA); PG8_STAGE(PG8_SB(1, 1), cB + hstepB + kstep, voffB);
        PG8_WAIT_V(6); PG8_BAR;
    }
    for (;;) {
        const bool has_next = S.next(ui + 1, nxt);
        if constexpr (GATHER) { if (has_next) { int t2 = threadIdx.x; asm volatile("" : "+v"(t2)); int rw_[2][2];
#pragma unroll
            for (int h = 0; h < 2; ++h)
#pragma unroll
                for (int i = 0; i < 2; ++i) { int R, C; stage_rc(t2 * 16 + i * 8192, R, C); rw_[h][i] = S.a_row(nxt, h * HALF + R); }
            asm volatile("" ::: "memory");
#pragma unroll
            for (int h = 0; h < 2; ++h)
#pragma unroll
                for (int i = 0; i < 2; ++i) { int R, C; stage_rc(t2 * 16 + i * 8192, R, C); vN[h][i] = (unsigned)(rw_[h][i] * g.lda + C) * 2u; } } }
        const char* nA = has_next ? (const char*)g.A + (size_t)nxt.pm * tstepA : cA; const char* nB = has_next ? (const char*)g.Bt + (size_t)nxt.pn * tstepB : cB;
#pragma nounroll
        for (int t = 0; t < nt; t += 2) {
            const bool last = (t == nt - 2);
            const char* a1 = cA + (size_t)(t + 1) * kstep;
            const char* a2 = last ? nA : cA + (size_t)(t + 2) * kstep; const char* b2 = last ? nB : cB + (size_t)(t + 2) * kstep;
            const char* a3 = a2 + kstep; const char* b3 = b2 + kstep;
            if (last && has_next) S.a_ready(nxt);
            if constexpr (SP2) {
            PG8_LDB(B0, 0, 0); PG8_LDB(B1, 0, 1); PG8_SCHED; PG8_LDA(At, 0, 0); PG8_STAGE_A(PG8_SA(1, 1), a1, 1, false);
            PG8_WAIT_V(8); PG8_WAIT_L(0); PG8_BAR; PG8_MMA(0, 0, At, B0); PG8_MMA(0, 1, At, B1); PG8_BAR; PG8_SCHED;
            PG8_LDA(At, 0, 1); PG8_STAGE(PG8_SB(0, 0), b2, voffB); PG8_STAGE(PG8_SB(0, 1), b2 + hstepB, voffB); PG8_STAGE_A(PG8_SA(0, 0), a2, 0, last);
            PG8_WAIT_V(8); PG8_WAIT_L(0); PG8_BAR; PG8_MMA(1, 0, At, B0); PG8_MMA(1, 1, At, B1); PG8_BAR; PG8_SCHED;
            PG8_LDB(B0, 1, 0); PG8_LDB(B1, 1, 1); PG8_SCHED; PG8_LDA(At, 1, 0); PG8_STAGE_A(PG8_SA(0, 1), a2, 1, last);
            PG8_WAIT_V(8); PG8_WAIT_L(0); PG8_BAR; PG8_MMA(0, 0, At, B0); PG8_MMA(0, 1, At, B1); PG8_BAR; PG8_SCHED;
            PG8_LDA(At, 1, 1); PG8_STAGE(PG8_SB(1, 0), b3, voffB); PG8_STAGE(PG8_SB(1, 1), b3 + hstepB, voffB); PG8_STAGE_A(PG8_SA(1, 0), a3, 0, last);
            PG8_WAIT_V(8); PG8_WAIT_L(0); PG8_BAR; PG8_MMA(1, 0, At, B0); PG8_MMA(1, 1, At, B1); PG8_BAR; PG8_SCHED;
            } else {
            PG8_LDB(B0, 0, 0); PG8_SCHED; PG8_LDA(At, 0, 0); PG8_STAGE(PG8_SA(1, 1), a1 + hstepA, voffA);
            PG8_WAIT_L(8); PG8_BAR; PG8_WAIT_L(0); PG8_MMA(0, 0, At, B0); PG8_BAR; PG8_SCHED;
            PG8_LDB(B1, 0, 1); PG8_STAGE(PG8_SB(0, 0), b2, voffB);
            PG8_BAR; PG8_WAIT_L(0); PG8_MMA(0, 1, At, B1); PG8_BAR;
            PG8_LDA(At, 0, 1); PG8_STAGE(PG8_SA(0, 0), a2, voffA);
            PG8_BAR; PG8_WAIT_L(0); PG8_MMA(1, 0, At, B0); PG8_BAR; PG8_SCHED;
            PG8_STAGE(PG8_SB(0, 1), b2 + hstepB, voffB);
            PG8_WAIT_V(6); PG8_BAR; PG8_MMA(1, 1, At, B1); PG8_BAR;
            PG8_LDB(B0, 1, 0); PG8_SCHED; PG8_LDA(At, 1, 0); PG8_STAGE(PG8_SA(0, 1), a2 + hstepA, voffA);
            PG8_WAIT_L(8); PG8_BAR; PG8_WAIT_L(0); PG8_MMA(0, 0, At, B0); PG8_BAR; PG8_SCHED;
            PG8_LDB(B1, 1, 1); PG8_STAGE(PG8_SB(1, 0), b3, voffB);
            PG8_BAR; PG8_WAIT_L(0); PG8_MMA(0, 1, At, B1); PG8_BAR;
            PG8_LDA(At, 1, 1); PG8_STAGE(PG8_SA(1, 0), a3, voffA);
            PG8_BAR; PG8_WAIT_L(0); PG8_MMA(1, 0, At, B0); PG8_BAR; PG8_SCHED;
            PG8_STAGE(PG8_SB(1, 1), b3 + hstepB, voffB);
            PG8_WAIT_V(6); PG8_BAR; PG8_MMA(1, 1, At, B1); PG8_BAR;
            }
        }
        if constexpr (FP8) { mfma8_drain(); PG8_SCHED; }
        if constexpr (ALIGN_EPI) { if (wr == 0) PG8_BAR; }
        if constexpr (!Epi::AFTER_DRAIN) { E(acc, cur, wr, wc, fr, fq); S.done(cur); }
        if (!has_next) break;
#pragma unroll
        for (int a = 0; a < 2; ++a)
#pragma unroll
            for (int b = 0; b < 2; ++b)
#pragma unroll
                for (int m = 0; m < 4; ++m)
#pragma unroll
                    for (int n = 0; n < 2; ++n) acc[a][b][m][n] = (f32x4){0.f, 0.f, 0.f, 0.f};
        cur = nxt; cA = nA; cB = nB; ++ui;
        if constexpr (GATHER) {
#pragma unroll
            for (int h = 0; h < 2; ++h)
#pragma unroll
                for (int i = 0; i < 2; ++i) vA[h][i] = vN[h][i]; }
        if constexpr (ALIGN_EPI) { if (wr == 1) PG8_BAR; }
    }
    PG8_WAIT_V(0);
    if constexpr (!ALIGN_EPI) { if (wr == 0) PG8_BAR; }
    PG8_BAR;
    if constexpr (Epi::AFTER_DRAIN) { E.fused(acc, cur, wr, wc, fr, fq, lds, wid, lane); S.done(cur); }
#undef PG8_SA
#undef PG8_SB
#undef PG8_STAGE
#undef PG8_STAGE_A
#undef PG8_LDA
#undef PG8_LDB
#undef PG8_MMA
#undef PG8_WAIT_V
#undef PG8_WAIT_L
#undef PG8_BAR
#undef PG8_SCHED
}
}
namespace pg8 {
__device__ __forceinline__ u32x4 pack8(const f32x4 v0, const f32x4 v1) { u32x4 w; w.x = cvt_pk_bf16(v0[0], v0[1]); w.y = cvt_pk_bf16(v0[2], v0[3]); w.z = cvt_pk_bf16(v1[0], v1[1]); w.w = cvt_pk_bf16(v1[2], v1[3]); return w; }
__device__ __forceinline__ float bfr(float v) { return __uint_as_float(cvt_pk_bf16(v, 0.f) << 16); }
#define PG8_EPI_LOOP for (int ai = 0; ai < 2; ++ai) _Pragma("unroll") for (int m = 0; m < 4; ++m) _Pragma("unroll") for (int bj = 0; bj < 2; ++bj)
struct EpiPlain {
    static constexpr bool PERM = true, AFTER_DRAIN = false;
    bf16_t* O; int ldc; const float* bias; int pn_mod;
    __device__ __forceinline__ void operator()(const f32x4 (&acc)[2][2][4][2], const Unit& u, int wr, int wc, int fr, int fq) const {
        const int row0 = u.pm * BM + wr * 64 + fr; const int ct = pn_mod ? u.pn % pn_mod : u.pn; const int col0 = ct * BM + wc * 32 + 8 * fq;
        f32x4 bv[2][2];
#pragma unroll
        for (int bj = 0; bj < 2; ++bj)
#pragma unroll
            for (int n = 0; n < 2; ++n) bv[bj][n] = bias ? *(const f32x4*)(bias + col0 + bj * HALF + 4 * n) : (f32x4){0.f, 0.f, 0.f, 0.f};
#pragma unroll
        PG8_EPI_LOOP { bf16_t* rowp = O + (size_t)(row0 + ai * HALF + m * 16) * ldc + col0 + bj * HALF; *(u32x4*)rowp = pack8(acc[ai][bj][m][0] + bv[bj][0], acc[ai][bj][m][1] + bv[bj][1]); }
    }
};
struct EpiMoeUp {
    static constexpr bool PERM = true, AFTER_DRAIN = false;
    bf16_t* H1;
    __device__ __forceinline__ void operator()(const f32x4 (&acc)[2][2][4][2], const Unit& u, int wr, int wc, int fr, int fq) const {
        const int row0 = u.pm * BM + wr * 64 + fr; const int ct = u.pn % (2 * D_EXP / BM); const int col0 = ct * HALF + wc * 32 + 8 * fq;
#pragma unroll
        for (int ai = 0; ai < 2; ++ai)
#pragma unroll
            for (int m = 0; m < 4; ++m) { f32x4 o[2];
#pragma unroll
                for (int n = 0; n < 2; ++n)
#pragma unroll
                    for (int j = 0; j < 4; ++j) { const float a = acc[ai][0][m][n][j], b = acc[ai][1][m][n][j]; o[n][j] = a / (1.0f + __expf(-a)) * b; }
                *(u32x4*)(H1 + (size_t)(row0 + ai * HALF + m * 16) * D_EXP + col0) = pack8(o[0], o[1]); }
    }
};
struct EpiMoeUp8 {
    static constexpr bool PERM = true, AFTER_DRAIN = false;
    unsigned char* H1;
    __device__ __forceinline__ void operator()(const f32x4 (&acc)[2][2][4][2], const Unit& u, int wr, int wc, int fr, int fq) const {
        const int row0 = u.pm * BM + wr * 64 + fr; const int ct = u.pn % (2 * D_EXP / BM); const int col0 = ct * HALF + wc * 32 + 8 * fq;
        constexpr float SA = 1.0f / (FP8_SF * FP8_SW1), SB = FP8_SH / (FP8_SF * FP8_SW1);
#pragma unroll
        for (int ai = 0; ai < 2; ++ai)
#pragma unroll
            for (int m = 0; m < 4; ++m) { f32x4 o[2];
#pragma unroll
                for (int n = 0; n < 2; ++n)
#pragma unroll
                    for (int j = 0; j < 4; ++j) { const float a = acc[ai][0][m][n][j] * SA, b = acc[ai][1][m][n][j] * SB; o[n][j] = a * __builtin_amdgcn_rcpf(1.0f + __expf(-a)) * b; }
                *(f32x2*)(H1 + (size_t)(row0 + ai * HALF + m * 16) * D_EXP + col0) = (f32x2){__uint_as_float(pk8(o[0][0], o[0][1], o[0][2], o[0][3])), __uint_as_float(pk8(o[1][0], o[1][1], o[1][2], o[1][3]))}; }
    }
};
struct EpiScale {
    static constexpr bool PERM = true, AFTER_DRAIN = false;
    unsigned char* O; int ldc; float scale; int pn_mod;
    __device__ __forceinline__ void operator()(const f32x4 (&acc)[2][2][4][2], const Unit& u, int wr, int wc, int fr, int fq) const {
        const int row0 = u.pm * BM + wr * 64 + fr; const int col0 = (u.pn % pn_mod) * BM + wc * 32 + 8 * fq;
#pragma unroll
        PG8_EPI_LOOP { unsigned char* rowp = O + (size_t)(row0 + ai * HALF + m * 16) * ldc + col0 + bj * HALF; const f32x4 a = acc[ai][bj][m][0] * scale, b = acc[ai][bj][m][1] * scale;
            *(f32x2*)rowp = (f32x2){__uint_as_float(pk8(a[0], a[1], a[2], a[3])), __uint_as_float(pk8(b[0], b[1], b[2], b[3]))}; }
    }
};
struct EpiInE {
    static constexpr bool PERM = true, AFTER_DRAIN = false;
    bf16_t* P; const float* bias; const float* rope;
    __device__ __forceinline__ void operator()(const f32x4 (&acc)[2][2][4][2], const Unit& u, int wr, int wc, int fr, int fq) const {
        const int row0 = u.pm * BM + wr * 64 + fr; const int col0 = u.pn * BM + wc * 32 + 8 * fq; const bool latent = u.pm * BM < TL;
#pragma unroll
        for (int bj = 0; bj < 2; ++bj) {
            const int c0 = col0 + bj * HALF; const f32x4 b0 = *(const f32x4*)(bias + c0), b1 = *(const f32x4*)(bias + c0 + 4);
            const bool roped = c0 >= EC_Q && c0 < EC_V; const float sc = (c0 >= EC_Q && c0 < EC_K) ? SWA_QSCALE : 1.0f;
            const int part = ((c0 - EC_Q) >> 5) & 1; const int i0 = 8 * (fq & 1);
#pragma unroll
            for (int ai = 0; ai < 2; ++ai)
#pragma unroll
                for (int m = 0; m < 4; ++m) {
                    const int row = row0 + ai * HALF + m * 16; f32x4 v0 = acc[ai][bj][m][0] + b0, v1 = acc[ai][bj][m][1] + b1;
                    if (roped) {
                        f32x4 p0, p1;
#pragma unroll
                        for (int j = 0; j < 4; ++j) { p0[j] = xchg32(v0[j]); p1[j] = xchg32(v1[j]); }
                        if (latent) { const int s = row % SEQ; const int pos = part == 0 ? s / GRID_W : s % GRID_W; const float* t = rope + (size_t)(pos * (SWA_HD / 4) + i0) * 2;
                            const float sg = fq >= 2 ? 1.0f : -1.0f;
#pragma unroll
                            for (int j = 0; j < 4; ++j) { v0[j] = v0[j] * t[2 * j] + sg * p0[j] * t[2 * j + 1]; v1[j] = v1[j] * t[8 + 2 * j] + sg * p1[j] * t[8 + 2 * j + 1]; } }
                        v0 = v0 * sc; v1 = v1 * sc;
                    }
                    *(u32x4*)(P + (size_t)row * EPLD + c0) = pack8(v0, v1);
                    asm volatile("" ::: "memory");
                }
        }
    }
};
struct EpiInO {
    static constexpr bool PERM = true, AFTER_DRAIN = false;
    bf16_t* P; const float* bias; const float* rope; float* SSQ; bf16_t* Kb;
    __device__ __forceinline__ void operator()(const f32x4 (&acc)[2][2][4][2], const Unit& u, int wr, int wc, int fr, int fq) const {
        const int row0 = u.pm * BM + wr * 64 + fr; const int col0 = u.pn * BM + wc * 32 + 8 * fq; const bool latent = u.pm * BM < TL;
        f32x4 bv_[2][2];
#pragma unroll
        for (int bj = 0; bj < 2; ++bj) { const int c0 = col0 + bj * HALF; const bool in = c0 < ODD_IN; const int cc = in ? c0 : 0;
            bv_[bj][0] = *(const f32x4*)(bias + cc); bv_[bj][1] = *(const f32x4*)(bias + cc + 4); if (!in) { bv_[bj][0] = (f32x4){0.f, 0.f, 0.f, 0.f}; bv_[bj][1] = (f32x4){0.f, 0.f, 0.f, 0.f}; } }
        asm volatile("" ::: "memory");
#pragma unroll
        for (int ai = 0; ai < 2; ++ai)
#pragma unroll
            for (int m = 0; m < 4; ++m) {
                const int row = row0 + ai * HALF + m * 16; float ssq[2];
#pragma unroll
                for (int bj = 0; bj < 2; ++bj) {
                    const int c0 = col0 + bj * HALF; f32x4 v0 = acc[ai][bj][m][0], v1 = acc[ai][bj][m][1];
                    v0 = v0 + bv_[bj][0]; v1 = v1 + bv_[bj][1];
                    *(u32x4*)(P + (size_t)row * OPLD + c0) = pack8(v0, v1);
                    float s = 0.f;
#pragma unroll
                    for (int j = 0; j < 4; ++j) { const float a = bfr(v0[j]), b = bfr(v1[j]); s += a * a + b * b; }
                    ssq[bj] = s;
                    if (u.pn == 1 && bj == 1 && wc == 0) {
                        f32x4 p0, p1;
#pragma unroll
                        for (int j = 0; j < 4; ++j) { p0[j] = xchg16(v0[j]); p1[j] = xchg16(v1[j]); }
                        if (latent) { const int s2 = row % SEQ; const int pos = (fq >> 1) == 0 ? s2 / GRID_W : s2 % GRID_W; const float* t = rope + (size_t)(pos * (MLA_ROPE / 4)) * 2;
                            const float sg = (fq & 1) ? 1.0f : -1.0f;
#pragma unroll
                            for (int j = 0; j < 4; ++j) { v0[j] = v0[j] * t[2 * j] + sg * p0[j] * t[2 * j + 1]; v1[j] = v1[j] * t[8 + 2 * j] + sg * p1[j] * t[8 + 2 * j + 1]; } }
                        const u32x4 w = pack8(v0, v1);
#pragma unroll
                        for (int h = 0; h < MLA_H; ++h) *(u32x4*)(Kb + (size_t)row * MLA_H * MLA_QD + h * MLA_QD + MLA_NOPE + 8 * fq) = w;
                    }
                }
                if (u.pn == 0) { float s = ssq[0] + ssq[1]; s += xchg16(s); s += xchg32(s); if (fq == 0) SSQ[(size_t)row * 8 + wc] = s; }
                if (u.pn == 1) { float s = ssq[0]; s += xchg16(s); s += xchg32(s); if (fq == 0) SSQ[(size_t)row * 8 + 4 + wc] = s; }
                asm volatile("" ::: "memory");
            }
    }
};
struct EpiUq {
    static constexpr bool PERM = true, AFTER_DRAIN = false;
    bf16_t* Q; const float* rope; const float* SSQ;
    __device__ __forceinline__ void operator()(const f32x4 (&acc)[2][2][4][2], const Unit& u, int wr, int wc, int fr, int fq) const {
        { int t_ = threadIdx.x; asm volatile("" : "+v"(t_)); const int w_ = t_ >> 6, l_ = t_ & 63; wr = w_ >> 2; wc = w_ & 3; fr = l_ & 15; fq = l_ >> 4; }
        typedef unsigned u32x2 __attribute__((ext_vector_type(2)));
        const int row0 = u.pm * BM + wr * 64 + fr; const int col0 = u.pn * BM + wc * 32 + 8 * fq; const float sg = (fq & 1) ? 1.0f : -1.0f;
#pragma unroll
        for (int ai = 0; ai < 2; ++ai) {
            f32x4 ssq_[4];
#pragma unroll
            for (int m = 0; m < 4; ++m) ssq_[m] = *(const f32x4*)(SSQ + (size_t)(row0 + ai * HALF + m * 16) * 8);
            asm volatile("" ::: "memory");
            float rs_[4];
#pragma unroll
            for (int m = 0; m < 4; ++m) rs_[m] = 1.0f / sqrtf(((ssq_[m][0] + ssq_[m][1]) + (ssq_[m][2] + ssq_[m][3])) / (float)MLA_QR + LN_EPS);
#pragma unroll
            for (int m = 0; m < 4; ++m) {
                const int row = row0 + ai * HALF + m * 16; const float rs = rs_[m];
                const int s2 = row % SEQ; const int pos = (fq >> 1) == 0 ? s2 / GRID_W : s2 % GRID_W; const float* t = rope + (size_t)(pos * (MLA_ROPE / 4)) * 2;
#pragma unroll
                for (int bj = 0; bj < 2; ++bj) {
                    const int c0 = col0 + bj * HALF; const bool pe = ((c0 >> 5) % 3) == 2;
#pragma unroll
                    for (int n = 0; n < 2; ++n) {
                        f32x4 v = acc[ai][bj][m][n] * rs;
                        if (pe) { f32x4 q;
#pragma unroll
                            for (int j = 0; j < 4; ++j) q[j] = xchg16(v[j]);
#pragma unroll
                            for (int j = 0; j < 4; ++j) v[j] = v[j] * t[8 * n + 2 * j] + sg * q[j] * t[8 * n + 2 * j + 1]; }
                        v = v * MLA_QSCALE; u32x2 w; w.x = cvt_pk_bf16(v[0], v[1]); w.y = cvt_pk_bf16(v[2], v[3]);
                        *(u32x2*)(Q + (size_t)row * MLA_H * MLA_QD + c0 + 4 * n) = w;
                    }
                }
                asm volatile("" ::: "memory");
            }
        }
    }
};
struct EpiUkv {
    static constexpr bool PERM = true, AFTER_DRAIN = false;
    bf16_t* Kb; bf16_t* V; const float* SSQ;
    __device__ __forceinline__ void operator()(const f32x4 (&acc)[2][2][4][2], const Unit& u, int wr, int wc, int fr, int fq) const {
        { int t_ = threadIdx.x; asm volatile("" : "+v"(t_)); const int w_ = t_ >> 6, l_ = t_ & 63; wr = w_ >> 2; wc = w_ & 3; fr = l_ & 15; fq = l_ >> 4; }
        const int row0 = u.pm * BM + wr * 64 + fr; const int col0 = u.pn * BM + wc * 32 + 8 * fq;
#pragma unroll
        for (int ai = 0; ai < 2; ++ai) {
            f32x4 ssq_[4];
#pragma unroll
            for (int m = 0; m < 4; ++m) ssq_[m] = *(const f32x4*)(SSQ + (size_t)(row0 + ai * HALF + m * 16) * 8 + 4);
            asm volatile("" ::: "memory");
            float rs_[4];
#pragma unroll
            for (int m = 0; m < 4; ++m) rs_[m] = 1.0f / sqrtf(((ssq_[m][0] + ssq_[m][1]) + (ssq_[m][2] + ssq_[m][3])) / (float)MLA_KVR + LN_EPS);
#pragma unroll
            for (int m = 0; m < 4; ++m) {
                const int row = row0 + ai * HALF + m * 16; const float rs = rs_[m];
#pragma unroll
                for (int bj = 0; bj < 2; ++bj) {
                    const int c0 = col0 + bj * HALF; const u32x4 w = pack8(acc[ai][bj][m][0] * rs, acc[ai][bj][m][1] * rs);
                    if (c0 < MLA_H * MLA_NOPE) *(u32x4*)(Kb + (size_t)row * MLA_H * MLA_QD + (c0 / MLA_NOPE) * MLA_QD + c0 % MLA_NOPE) = w;
                    else *(u32x4*)(V + (size_t)row * MLA_H * MLA_V + (c0 - MLA_H * MLA_NOPE)) = w;
                }
                asm volatile("" ::: "memory");
            }
        }
    }
};
struct MoeOrder {
    static constexpr int TABC = N_EXP + 4;
    PG8_LAS const int* tab; const int* slot_tok; int nN, G, v; mutable int s0_, c0_;
    __device__ __forceinline__ void init(const int* cnt_, int nN_, int G_, int c_, PG8_LAS int* tab_, const int* slot_tok_ = nullptr) {
        static_assert(N_EXP <= 64, "one wave scans the tile counts");
        tab = tab_; slot_tok = slot_tok_; nN = nN_; G = G_; v = (G_ % NXCD == 0) ? (c_ % NXCD) * (G_ / NXCD) + c_ / NXCD : c_;
        __syncthreads();
        const int t = threadIdx.x;
        if (t < 64) { const int c = t < N_EXP ? cnt_[t * CS] : 0; int incl = (c + BM - 1) / BM;
#pragma unroll
            for (int d = 1; d < 64; d <<= 1) { const int y = __shfl_up(incl, d, 64); if (t >= d) incl += y; }
            if (t < N_EXP) { tab_[t + 1] = incl; tab_[TABC + t] = c; } if (t == 0) tab_[0] = 0; }
        __syncthreads();
    }
    __device__ __forceinline__ bool next(int i, Unit& u) const {
        const int L = i * G + v; const int rt = L / nN, ct = L % nN;
        if (rt >= __builtin_amdgcn_readfirstlane(tab[N_EXP])) return false;
        int lo = 0, hi = N_EXP;
#pragma unroll
        for (int st = 0; st < 6; ++st) { if (hi - lo > 1) { const int mid = (lo + hi) >> 1; if (rt >= __builtin_amdgcn_readfirstlane(tab[mid])) lo = mid; else hi = mid; } }
        u.pm = rt; u.pn = lo * nN + ct; s0_ = __builtin_amdgcn_readfirstlane(tab[lo]); c0_ = __builtin_amdgcn_readfirstlane(tab[TABC + lo]); return true;
    }
    __device__ __forceinline__ int a_row(const Unit& u, int r) const { int pos = (u.pm - s0_) * BM + r; pos = pos < c0_ ? pos : c0_ - 1; return slot_tok[(size_t)(u.pn / nN) * TT + pos]; }
    __device__ __forceinline__ void a_ready(const Unit&) const {}
    __device__ __forceinline__ void done(const Unit&) const {}
};
}
#endif


#ifndef CPU_SIM
namespace fa {
using bf16x8 = __attribute__((ext_vector_type(8))) short;
using s16x4  = __attribute__((ext_vector_type(4))) short;
using f32x16 = __attribute__((ext_vector_type(16))) float;
using u32x4  = __attribute__((ext_vector_type(4))) unsigned;
constexpr int NW = 8, QBLK = 32, KVBLK = 64, DV = 64;
constexpr int SHM_K = KVBLK * 256, SHM_V = KVBLK * DV * 2;
constexpr int NRING = 4;
constexpr int LDS_V = 0, LDS_K = NRING * SHM_V, LDS_WS = LDS_K + NRING * SHM_K, LDS_TOTAL = LDS_WS + NW * 64 * 4;
static_assert(LDS_TOTAL <= 147456, "attention LDS map");
constexpr float THR2 = 8.0f;
#define FA_KSWZ(row, colB) ((row) * 256 + ((colB) ^ (((row) & 15) << 4)))
#define FA_SBAR() __builtin_amdgcn_sched_barrier(0)
__device__ __forceinline__ int crow(int r, int hi) { return (r & 3) + 8 * (r >> 2) + 4 * hi; }
__device__ __forceinline__ unsigned cvtpk(float lo, float hi) { unsigned r; asm volatile("v_cvt_pk_bf16_f32 %0, %1, %2" : "=v"(r) : "v"(lo), "v"(hi)); return r; }
__device__ __forceinline__ void partialSM(f32x16& p0, f32x16& p1, float& m_reg, float& alpha) {
  float pmax = p0[0];
#pragma unroll
  for (int r = 1; r < 16; ++r) pmax = fmaxf(pmax, p0[r]);
#pragma unroll
  for (int r = 0; r < 16; ++r) pmax = fmaxf(pmax, p1[r]);
  { auto rr = __builtin_amdgcn_permlane32_swap(__float_as_uint(pmax), __float_as_uint(pmax), false, false); pmax = fmaxf(__uint_as_float(rr[0]), __uint_as_float(rr[1])); }
  float mn;
  if (__builtin_expect(__all(pmax - m_reg <= THR2), 1)) { mn = m_reg; alpha = 1.f; }
  else { mn = fmaxf(m_reg, pmax); alpha = __builtin_amdgcn_exp2f(m_reg - mn); m_reg = mn; }
#pragma unroll
  for (int r = 0; r < 16; ++r) p0[r] -= mn;
#pragma unroll
  for (int r = 0; r < 16; ++r) p1[r] -= mn;
#pragma unroll
  for (int r = 0; r < 16; ++r) p0[r] = __builtin_amdgcn_exp2f(p0[r]);
}
__device__ __forceinline__ void finishSM(f32x16& p0, f32x16& p1, float alpha, float& l_reg, bf16x8& pa0, bf16x8& pa1, bf16x8& pa2, bf16x8& pa3) {
#pragma unroll
  for (int r = 0; r < 16; ++r) p1[r] = __builtin_amdgcn_exp2f(p1[r]);
  float ps = 0;
#pragma unroll
  for (int r = 0; r < 16; ++r) ps += p0[r];
#pragma unroll
  for (int r = 0; r < 16; ++r) ps += p1[r];
  { auto rr = __builtin_amdgcn_permlane32_swap(__float_as_uint(ps), __float_as_uint(ps), false, false); ps = __uint_as_float(rr[0]) + __uint_as_float(rr[1]); }
  l_reg = l_reg * alpha + ps;
#define FA_PK4(P, BASE, OUT) do { unsigned a0 = cvtpk(P[BASE + 0], P[BASE + 1]), a1 = cvtpk(P[BASE + 2], P[BASE + 3]);   \
    unsigned b0 = cvtpk(P[BASE + 4], P[BASE + 5]), b1 = cvtpk(P[BASE + 6], P[BASE + 7]);                              \
    auto r0 = __builtin_amdgcn_permlane32_swap(a0, b0, false, false); auto r1 = __builtin_amdgcn_permlane32_swap(a1, b1, false, false); \
    u32x4 w = {r0[0], r1[0], r0[1], r1[1]}; OUT = *reinterpret_cast<bf16x8*>(&w); } while (0)
  FA_PK4(p0, 0, pa0); FA_PK4(p0, 8, pa1); FA_PK4(p1, 0, pa2); FA_PK4(p1, 8, pa3);
#undef FA_PK4
}
__device__ __forceinline__ void finishSM_probe(f32x16& p0, f32x16& p1, float& l_reg, bf16x8& pa0, bf16x8& pa1, bf16x8& pa2, bf16x8& pa3) {
  l_reg += p0[0] + p1[0];
#define FA_PK4(P, BASE, OUT) do { unsigned a0 = cvtpk(P[BASE + 0], P[BASE + 1]), a1 = cvtpk(P[BASE + 2], P[BASE + 3]);   \
    unsigned b0 = cvtpk(P[BASE + 4], P[BASE + 5]), b1 = cvtpk(P[BASE + 6], P[BASE + 7]);                              \
    auto r0 = __builtin_amdgcn_permlane32_swap(a0, b0, false, false); auto r1 = __builtin_amdgcn_permlane32_swap(a1, b1, false, false); \
    u32x4 w = {r0[0], r1[0], r0[1], r1[1]}; OUT = *reinterpret_cast<bf16x8*>(&w); } while (0)
  FA_PK4(p0, 0, pa0); FA_PK4(p0, 8, pa1); FA_PK4(p1, 0, pa2); FA_PK4(p1, 8, pa3);
#undef FA_PK4
}
template <int DQK> __device__ __forceinline__ void qkt(f32x16& p0, f32x16& p1, const FLAS char* Ks, const bf16x8* qr, int r32, int hi) {
  p0 = f32x16{}; p1 = f32x16{};
#pragma unroll
  for (int d0 = 0; d0 < DQK / 16; ++d0) { const int cb = (d0 * 16 + hi * 8) * 2;
    const bf16x8 b0 = *(const FLAS bf16x8*)(Ks + FA_KSWZ(r32, cb));
    const bf16x8 b1 = *(const FLAS bf16x8*)(Ks + FA_KSWZ(32 + r32, cb));
    p0 = __builtin_amdgcn_mfma_f32_32x32x16_bf16(b0, qr[d0], p0, 0, 0, 0);
    p1 = __builtin_amdgcn_mfma_f32_32x32x16_bf16(b1, qr[d0], p1, 0, 0, 0); }
}
__device__ __forceinline__ int v_st(int k, int c) { const int kk = (k & ~0xC) | ((k & 4) << 1) | ((k & 8) >> 1); return ((kk >> 3) * 2 + (c >> 5)) * 512 + ((kk & 7) * 32 + (c & 31)) * 2; }
__device__ __forceinline__ int v_rd_base(int lane) { return ((lane & 3) << 3) | (((lane >> 2) & 3) << 6) | (((lane >> 4) & 1) << 5) | (((lane >> 5) & 1) << 8); }
constexpr int v_rd_off(int d0, int ks, int half) { return d0 * 512 + ks * 2048 + half * 1024; }
template <int OFF> __device__ __forceinline__ s16x4 tr_read(int vb) { s16x4 r; asm volatile("ds_read_b64_tr_b16 %0, %1 offset:%2" : "=&v"(r) : "v"(vb), "i"(OFF) : "memory"); return r; }
template <int D0> __device__ __forceinline__ void pv_one(f32x16& od, int vb, bf16x8 pa0, bf16x8 pa1, bf16x8 pa2, bf16x8 pa3) {
  const s16x4 l0 = tr_read<v_rd_off(D0, 0, 0)>(vb), h0 = tr_read<v_rd_off(D0, 0, 1)>(vb), l1 = tr_read<v_rd_off(D0, 1, 0)>(vb), h1 = tr_read<v_rd_off(D0, 1, 1)>(vb);
  const s16x4 l2 = tr_read<v_rd_off(D0, 2, 0)>(vb), h2 = tr_read<v_rd_off(D0, 2, 1)>(vb), l3 = tr_read<v_rd_off(D0, 3, 0)>(vb), h3 = tr_read<v_rd_off(D0, 3, 1)>(vb);
  asm volatile("s_waitcnt lgkmcnt(0)" ::: "memory"); FA_SBAR();
#define FA_PK(L, H) (bf16x8){L[0], L[1], L[2], L[3], H[0], H[1], H[2], H[3]}
  od = __builtin_amdgcn_mfma_f32_32x32x16_bf16(pa0, FA_PK(l0, h0), od, 0, 0, 0);
  od = __builtin_amdgcn_mfma_f32_32x32x16_bf16(pa1, FA_PK(l1, h1), od, 0, 0, 0);
  od = __builtin_amdgcn_mfma_f32_32x32x16_bf16(pa2, FA_PK(l2, h2), od, 0, 0, 0);
  od = __builtin_amdgcn_mfma_f32_32x32x16_bf16(pa3, FA_PK(l3, h3), od, 0, 0, 0);
#undef FA_PK
}
__device__ __forceinline__ void pv_all(f32x16* o, int vb, bf16x8 pa0, bf16x8 pa1, bf16x8 pa2, bf16x8 pa3) { pv_one<0>(o[0], vb, pa0, pa1, pa2, pa3); pv_one<1>(o[1], vb, pa0, pa1, pa2, pa3); }
struct VFrag { s16x4 f[16]; };
__device__ __forceinline__ void pv_reads(VFrag& v, int vb) {
  v.f[0] = tr_read<v_rd_off(0, 0, 0)>(vb); v.f[1] = tr_read<v_rd_off(0, 0, 1)>(vb); v.f[2] = tr_read<v_rd_off(0, 1, 0)>(vb); v.f[3] = tr_read<v_rd_off(0, 1, 1)>(vb);
  v.f[4] = tr_read<v_rd_off(0, 2, 0)>(vb); v.f[5] = tr_read<v_rd_off(0, 2, 1)>(vb); v.f[6] = tr_read<v_rd_off(0, 3, 0)>(vb); v.f[7] = tr_read<v_rd_off(0, 3, 1)>(vb);
  v.f[8] = tr_read<v_rd_off(1, 0, 0)>(vb); v.f[9] = tr_read<v_rd_off(1, 0, 1)>(vb); v.f[10] = tr_read<v_rd_off(1, 1, 0)>(vb); v.f[11] = tr_read<v_rd_off(1, 1, 1)>(vb);
  v.f[12] = tr_read<v_rd_off(1, 2, 0)>(vb); v.f[13] = tr_read<v_rd_off(1, 2, 1)>(vb); v.f[14] = tr_read<v_rd_off(1, 3, 0)>(vb); v.f[15] = tr_read<v_rd_off(1, 3, 1)>(vb);
}
__device__ __forceinline__ void pv_mfmas(f32x16* o, const VFrag& v, bf16x8 pa0, bf16x8 pa1, bf16x8 pa2, bf16x8 pa3) {
  asm volatile("s_waitcnt lgkmcnt(0)" ::: "memory"); FA_SBAR();
#define FA_PK(L, H) (bf16x8){L[0], L[1], L[2], L[3], H[0], H[1], H[2], H[3]}
  o[0] = __builtin_amdgcn_mfma_f32_32x32x16_bf16(pa0, FA_PK(v.f[0], v.f[1]), o[0], 0, 0, 0); o[1] = __builtin_amdgcn_mfma_f32_32x32x16_bf16(pa0, FA_PK(v.f[8], v.f[9]), o[1], 0, 0, 0);
  o[0] = __builtin_amdgcn_mfma_f32_32x32x16_bf16(pa1, FA_PK(v.f[2], v.f[3]), o[0], 0, 0, 0); o[1] = __builtin_amdgcn_mfma_f32_32x32x16_bf16(pa1, FA_PK(v.f[10], v.f[11]), o[1], 0, 0, 0);
  o[0] = __builtin_amdgcn_mfma_f32_32x32x16_bf16(pa2, FA_PK(v.f[4], v.f[5]), o[0], 0, 0, 0); o[1] = __builtin_amdgcn_mfma_f32_32x32x16_bf16(pa2, FA_PK(v.f[12], v.f[13]), o[1], 0, 0, 0);
  o[0] = __builtin_amdgcn_mfma_f32_32x32x16_bf16(pa3, FA_PK(v.f[6], v.f[7]), o[0], 0, 0, 0); o[1] = __builtin_amdgcn_mfma_f32_32x32x16_bf16(pa3, FA_PK(v.f[14], v.f[15]), o[1], 0, 0, 0);
#undef FA_PK
}

struct AllTiles { __device__ __forceinline__ bool operator()(int, int) const { return true; } };
template <int DQK, class RowOf, class Mask, int VAR = 0, class Act = AllTiles>
__device__ __forceinline__ void attn_unit(const bf16_t* Qb, int ldq, const bf16_t* Kbase, int ldk, const bf16_t* Vbase, int ldv, bf16_t* Ob, int ldo, int NT, const RowOf& rowof, const Mask& mask, float m0, float l0, FLAS char* lds, const Act& act = Act{}) {
  int tid = threadIdx.x; asm volatile("" : "+v"(tid));
  const int wid = tid >> 6, lane = tid & 63, r32 = lane & 31, hi = lane >> 5; const int swid = __builtin_amdgcn_readfirstlane(wid);
  FLAS char* V_lds = lds + LDS_V; FLAS char* K_lds = lds + LDS_K;
  FLAS float* ws = (FLAS float*)(lds + LDS_WS) + wid * 64; FLAS float* li_l = ws; FLAS float* al_l = ws + 32;
  float m_reg = m0, l_reg = l0; f32x16 o[2] = {}; bf16x8 qr[DQK / 16];
  const bf16_t* Qw = Qb + (long)(wid * QBLK + r32) * ldq + hi * 8;
#pragma unroll
  for (int d0 = 0; d0 < DQK / 16; ++d0) qr[d0] = *reinterpret_cast<const bf16x8*>(Qw + d0 * 16);
  constexpr int NCH = DQK / 8;
  unsigned kof[2], vof;
#pragma unroll
  for (int i = 0; i < 2; ++i) { const int r = 8 * wid + 4 * i + (lane >> 4); int c = (lane & 15) ^ (r & 15); if (c >= NCH) c &= 7; kof[i] = (unsigned)(r * ldk * 2 + c * 16); }
  { const int o = lane * 16, kk = 8 * wid + ((o & 511) >> 6), c = 32 * (o >> 9) + ((o & 63) >> 1); const int k = (kk & ~0xC) | ((kk & 4) << 1) | ((kk & 8) >> 1); vof = (unsigned)(k * ldv * 2 + c * 2); }
  const int vb0 = (int)(uintptr_t)V_lds + v_rd_base(lane);
  const int qrow = wid * QBLK + r32;
#define FA_DMA(t, b) do { const long row0_ = rowof(t); const char* kb_ = (const char*)(Kbase + row0_ * ldk); const char* vb_ = (const char*)(Vbase + row0_ * ldv); \
    __builtin_amdgcn_global_load_lds((const unsigned*)(kb_ + kof[0]), (FLAS unsigned*)(K_lds + (b) * SHM_K + swid * 2048), 16, 0, 0); \
    __builtin_amdgcn_global_load_lds((const unsigned*)(kb_ + kof[1]), (FLAS unsigned*)(K_lds + (b) * SHM_K + swid * 2048 + 1024), 16, 0, 0); \
    __builtin_amdgcn_global_load_lds((const unsigned*)(vb_ + vof), (FLAS unsigned*)(V_lds + (b) * SHM_V + swid * 1024), 16, 0, 0); } while (0)
#define FA_RESC(a) do { if (__any((a) < 1.f)) { if (hi == 0) al_l[r32] = (a); asm volatile("s_waitcnt lgkmcnt(0)" ::: "memory"); \
    _Pragma("unroll") for (int d = 0; d < 2; ++d) _Pragma("unroll") for (int r = 0; r < 16; ++r) o[d][r] *= al_l[crow(r, hi)]; } } while (0)
  f32x16 pA0, pA1, pB0, pB1; float alA, alB; bf16x8 pa0, pa1, pa2, pa3; VFrag vf;
#define FA_SYNC() do { if constexpr (!(VAR & 1)) { asm volatile("s_waitcnt lgkmcnt(0)" ::: "memory"); __builtin_amdgcn_s_barrier(); asm volatile("" ::: "memory"); } } while (0)
#define FA_QKT(P0, P1, KS) do { if constexpr (VAR & 4) { _Pragma("unroll") for (int r_ = 0; r_ < 16; ++r_) { P0[r_] = m_reg * (float)r_; P1[r_] = l_reg - (float)r_; } } else qkt<DQK>(P0, P1, KS, qr, r32, hi); } while (0)
#define FA_PART(P0, P1, AL) do { if constexpr (VAR & 2) { AL = 1.f; } else partialSM(P0, P1, m_reg, AL); } while (0)
#define FA_FIN(P0, P1, AL) do { if constexpr (VAR & 2) finishSM_probe(P0, P1, l_reg, pa0, pa1, pa2, pa3); else finishSM(P0, P1, AL, l_reg, pa0, pa1, pa2, pa3); } while (0)
#define FA_PV(VB) do { if constexpr (VAR & 4) { _Pragma("unroll") for (int r_ = 0; r_ < 16; ++r_) { o[0][r_] += __builtin_bit_cast(float, (int)pa0[r_ & 7] << 16); o[1][r_] += __builtin_bit_cast(float, (int)pa2[r_ & 7] << 16); } } else pv_all(o, VB, pa0, pa1, pa2, pa3); } while (0)
#define FA_KAHEAD() do { __builtin_amdgcn_sched_group_barrier(0x100, 4, 0); _Pragma("unroll") for (int i_ = 0; i_ < DQK / 16; ++i_) { \
    __builtin_amdgcn_sched_group_barrier(0x008, 2, 0); if (i_ + 2 < DQK / 16) __builtin_amdgcn_sched_group_barrier(0x100, 2, 0); } } while (0)
#define FA_STEP(J, PC0, PC1, ALC, PP0, PP1, ALP, RK, RV, RW) do { const int j_ = (J); const bool ac_ = act(j_, swid), ap_ = act(j_ - 1, swid); \
    if (j_ + 2 < NT) FA_DMA(j_ + 2, RW); \
    if (ap_) pv_reads(vf, vb0 + (RV) * SHM_V); \
    FA_SBAR(); if (ac_) { FA_QKT(PC0, PC1, K_lds + (RK) * SHM_K); mask(PC0, PC1, j_, qrow, hi); } \
    if (ap_) FA_FIN(PP0, PP1, ALP); if (ac_ && ap_) FA_KAHEAD(); FA_SBAR(); \
    if (ap_) pv_mfmas(o, vf, pa0, pa1, pa2, pa3); if (ac_) FA_PART(PC0, PC1, ALC); else ALC = 1.f; \
    FA_RESC(ALC); \
    if (j_ + 2 < NT) asm volatile("s_waitcnt vmcnt(3)" ::: "memory"); else asm volatile("s_waitcnt vmcnt(0)" ::: "memory"); \
    FA_SYNC(); } while (0)
  FA_DMA(0, 0); FA_DMA(1, 1); asm volatile("s_waitcnt vmcnt(0)" ::: "memory"); FA_SYNC();
  FA_DMA(2, 2);
  if (act(0, swid)) { qkt<DQK>(pA0, pA1, K_lds, qr, r32, hi); mask(pA0, pA1, 0, qrow, hi); partialSM(pA0, pA1, m_reg, alA); } else alA = 1.f;
  int j = 1;
  for (; j + 3 < NT; j += 4) {
    FA_STEP(j,     pB0, pB1, alB, pA0, pA1, alA, 1, 0, 3);
    FA_STEP(j + 1, pA0, pA1, alA, pB0, pB1, alB, 2, 1, 0);
    FA_STEP(j + 2, pB0, pB1, alB, pA0, pA1, alA, 3, 2, 1);
    FA_STEP(j + 3, pA0, pA1, alA, pB0, pB1, alB, 0, 3, 2);
  }
  FA_STEP(j,     pB0, pB1, alB, pA0, pA1, alA, 1, 0, 3);
  FA_STEP(j + 1, pA0, pA1, alA, pB0, pB1, alB, 2, 1, 0);
  FA_STEP(j + 2, pB0, pB1, alB, pA0, pA1, alA, 3, 2, 1);
  if (act(NT - 1, swid)) { FA_FIN(pB0, pB1, alB); FA_SBAR(); FA_PV(vb0 + 3 * SHM_V); }
#undef FA_STEP
#undef FA_KAHEAD
  if (hi == 0) li_l[r32] = l_reg; asm volatile("s_waitcnt lgkmcnt(0)" ::: "memory");
  float rli[16];
#pragma unroll
  for (int r = 0; r < 16; ++r) rli[r] = __builtin_amdgcn_rcpf(li_l[crow(r, hi)]);
  bf16_t* Ow = Ob + (long)(wid * QBLK) * ldo;
#pragma unroll
  for (int r = 0; r < 16; ++r) { const int orow = crow(r, hi);
#pragma unroll
    for (int d0 = 0; d0 < 2; ++d0) Ow[(long)orow * ldo + d0 * 32 + r32] = (bf16_t)cvtpk(o[d0][r] * rli[r], 0.f); }
  __syncthreads();
#undef FA_DMA
#undef FA_RESC
#undef FA_SYNC
#undef FA_QKT
#undef FA_PART
#undef FA_FIN
#undef FA_PV
}
struct NoMask { __device__ __forceinline__ void operator()(f32x16&, f32x16&, int, int, int) const {} };
}
#endif


#ifndef CPU_SIM
struct XcdBarrier;
__device__ __forceinline__ void xcd_barrier(const XcdBarrier& b);
namespace fast {
typedef float f32x4 __attribute__((ext_vector_type(4)));
typedef unsigned u32x2 __attribute__((ext_vector_type(2)));
typedef unsigned u32x4 __attribute__((ext_vector_type(4)));
__device__ __forceinline__ float wave_sum(float v) {
    v += __builtin_bit_cast(float, __builtin_amdgcn_update_dpp(0, __builtin_bit_cast(int, v), 0xB1, 0xF, 0xF, false));
    v += __builtin_bit_cast(float, __builtin_amdgcn_update_dpp(0, __builtin_bit_cast(int, v), 0x4E, 0xF, 0xF, false));
    v += __builtin_bit_cast(float, __builtin_amdgcn_update_dpp(0, __builtin_bit_cast(int, v), 0x141, 0xF, 0xF, false));
    v += __builtin_bit_cast(float, __builtin_amdgcn_update_dpp(0, __builtin_bit_cast(int, v), 0x140, 0xF, 0xF, false));
    v += __builtin_bit_cast(float, __builtin_amdgcn_update_dpp(0, __builtin_bit_cast(int, v), 0x142, 0xA, 0xF, false));
    v += __builtin_bit_cast(float, __builtin_amdgcn_update_dpp(0, __builtin_bit_cast(int, v), 0x143, 0xC, 0xF, false));
    return __builtin_bit_cast(float, __builtin_amdgcn_readlane(__builtin_bit_cast(int, v), 63));
}
__device__ __forceinline__ unsigned pk2(float lo, float hi) { unsigned r; asm("v_cvt_pk_bf16_f32 %0, %1, %2" : "=v"(r) : "v"(lo), "v"(hi)); return r; }
__device__ __forceinline__ bf16_t f2bf_hw(float v) { return (bf16_t)pk2(v, 0.f); }
__device__ __forceinline__ void cvt_item(const float* src, int ld_src, const float* scale, bf16_t* dst, int ldd, int dst_row0, int k0, int n0, FLAS float* scr, int lane) {
#pragma unroll 8
    for (int i = 0; i < 32; ++i) { const int kk = 2 * i + (lane >> 5); float v = src[(size_t)(k0 + kk) * ld_src + n0 + (lane & 31)]; if (scale) v *= scale[k0 + kk]; scr[kk * 33 + (lane & 31)] = v; }
    asm volatile("s_waitcnt lgkmcnt(0)" ::: "memory");
    const int c = lane & 7;
#pragma unroll
    for (int j = 0; j < 4; ++j) { const int n = (lane >> 3) + 8 * j; const FLAS float* s = scr + (8 * c) * 33 + n;
        u32x4 o; o.x = pk2(s[0 * 33], s[1 * 33]); o.y = pk2(s[2 * 33], s[3 * 33]); o.z = pk2(s[4 * 33], s[5 * 33]); o.w = pk2(s[6 * 33], s[7 * 33]);
        *(u32x4*)(dst + (size_t)(dst_row0 + n0 + n) * ldd + k0 + 8 * c) = o; }
    asm volatile("s_waitcnt lgkmcnt(0)" ::: "memory");
}
__device__ __forceinline__ void cvt_item8(const float* src, int ld_src, float mul, unsigned char* dst, int ldd, int dst_row0, int k0, int n0, FLAS float* scr, int lane) {
#pragma unroll 8
    for (int i = 0; i < 32; ++i) { const int kk = 2 * i + (lane >> 5); scr[kk * 33 + (lane & 31)] = src[(size_t)(k0 + kk) * ld_src + n0 + (lane & 31)] * mul; }
    asm volatile("s_waitcnt lgkmcnt(0)" ::: "memory");
    const int c = lane & 3;
#pragma unroll
    for (int j = 0; j < 2; ++j) { const int n = (lane >> 2) + 16 * j; const FLAS float* s = scr + (16 * c) * 33 + n;
        u32x4 o; o.x = pg8::pk8(s[0 * 33], s[1 * 33], s[2 * 33], s[3 * 33]); o.y = pg8::pk8(s[4 * 33], s[5 * 33], s[6 * 33], s[7 * 33]);
        o.z = pg8::pk8(s[8 * 33], s[9 * 33], s[10 * 33], s[11 * 33]); o.w = pg8::pk8(s[12 * 33], s[13 * 33], s[14 * 33], s[15 * 33]);
        *(u32x4*)(dst + (size_t)(dst_row0 + n0 + n) * ldd + k0 + 16 * c) = o; }
    asm volatile("s_waitcnt lgkmcnt(0)" ::: "memory");
}
struct MoeItem { const float* src; unsigned char* dst; int ld_src, ldd, drow, k0, n0; float mul; };
__device__ __forceinline__ void moe_item(const Params& p, int m, MoeItem& it) {
    constexpr int I_W13 = (DM / 64) * (D_EXP / 32), I_W2 = (D_EXP / 64) * (DM / 32), I_EXP = 2 * I_W13 + I_W2;
    const int le = m / I_EXP; int r = m - le * I_EXP;
    if (r < 2 * I_W13) { const int w = r / I_W13; r -= w * I_W13; const int nb = D_EXP / 32, n0 = 32 * (r % nb);
        it.src = (w ? p.moe_w3 : p.moe_w1) + (size_t)le * DM * D_EXP; it.ld_src = D_EXP; it.mul = FP8_SW1; it.dst = (unsigned char*)p.W_up + (size_t)le * 2 * D_EXP * DM; it.ldd = DM;
        it.drow = (n0 / UPG) * UPG + w * UPG + n0; it.k0 = 64 * (r / nb); it.n0 = n0; }
    else { r -= 2 * I_W13; const int nb = DM / 32, n0 = 32 * (r % nb);
        it.src = p.moe_w2 + (size_t)le * D_EXP * DM; it.ld_src = DM; it.mul = FP8_SW2; it.dst = (unsigned char*)p.W_dn + (size_t)le * DM * D_EXP; it.ldd = D_EXP; it.drow = n0; it.k0 = 64 * (r / nb); it.n0 = n0; }
}
__device__ __forceinline__ void moe_item_load(const MoeItem& it, float (&r)[32], int lane) {
    const float* s = it.src + (size_t)(it.k0 + (lane >> 5)) * it.ld_src + it.n0 + (lane & 31);
#pragma unroll
    for (int i = 0; i < 32; ++i) r[i] = s[(size_t)(2 * i) * it.ld_src];
}
__device__ __forceinline__ void moe_item_store(const MoeItem& it, const float (&r)[32], FLAS float* scr, int lane) {
#pragma unroll
    for (int i = 0; i < 32; ++i) scr[(2 * i + (lane >> 5)) * 33 + (lane & 31)] = r[i] * it.mul;
    asm volatile("s_waitcnt lgkmcnt(0)" ::: "memory");
    const int c = lane & 3;
#pragma unroll
    for (int j = 0; j < 2; ++j) { const int n = (lane >> 2) + 16 * j; const FLAS float* s = scr + (16 * c) * 33 + n;
        u32x4 o; o.x = pg8::pk8(s[0 * 33], s[1 * 33], s[2 * 33], s[3 * 33]); o.y = pg8::pk8(s[4 * 33], s[5 * 33], s[6 * 33], s[7 * 33]);
        o.z = pg8::pk8(s[8 * 33], s[9 * 33], s[10 * 33], s[11 * 33]); o.w = pg8::pk8(s[12 * 33], s[13 * 33], s[14 * 33], s[15 * 33]);
        *(u32x4*)(it.dst + (size_t)(it.drow + n) * it.ldd + it.k0 + 16 * c) = o; }
    asm volatile("s_waitcnt lgkmcnt(0)" ::: "memory");
}
__device__ __forceinline__ void moe_stream_range(const Params& p, FLAS float* scr, int lane, int m0, int mend, int stride) {
    float rA[32], rB[32]; MoeItem ia, ib; int m = m0;
    if (m >= mend) return;
    moe_item(p, m, ia); moe_item_load(ia, rA, lane);
    for (;;) {
        const int mb = m + stride; const bool hasB = mb < mend;
        if (hasB) { moe_item(p, mb, ib); moe_item_load(ib, rB, lane); }
        moe_item_store(ia, rA, scr, lane);
        if (!hasB) break;
        const int ma = mb + stride; const bool hasA = ma < mend;
        if (hasA) { moe_item(p, ma, ia); moe_item_load(ia, rA, lane); }
        moe_item_store(ib, rB, scr, lane);
        if (!hasA) break;
        m = ma;
    }
}
constexpr int WS_HEAD = 6;
constexpr int WS_NMH = N_EXP * (2 * (DM / 64) * (D_EXP / 32) + (D_EXP / 64) * (DM / 32)), WS_A = WS_NMH * 3 / 8, WS_B = WS_A + WS_NMH * 13 / 50, WS_P = WS_NMH / 8;
constexpr int WS_SMALL0 = (DM / 64) * (EVEN_IN / 32);
constexpr int WS_L1A = WS_NMH + WS_NMH * 7 / 24, WS_L1B = WS_L1A + WS_NMH * 7 / 16;
__device__ __forceinline__ void moe_weights_stream(const Params& p, FLAS unsigned char* lds_raw, int nmod) {
    int t_ = threadIdx.x; asm volatile("" : "+v"(t_)); const int lane = t_ & 63, wave = t_ >> 6; FLAS float* scr = (FLAS float*)lds_raw + wave * (64 * 33);
    constexpr int NM = WS_P;
    const int bx = (int)blockIdx.x, G = (int)gridDim.x; const int nfree = G > nmod ? G - nmod : 0; const int head = nfree * 8 * WS_HEAD < NM ? nfree * 8 * WS_HEAD : 0;
    if (head && bx >= nmod) moe_stream_range(p, scr, lane, __builtin_amdgcn_readfirstlane((bx - nmod) * 8 + wave), head, nfree * 8);
    moe_stream_range(p, scr, lane, head + __builtin_amdgcn_readfirstlane(bx * 8 + wave), NM, G * 8);
}
__device__ __forceinline__ void moe_stream_l1(const Params& p, FLAS float* scr, int lane, int gw, int NGW, int slice, int per) {
    constexpr int I_W13 = (DM / 64) * (D_EXP / 32), I_W2 = (D_EXP / 64) * (DM / 32), NMH = N_EXP * (2 * I_W13 + I_W2);
    const int m0 = NMH + gw + slice * per * NGW; const int mend = (m0 + per * NGW < 2 * NMH) ? m0 + per * NGW : 2 * NMH;
    moe_stream_range(p, scr, lane, m0, mend, NGW);
}
__device__ __forceinline__ void moe_stream_extra(const Params& p, FLAS unsigned char* scr0, int lo, int hi, int first) {
    int t_ = threadIdx.x; asm volatile("" : "+v"(t_)); const int lane = t_ & 63, wave = t_ >> 6; const int bx = (int)blockIdx.x, G = (int)gridDim.x;
    if (first >= G) first = 0;
    if (bx < first) return;
    moe_stream_range(p, (FLAS float*)scr0 + wave * (64 * 33), lane, lo + __builtin_amdgcn_readfirstlane((bx - first) * 8 + wave), hi, (G - first) * 8);
}
__device__ __forceinline__ void weights_phase(const Params& p, FLAS unsigned char* lds_raw, int part, int wg0, int it_lo = 0, int it_hi = 1 << 30) {
    int t_ = threadIdx.x; asm volatile("" : "+v"(t_)); const int lane = t_ & 63, wave = t_ >> 6; FLAS float* scr = (FLAS float*)lds_raw + wave * (64 * 33);
    if ((int)blockIdx.x < wg0) return;
    const int gw = ((int)blockIdx.x - wg0) * 8 + wave, NGW = ((int)gridDim.x - wg0) * 8;
    constexpr int I_EIN = (DM / 64) * (EVEN_IN / 32), I_SQ = (DM / 64) * (DM / 32), I_OIN = (DM / 64) * (ODD_IN / 32), I_UQ = (MLA_QR / 64) * (MLA_H * MLA_QD / 32), I_UK = (MLA_KVR / 64) * (MLA_H * MLA_NOPE / 32);
    constexpr int I_W13 = (DM / 64) * (D_EXP / 32), I_W2 = (D_EXP / 64) * (DM / 32), I_EXP = 2 * I_W13 + I_W2;
    constexpr int NSMALL = I_EIN + 2 * I_SQ + I_OIN + I_UQ + 2 * I_UK, NITEMS = NSMALL + 2 * N_EXP * I_EXP;
    constexpr int NPART0 = NSMALL + N_EXP * I_EXP;
    (void)NITEMS; (void)NPART0;
    if (it_hi > NSMALL) it_hi = NSMALL;
    for (int it = it_lo + gw; it < (part ? 0 : it_hi); it += NGW) {
        int r = it;
        if (r < I_EIN) { const int nb = EVEN_IN / 32; cvt_item(p.e_w_in, EVEN_IN, nullptr, p.W_ein, DM, 0, 64 * (r / nb), 32 * (r % nb), scr, lane); continue; } r -= I_EIN;
        if (r < I_SQ) { const int nb = DM / 32; cvt_item(p.e_w_out, DM, nullptr, p.W_eout, DM, 0, 64 * (r / nb), 32 * (r % nb), scr, lane); continue; } r -= I_SQ;
        if (r < I_SQ) { const int nb = DM / 32; cvt_item(p.o_w_out, DM, nullptr, p.W_oout, DM, 0, 64 * (r / nb), 32 * (r % nb), scr, lane); continue; } r -= I_SQ;
        if (r < I_OIN) { const int nb = ODD_IN / 32; cvt_item(p.o_w_in, ODD_IN, nullptr, p.W_oin, DM, 0, 64 * (r / nb), 32 * (r % nb), scr, lane); continue; } r -= I_OIN;
        if (r < I_UQ) { const int nb = MLA_H * MLA_QD / 32; cvt_item(p.o_w_uq, MLA_H * MLA_QD, p.o_q_norm, p.W_uq, MLA_QR, 0, 64 * (r / nb), 32 * (r % nb), scr, lane); continue; } r -= I_UQ;
        if (r < I_UK) { const int nb = MLA_H * MLA_NOPE / 32; cvt_item(p.o_w_uk, MLA_H * MLA_NOPE, p.o_kv_norm, p.W_ukv, MLA_KVR, 0, 64 * (r / nb), 32 * (r % nb), scr, lane); continue; } r -= I_UK;
        if (r < I_UK) { const int nb = MLA_H * MLA_V / 32; cvt_item(p.o_w_uv, MLA_H * MLA_V, p.o_kv_norm, p.W_ukv, MLA_KVR, MLA_H * MLA_NOPE, 64 * (r / nb), 32 * (r % nb), scr, lane); continue; } r -= I_UK;
        const int le = r / I_EXP; r -= le * I_EXP;
        if (r < 2 * I_W13) { const int w = r / I_W13; r -= w * I_W13; const int nb = D_EXP / 32, n0 = 32 * (r % nb);
            cvt_item8((w ? p.moe_w3 : p.moe_w1) + (size_t)le * DM * D_EXP, D_EXP, FP8_SW1, (unsigned char*)p.W_up + (size_t)le * 2 * D_EXP * DM, DM, (n0 / UPG) * UPG + w * UPG, 64 * (r / nb), n0, scr, lane); continue; }
        r -= 2 * I_W13; { const int nb = DM / 32; cvt_item8(p.moe_w2 + (size_t)le * D_EXP * DM, DM, FP8_SW2, (unsigned char*)p.W_dn + (size_t)le * DM * D_EXP, D_EXP, 0, 64 * (r / nb), 32 * (r % nb), scr, lane); }
    }
    if (part == 0 && it_lo == 0) for (long i = (long)((int)blockIdx.x - wg0) * 512 + threadIdx.x; i < (long)(OPLD - ODD_IN) * DM / 8; i += (long)((int)gridDim.x - wg0) * 512) *(u32x4*)(p.W_oin + (size_t)ODD_IN * DM + i * 8) = (u32x4){0u, 0u, 0u, 0u};
}

__device__ __forceinline__ void mod_phase(const Params& p, FLAS unsigned char* lds_raw) {
    FLAS float* sc = (FLAS float*)lds_raw;
    FLAS float* part = sc + (NB + 1) * DM;
    const int tid = threadIdx.x;
    constexpr int NC = 64, NU = 2 * (6 * DM / NC);
    if ((int)blockIdx.x >= NU) return;
    for (int i = tid; i < (NB + 1) * DM; i += 512) { const int cn = i / DM, k = i % DM; const float v = cn < NB ? p.c[cn * DM + k] : p.c_ctx[k]; sc[i] = v / (1.0f + __expf(-v)); }
    __syncthreads();
    for (int u = blockIdx.x; u < NU; u += gridDim.x) {
        const int l = u / (6 * DM / NC), j = (u % (6 * DM / NC)) * NC + (tid & (NC - 1)), kq = tid / NC;
        const float* w = p.w_mod + (size_t)l * DM * 6 * DM + j;
        float acc[NB + 1];
#pragma unroll
        for (int cn = 0; cn <= NB; ++cn) acc[cn] = 0.f;
        static_assert(DM / 8 == 8 * 16, "eight batches of sixteen");
        float wv[2][16]; const int kb = kq * (DM / 8);
#pragma unroll
        for (int i = 0; i < 16; ++i) wv[0][i] = w[(size_t)(kb + i) * 6 * DM];
#pragma unroll
        for (int bt = 0; bt < 8; ++bt) { const int k0 = kb + 16 * bt;
            if (bt + 1 < 8) {
#pragma unroll
                for (int i = 0; i < 16; ++i) wv[(bt + 1) & 1][i] = w[(size_t)(k0 + 16 + i) * 6 * DM]; }
            f32x4 s4[NB + 1][4];
#pragma unroll
            for (int cn = 0; cn <= NB; ++cn)
#pragma unroll
                for (int q = 0; q < 4; ++q) s4[cn][q] = *(const FLAS f32x4*)(sc + cn * DM + k0 + 4 * q);
            asm volatile("" ::: "memory");
#pragma unroll
            for (int i = 0; i < 16; ++i)
#pragma unroll
                for (int cn = 0; cn <= NB; ++cn) acc[cn] += s4[cn][i >> 2][i & 3] * wv[bt & 1][i]; }
#pragma unroll
        for (int cn = 0; cn <= NB; ++cn) part[(kq * (NB + 1) + cn) * NC + (tid & (NC - 1))] = acc[cn];
        __syncthreads();
        if (tid < NC) {
#pragma unroll
            for (int cn = 0; cn <= NB; ++cn) { float s = 0.f;
#pragma unroll
                for (int q = 0; q < 8; ++q) s += part[(q * (NB + 1) + cn) * NC + tid];
                p.MOD[((size_t)l * (NB + 1) + cn) * 6 * DM + j] = s + p.b_mod[(size_t)l * 6 * DM + j]; }
        }
        __syncthreads();
    }
}
__device__ __forceinline__ void ld_row_f32(const float* row, int lane, f32x4 (&v)[4]) {
#pragma unroll
    for (int j = 0; j < 4; ++j) v[j] = *(const f32x4*)(row + 256 * j + 4 * lane);
}
__device__ __forceinline__ void ld_row_bf16(const bf16_t* row, int lane, f32x4 (&v)[4]) {
#pragma unroll
    for (int j = 0; j < 4; ++j) { const u32x2 w = *(const u32x2*)(row + 256 * j + 4 * lane); v[j] = (f32x4){__uint_as_float(w.x << 16), __uint_as_float(w.x & 0xffff0000u), __uint_as_float(w.y << 16), __uint_as_float(w.y & 0xffff0000u)}; }
}
__device__ __forceinline__ void ld_row_fp8(const unsigned char* row, int lane, f32x4 (&v)[4]) {
#pragma unroll
    for (int j = 0; j < 4; ++j) { const int w = *(const int*)(row + 256 * j + 4 * lane);
        v[j] = (f32x4){__builtin_amdgcn_cvt_f32_fp8(w, 0), __builtin_amdgcn_cvt_f32_fp8(w, 1), __builtin_amdgcn_cvt_f32_fp8(w, 2), __builtin_amdgcn_cvt_f32_fp8(w, 3)}; }
}
__device__ __forceinline__ void st_row_bf16(bf16_t* row, int lane, const f32x4 (&v)[4]) {
#pragma unroll
    for (int j = 0; j < 4; ++j) { u32x2 w; w.x = pk2(v[j][0], v[j][1]); w.y = pk2(v[j][2], v[j][3]); *(u32x2*)(row + 256 * j + 4 * lane) = w; }
}
__device__ __forceinline__ void layer_norm_row(f32x4 (&v)[4], const float* g, const float* b, int lane) {
    float s = 0.f;
#pragma unroll
    for (int j = 0; j < 4; ++j) s += (v[j][0] + v[j][1]) + (v[j][2] + v[j][3]);
    const float mu = wave_sum(s) * (1.0f / DM); float q = 0.f;
#pragma unroll
    for (int j = 0; j < 4; ++j) { v[j] = v[j] - mu; q += (v[j][0] * v[j][0] + v[j][1] * v[j][1]) + (v[j][2] * v[j][2] + v[j][3] * v[j][3]); }
    const float rstd = 1.0f / sqrtf(wave_sum(q) * (1.0f / DM) + LN_EPS);
#pragma unroll
    for (int j = 0; j < 4; ++j) { const f32x4 gg = *(const f32x4*)(g + 256 * j + 4 * lane), bb = *(const f32x4*)(b + 256 * j + 4 * lane); v[j] = v[j] * rstd * gg + bb; }
}
__device__ __forceinline__ void modulate0_phase(const Params& p) {
    int t_ = threadIdx.x; asm volatile("" : "+v"(t_)); const int lane = t_ & 63, gw = blockIdx.x * 8 + (t_ >> 6), NGW = gridDim.x * 8;
    for (int r = gw; r < TT; r += 2 * NGW) {
        const int r2 = r + NGW < TT ? r + NGW : r;
        const float* xa = r < TL ? p.x + (size_t)r * DM : p.ctx + (size_t)(r - TL) * DM; const float* ma = p.MOD + (size_t)cond_of_row(r) * 6 * DM;
        const float* xb = r2 < TL ? p.x + (size_t)r2 * DM : p.ctx + (size_t)(r2 - TL) * DM; const float* mb = p.MOD + (size_t)cond_of_row(r2) * 6 * DM;
        f32x4 va[4], vb[4], sha[4], sca[4], shb[4], scb[4]; ld_row_f32(xa, lane, va); ld_row_f32(xb, lane, vb);
#pragma unroll
        for (int j = 0; j < 4; ++j) { sha[j] = *(const f32x4*)(ma + 256 * j + 4 * lane); sca[j] = *(const f32x4*)(ma + DM + 256 * j + 4 * lane); shb[j] = *(const f32x4*)(mb + 256 * j + 4 * lane); scb[j] = *(const f32x4*)(mb + DM + 256 * j + 4 * lane); }
        asm volatile("" ::: "memory");
#pragma unroll
        for (int j = 0; j < 4; ++j) { va[j] = va[j] * (sca[j] + 1.0f) + sha[j]; vb[j] = vb[j] * (scb[j] + 1.0f) + shb[j]; }
        st_row_bf16(p.ACT + (size_t)r * DM, lane, va);
        if (r2 != r) st_row_bf16(p.ACT + (size_t)r2 * DM, lane, vb);
    }
}
__device__ __forceinline__ void ln1_norm(const Params& p, int l, int r, int lane, f32x4 (&v)[4], const f32x4 (&y)[4]) {
    float* xo = r < TL ? p.out + (size_t)r * DM : p.XC + (size_t)(r - TL) * DM;
    const float* m = p.MOD + ((size_t)l * (NB + 1) + cond_of_row(r)) * 6 * DM;
#pragma unroll
    for (int j = 0; j < 4; ++j) { const f32x4 gt = *(const f32x4*)(m + 2 * DM + 256 * j + 4 * lane); v[j] = v[j] * DN_ALPHA + gt * y[j]; }
    layer_norm_row(v, p.ln_g + (size_t)(l * 2) * DM, p.ln_b + (size_t)(l * 2) * DM, lane);
#pragma unroll
    for (int j = 0; j < 4; ++j) *(f32x4*)(xo + 256 * j + 4 * lane) = v[j];
#pragma unroll
    for (int j = 0; j < 4; ++j) { const f32x4 sh = *(const f32x4*)(m + 3 * DM + 256 * j + 4 * lane), sc = *(const f32x4*)(m + 4 * DM + 256 * j + 4 * lane); v[j] = v[j] * (sc + 1.0f) + sh; }
    { unsigned char* a8 = (unsigned char*)p.ACT + (size_t)r * DM;
#pragma unroll
      for (int j = 0; j < 4; ++j) *(unsigned*)(a8 + 256 * j + 4 * lane) = pg8::pk8(v[j][0] * FP8_SF, v[j][1] * FP8_SF, v[j][2] * FP8_SF, v[j][3] * FP8_SF); }
}
struct RowVecs { f32x4 gt[4], lg[4], lb[4], sh[4], sc[4]; };
__device__ __forceinline__ void ln1_norm_reg(const Params& p, int l, int r, int lane, f32x4 (&v)[4], const f32x4 (&y)[4], const RowVecs& rv) {
    float* xo = r < TL ? p.out + (size_t)r * DM : p.XC + (size_t)(r - TL) * DM;
#pragma unroll
    for (int j = 0; j < 4; ++j) v[j] = v[j] * DN_ALPHA + rv.gt[j] * y[j];
    float s = 0.f;
#pragma unroll
    for (int j = 0; j < 4; ++j) s += (v[j][0] + v[j][1]) + (v[j][2] + v[j][3]);
    const float mu = wave_sum(s) * (1.0f / DM); float q = 0.f;
#pragma unroll
    for (int j = 0; j < 4; ++j) { v[j] = v[j] - mu; q += (v[j][0] * v[j][0] + v[j][1] * v[j][1]) + (v[j][2] * v[j][2] + v[j][3] * v[j][3]); }
    const float rstd = 1.0f / sqrtf(wave_sum(q) * (1.0f / DM) + LN_EPS);
#pragma unroll
    for (int j = 0; j < 4; ++j) v[j] = v[j] * rstd * rv.lg[j] + rv.lb[j];
    st_row_bf16((bf16_t*)xo, lane, v);
#pragma unroll
    for (int j = 0; j < 4; ++j) v[j] = v[j] * (rv.sc[j] + 1.0f) + rv.sh[j];
    { unsigned char* a8 = (unsigned char*)p.ACT + (size_t)r * DM;
#pragma unroll
      for (int j = 0; j < 4; ++j) *(unsigned*)(a8 + 256 * j + 4 * lane) = pg8::pk8(v[j][0] * FP8_SF, v[j][1] * FP8_SF, v[j][2] * FP8_SF, v[j][3] * FP8_SF); }
}
__device__ __forceinline__ void route_row(const Params& p, int l, int r, int lane, const float (&lg)[N_GROUPS + N_EXP], FLAS int* lcnt) {
    int gi = 0; float gm = lg[0];
#pragma unroll
    for (int j = 1; j < N_GROUPS; ++j) if (lg[j] > gm) { gm = lg[j]; gi = j; }
    float gs = 0.f;
#pragma unroll
    for (int j = 0; j < N_GROUPS; ++j) gs += expf(lg[j] - gm);
    const float gprob = 1.0f / gs;
    float ev[EPG];
#pragma unroll
    for (int j = 0; j < EPG; ++j) { float e = 0.f;
#pragma unroll
        for (int g2 = 0; g2 < N_GROUPS; ++g2) if (g2 == gi) e = lg[N_GROUPS + g2 * EPG + j];
        ev[j] = e; }
    int i0 = 0; float m0 = ev[0];
#pragma unroll
    for (int j = 1; j < EPG; ++j) if (ev[j] > m0) { m0 = ev[j]; i0 = j; }
    int i1 = -1; float m1 = -3.0e38f;
#pragma unroll
    for (int j = 0; j < EPG; ++j) if (j != i0 && ev[j] > m1) { m1 = ev[j]; i1 = j; }
    const float e1 = expf(m1 - m0), g0 = gprob / (1.0f + e1), g1 = gprob * e1 / (1.0f + e1);
    if (lane == 0) {
        const int ex0 = gi * EPG + i0, ex1 = gi * EPG + i1;
        const int p0 = __hip_atomic_fetch_add(&lcnt[ex0], 1, __ATOMIC_RELAXED, __HIP_MEMORY_SCOPE_WORKGROUP), p1 = __hip_atomic_fetch_add(&lcnt[ex1], 1, __ATOMIC_RELAXED, __HIP_MEMORY_SCOPE_WORKGROUP);
        p.tok_e[2 * r] = ex0; p.tok_e[2 * r + 1] = ex1; p.tok_pos[2 * r] = p0; p.tok_pos[2 * r + 1] = p1; p.tok_gate[2 * r] = g0; p.tok_gate[2 * r + 1] = g1;
    }
}
typedef __attribute__((ext_vector_type(8))) short rt_bf16x8;
typedef __attribute__((ext_vector_type(16))) float rt_f32x16;
__device__ __forceinline__ void ln1_phase(const Params& p, int l, FLAS unsigned char* lds_raw) {
    constexpr int NJ = N_GROUPS + N_EXP, PITCH = DM * 2 + 16;
    constexpr int LDS_AH = 0, LDS_AL = 32 * PITCH, LDS_CP = 0;
    constexpr int CPP = 65;
    static_assert(2 * 32 * PITCH <= 147456 && (8 * 32 * CPP + 32 * (NJ + 1)) * 4 <= 2 * 32 * PITCH, "LN1 LDS map");
    FLAS unsigned char* lds = lds_raw; FLAS int* lcnt = (FLAS int*)(lds_raw + 147456 + 128);
    int tix = threadIdx.x; asm volatile("" : "+v"(tix));
    if (tix < N_EXP) lcnt[tix] = 0;
    const int lane = tix & 63, wave = tix >> 6, r32 = lane & 31, hi = lane >> 5; const int nrows = l == 0 ? TT : TL; const bf16_t* Y = P_of(p);
    const bf16_t* WRH = p.WRH + (size_t)l * 64 * DM; const bf16_t* WRL = p.WRL + (size_t)l * 64 * DM;
    for (int g = blockIdx.x; g < nrows / 32; g += gridDim.x) {
        __syncthreads();
        RowVecs rv;
        { const float* m = p.MOD + ((size_t)l * (NB + 1) + cond_of_row(g * 32)) * 6 * DM; const float* lgp = p.ln_g + (size_t)(l * 2) * DM; const float* lbp = p.ln_b + (size_t)(l * 2) * DM;
#pragma unroll
          for (int j = 0; j < 4; ++j) { const int o = 256 * j + 4 * lane; rv.gt[j] = *(const f32x4*)(m + 2 * DM + o); rv.sh[j] = *(const f32x4*)(m + 3 * DM + o); rv.sc[j] = *(const f32x4*)(m + 4 * DM + o);
              rv.lg[j] = *(const f32x4*)(lgp + o); rv.lb[j] = *(const f32x4*)(lbp + o); } }
#pragma unroll
        for (int i = 0; i < 4; i += 2) {
            const int ra = g * 32 + wave * 4 + i, rb = ra + 1;
            const float* xa = l == 0 ? (ra < TL ? p.x + (size_t)ra * DM : p.ctx + (size_t)(ra - TL) * DM) : p.out + (size_t)ra * DM;
            const float* xb = l == 0 ? (rb < TL ? p.x + (size_t)rb * DM : p.ctx + (size_t)(rb - TL) * DM) : p.out + (size_t)rb * DM;
            f32x4 va[4], ya[4], vb[4], yb[4];
            if (l == 0) { ld_row_f32(xa, lane, va); ld_row_f32(xb, lane, vb); } else { ld_row_bf16((const bf16_t*)xa, lane, va); ld_row_bf16((const bf16_t*)xb, lane, vb); }
            ld_row_bf16(Y + (size_t)ra * DM, lane, ya); ld_row_bf16(Y + (size_t)rb * DM, lane, yb);
            asm volatile("" ::: "memory");
            ln1_norm_reg(p, l, ra, lane, va, ya, rv); ln1_norm_reg(p, l, rb, lane, vb, yb, rv);
#pragma unroll
            for (int q = 0; q < 2; ++q) { const f32x4 (&v)[4] = q ? vb : va; const int rl = wave * 4 + i + q;
#pragma unroll
                for (int j = 0; j < 4; ++j) { const unsigned h0 = pk2(v[j][0], v[j][1]), h1 = pk2(v[j][2], v[j][3]);
                    const unsigned l0 = pk2(v[j][0] - __uint_as_float(h0 << 16), v[j][1] - __uint_as_float(h0 & 0xffff0000u)), l1 = pk2(v[j][2] - __uint_as_float(h1 << 16), v[j][3] - __uint_as_float(h1 & 0xffff0000u));
                    *(FLAS u32x2*)(lds + LDS_AH + rl * PITCH + (256 * j + 4 * lane) * 2) = (u32x2){h0, h1}; *(FLAS u32x2*)(lds + LDS_AL + rl * PITCH + (256 * j + 4 * lane) * 2) = (u32x2){l0, l1}; } }
        }
        rt_bf16x8 BH0[8], BH1[8], BL0[8], BL1[8];
#pragma unroll
        for (int s2 = 0; s2 < 8; ++s2) { const int k0 = wave * 128 + s2 * 16 + 8 * hi;
            BH0[s2] = *(const rt_bf16x8*)(WRH + (size_t)r32 * DM + k0); BH1[s2] = *(const rt_bf16x8*)(WRH + (size_t)(32 + r32) * DM + k0);
            BL0[s2] = *(const rt_bf16x8*)(WRL + (size_t)r32 * DM + k0); BL1[s2] = *(const rt_bf16x8*)(WRL + (size_t)(32 + r32) * DM + k0); }
        asm volatile("" ::: "memory");
        __syncthreads();
        rt_f32x16 C0 = {}, C1 = {};
#pragma unroll
        for (int s2 = 0; s2 < 8; ++s2) { const int k0 = wave * 128 + s2 * 16 + 8 * hi;
            const rt_bf16x8 ah = *(const FLAS rt_bf16x8*)(lds + LDS_AH + r32 * PITCH + k0 * 2), al = *(const FLAS rt_bf16x8*)(lds + LDS_AL + r32 * PITCH + k0 * 2);
            const rt_bf16x8 bh0 = BH0[s2], bh1 = BH1[s2], bl0 = BL0[s2], bl1 = BL1[s2];
            C0 = __builtin_amdgcn_mfma_f32_32x32x16_bf16(ah, bh0, C0, 0, 0, 0); C0 = __builtin_amdgcn_mfma_f32_32x32x16_bf16(al, bh0, C0, 0, 0, 0); C0 = __builtin_amdgcn_mfma_f32_32x32x16_bf16(ah, bl0, C0, 0, 0, 0);
            C1 = __builtin_amdgcn_mfma_f32_32x32x16_bf16(ah, bh1, C1, 0, 0, 0); C1 = __builtin_amdgcn_mfma_f32_32x32x16_bf16(al, bh1, C1, 0, 0, 0); C1 = __builtin_amdgcn_mfma_f32_32x32x16_bf16(ah, bl1, C1, 0, 0, 0); }
        __syncthreads();
        { FLAS float* Cp = (FLAS float*)(lds + LDS_CP) + wave * (32 * CPP);
#pragma unroll
          for (int r = 0; r < 16; ++r) { const int row = (r & 3) + 8 * (r >> 2) + 4 * hi; Cp[row * CPP + r32] = C0[r]; Cp[row * CPP + 32 + r32] = C1[r]; } }
        __syncthreads();
        { FLAS float* LG = (FLAS float*)(lds + LDS_CP) + 8 * 32 * CPP;
          for (int o = tix; o < 32 * NJ; o += 512) { const int row = o / NJ, j = o - row * NJ; const FLAS float* c = (const FLAS float*)(lds + LDS_CP) + row * CPP + j;
              const float bj = j < N_GROUPS ? p.moe_bg[l * N_GROUPS + j] : p.moe_br[l * N_EXP + j - N_GROUPS];
              float t8[8];
#pragma unroll
              for (int w = 0; w < 8; ++w) t8[w] = c[w * (32 * CPP)];
              asm volatile("" ::: "memory");
              LG[row * (NJ + 1) + j] = (((t8[0] + t8[1]) + (t8[2] + t8[3])) + ((t8[4] + t8[5]) + (t8[6] + t8[7]))) + bj; } }
        __syncthreads();
        if (tix < 32) { const FLAS float* LG = (const FLAS float*)(lds + LDS_CP) + 8 * 32 * CPP + tix * (NJ + 1); float lg[NJ];
#pragma unroll
            for (int j = 0; j < NJ; ++j) lg[j] = LG[j];
            asm volatile("" ::: "memory");
            route_row(p, l, g * 32 + tix, 0, lg, lcnt); }
    }
    __syncthreads();
    if (tix < N_EXP) { const int c = lcnt[tix]; lcnt[tix] = c ? atomicAdd(&p.cnt[(l * N_EXP + tix) * CS], c) : 0; }
    __syncthreads();
    for (int g = blockIdx.x + (tix >> 5) * gridDim.x; g < nrows / 32; g += 16 * gridDim.x) { const int r = g * 32 + (tix & 31); const int e0 = p.tok_e[2 * r], e1 = p.tok_e[2 * r + 1]; const int q0 = p.tok_pos[2 * r] + lcnt[e0], q1 = p.tok_pos[2 * r + 1] + lcnt[e1];
        p.tok_pos[2 * r] = q0; p.tok_pos[2 * r + 1] = q1; p.slot_tok[(size_t)e0 * TT + q0] = r; p.slot_tok[(size_t)e1 * TT + q1] = r; }
    __syncthreads();
}
__device__ __forceinline__ void scatter_phase(const Params& p, int l) {
    const int ntok = l == 0 ? TT : TL;
    int t_ = threadIdx.x; asm volatile("" : "+v"(t_)); const int lane = t_ & 63, gw = blockIdx.x * 8 + (t_ >> 6), NGW = gridDim.x * 8; const int* cnt = p.cnt + l * N_EXP * CS;
    bf16_t* XS = (bf16_t*)(p.M + M_XS);
    int ps = lane < N_EXP ? (cnt[lane * CS] + MOE_PAD - 1) / MOE_PAD * MOE_PAD : 0;
#pragma unroll
    for (int o = 1; o < N_EXP; o <<= 1) { const int t = __shfl_up(ps, o); if (lane >= o) ps += t; }
    ps = __shfl_up(ps, 1); if (lane == 0) ps = 0;
    for (int a0 = gw; a0 < 2 * ntok; a0 += 4 * NGW) {
        int aa[4], row[4]; u32x4 v0[4], v1[4];
#pragma unroll
        for (int i = 0; i < 4; ++i) { aa[i] = a0 + i * NGW; const int ac = aa[i] < 2 * ntok ? aa[i] : a0; row[i] = __shfl(ps, p.tok_e[ac]) + p.tok_pos[ac];
            const bf16_t* s = p.ACT + (size_t)(ac >> 1) * DM; v0[i] = *(const u32x4*)(s + 8 * lane); v1[i] = *(const u32x4*)(s + 512 + 8 * lane); }
#pragma unroll
        for (int i = 0; i < 4; ++i) if (aa[i] < 2 * ntok) { if (lane == 0) p.tok_row[aa[i]] = row[i]; bf16_t* d = XS + (size_t)row[i] * DM; *(u32x4*)(d + 8 * lane) = v0[i]; *(u32x4*)(d + 512 + 8 * lane) = v1[i]; }
    }
}
__device__ __forceinline__ void ln2_row_finish(const Params& p, int l, int r, int lane, f32x4 (&v)[4], const f32x4 (&y0)[4], const f32x4 (&y1)[4], float g0, float g1) {
    float* xo = r < TL ? p.out + (size_t)r * DM : p.XC + (size_t)(r - TL) * DM;
    const float* m = p.MOD + ((size_t)l * (NB + 1) + cond_of_row(r)) * 6 * DM;
#pragma unroll
    for (int j = 0; j < 4; ++j) { const f32x4 gt = *(const f32x4*)(m + 5 * DM + 256 * j + 4 * lane); v[j] = v[j] * DN_ALPHA + gt * (y0[j] * g0 + y1[j] * g1); }
    layer_norm_row(v, p.ln_g + (size_t)(l * 2 + 1) * DM, p.ln_b + (size_t)(l * 2 + 1) * DM, lane);
    if (l == 0) st_row_bf16((bf16_t*)xo, lane, v);
    else {
#pragma unroll
        for (int j = 0; j < 4; ++j) *(f32x4*)(xo + 256 * j + 4 * lane) = v[j]; }
    if (l == 0) { const float* m1 = p.MOD + ((size_t)(NB + 1) + cond_of_row(r)) * 6 * DM;
#pragma unroll
        for (int j = 0; j < 4; ++j) { const f32x4 sh = *(const f32x4*)(m1 + 256 * j + 4 * lane), sc = *(const f32x4*)(m1 + DM + 256 * j + 4 * lane); v[j] = v[j] * (sc + 1.0f) + sh; }
        st_row_bf16(p.ACT + (size_t)r * DM, lane, v); }
}
__device__ __forceinline__ void ln2_row_finish2(const Params& p, int l, int r, int lane, f32x4 (&v)[4], const f32x4 (&y0)[4], const f32x4 (&y1)[4], float g0, float g1, const f32x4 (&gt)[4], const f32x4 (&lg)[4], const f32x4 (&lb)[4]) {
    float* xo = r < TL ? p.out + (size_t)r * DM : p.XC + (size_t)(r - TL) * DM;
    f32x4 sh[4], sc[4];
    if (l == 0) { const float* m1 = p.MOD + ((size_t)(NB + 1) + cond_of_row(r)) * 6 * DM;
#pragma unroll
        for (int j = 0; j < 4; ++j) { sh[j] = *(const f32x4*)(m1 + 256 * j + 4 * lane); sc[j] = *(const f32x4*)(m1 + DM + 256 * j + 4 * lane); }
        asm volatile("" ::: "memory"); }
#pragma unroll
    for (int j = 0; j < 4; ++j) v[j] = v[j] * DN_ALPHA + gt[j] * (y0[j] * g0 + y1[j] * g1);
    { float s = 0.f;
#pragma unroll
      for (int j = 0; j < 4; ++j) s += (v[j][0] + v[j][1]) + (v[j][2] + v[j][3]);
      const float mu = wave_sum(s) * (1.0f / DM); float q = 0.f;
#pragma unroll
      for (int j = 0; j < 4; ++j) { v[j] = v[j] - mu; q += (v[j][0] * v[j][0] + v[j][1] * v[j][1]) + (v[j][2] * v[j][2] + v[j][3] * v[j][3]); }
      const float rstd = 1.0f / sqrtf(wave_sum(q) * (1.0f / DM) + LN_EPS);
#pragma unroll
      for (int j = 0; j < 4; ++j) v[j] = v[j] * rstd * lg[j] + lb[j]; }
    if (l == 0) st_row_bf16((bf16_t*)xo, lane, v);
    else {
#pragma unroll
        for (int j = 0; j < 4; ++j) __builtin_nontemporal_store(v[j], (f32x4*)(xo + 256 * j + 4 * lane)); }
    if (l == 0) {
#pragma unroll
        for (int j = 0; j < 4; ++j) v[j] = v[j] * (sc[j] + 1.0f) + sh[j];
        st_row_bf16(p.ACT + (size_t)r * DM, lane, v); }
}
__device__ __forceinline__ void ln2_phase(const Params& p, int l) {
    int t_ = threadIdx.x; asm volatile("" : "+v"(t_)); const int lane = t_ & 63, gw = blockIdx.x * 8 + (t_ >> 6), NGW = gridDim.x * 8; const int nrows = l == 0 ? TT : TL;
    const unsigned char* YS = (const unsigned char*)(p.M + M_XS);
    const int* cnt = p.cnt + l * N_EXP * CS; int ps = lane < N_EXP ? (cnt[lane * CS] + MOE_PAD - 1) / MOE_PAD * MOE_PAD : 0;
#pragma unroll
    for (int o = 1; o < N_EXP; o <<= 1) { const int t = __shfl_up(ps, o); if (lane >= o) ps += t; }
    ps = __shfl_up(ps, 1); if (lane == 0) ps = 0;
    int e_[4], q_[4]; float g_[4];
#define LN2_IDX(R) do { const int ra_ = (R) < nrows ? (R) : gw, rb_ = ra_ + NGW < nrows ? ra_ + NGW : ra_; \
        e_[0] = p.tok_e[2 * ra_]; e_[1] = p.tok_e[2 * ra_ + 1]; e_[2] = p.tok_e[2 * rb_]; e_[3] = p.tok_e[2 * rb_ + 1]; \
        q_[0] = p.tok_pos[2 * ra_]; q_[1] = p.tok_pos[2 * ra_ + 1]; q_[2] = p.tok_pos[2 * rb_]; q_[3] = p.tok_pos[2 * rb_ + 1]; \
        g_[0] = p.tok_gate[2 * ra_]; g_[1] = p.tok_gate[2 * ra_ + 1]; g_[2] = p.tok_gate[2 * rb_]; g_[3] = p.tok_gate[2 * rb_ + 1]; } while (0)
    if (gw < nrows) LN2_IDX(gw);
    f32x4 lg_[4], lb_[4];
#pragma unroll
    for (int j = 0; j < 4; ++j) { lg_[j] = *(const f32x4*)(p.ln_g + (size_t)(l * 2 + 1) * DM + 256 * j + 4 * lane); lb_[j] = *(const f32x4*)(p.ln_b + (size_t)(l * 2 + 1) * DM + 256 * j + 4 * lane); }
    for (int r = gw; r < nrows; r += 2 * NGW) {
        const int r2 = r + NGW < nrows ? r + NGW : r;
        const float* xa = r < TL ? p.out + (size_t)r * DM : p.XC + (size_t)(r - TL) * DM; const float* xb = r2 < TL ? p.out + (size_t)r2 * DM : p.XC + (size_t)(r2 - TL) * DM;
        const int ra0 = __shfl(ps, e_[0]) + q_[0], ra1 = __shfl(ps, e_[1]) + q_[1], rb0 = __shfl(ps, e_[2]) + q_[2], rb1 = __shfl(ps, e_[3]) + q_[3];
        const float ga0 = g_[0] * (1.0f / FP8_SY), ga1 = g_[1] * (1.0f / FP8_SY), gb0 = g_[2] * (1.0f / FP8_SY), gb1 = g_[3] * (1.0f / FP8_SY);
        f32x4 va[4], ya0[4], ya1[4], vb[4], yb0[4], yb1[4];
        ld_row_bf16((const bf16_t*)xa, lane, va); ld_row_bf16((const bf16_t*)xb, lane, vb);
        ld_row_fp8(YS + (size_t)ra0 * DM, lane, ya0); ld_row_fp8(YS + (size_t)ra1 * DM, lane, ya1); ld_row_fp8(YS + (size_t)rb0 * DM, lane, yb0); ld_row_fp8(YS + (size_t)rb1 * DM, lane, yb1);
        f32x4 gta[4], gtb[4]; { const float* ma = p.MOD + ((size_t)l * (NB + 1) + cond_of_row(r)) * 6 * DM + 5 * DM; const float* mb = p.MOD + ((size_t)l * (NB + 1) + cond_of_row(r2)) * 6 * DM + 5 * DM;
#pragma unroll
            for (int j = 0; j < 4; ++j) { gta[j] = *(const f32x4*)(ma + 256 * j + 4 * lane); gtb[j] = *(const f32x4*)(mb + 256 * j + 4 * lane); } }
        LN2_IDX(r + 2 * NGW);
        asm volatile("" ::: "memory");
        ln2_row_finish2(p, l, r, lane, va, ya0, ya1, ga0, ga1, gta, lg_, lb_);
        if (r2 != r) ln2_row_finish2(p, l, r2, lane, vb, yb0, yb1, gb0, gb1, gtb, lg_, lb_);
    }
#undef LN2_IDX
}
}
#endif


#ifndef CPU_SIM
#define LAS __attribute__((address_space(3)))
#define XB_TMO      128
#define XB_XCNT(j)  (256  + 64 * (j))
#define XB_XSUB(j)  (1280 + 64 * (j))
#define XB_XGEN(j)  (2304 + 64 * (j))
#define XB_TOP      3328
#define XB_TOPGEN   3392
#define XCD_BAR_WORDS 3456
#define XB_SPIN_CAP (1u << 26)

__device__ __forceinline__ unsigned xb_ld(unsigned* p)              { return __hip_atomic_load(p, __ATOMIC_RELAXED, __HIP_MEMORY_SCOPE_AGENT); }
__device__ __forceinline__ unsigned xb_add(unsigned* p, unsigned v) { return __hip_atomic_fetch_add(p, v, __ATOMIC_RELAXED, __HIP_MEMORY_SCOPE_AGENT); }
__device__ __forceinline__ unsigned xb_xcc_id() { return (unsigned)__builtin_amdgcn_s_getreg((3 << 11) | 20) & 0xFu; }
#define XB_SPIN(cond, bar) do { unsigned _sp = 0; while (cond) { __builtin_amdgcn_s_sleep(1); \
    if ((++_sp & 255u) == 0u) { if (xb_ld(&(bar)[XB_TMO])) break; if (_sp > XB_SPIN_CAP) { atomicAdd(&(bar)[XB_TMO], 1u); break; } } } } while (0)

struct XcdBarrier {
    unsigned* bar; unsigned x;
    volatile LAS unsigned* st;
};

__device__ __forceinline__ XcdBarrier xcd_barrier_post(unsigned* bar, volatile LAS unsigned* st) {
    XcdBarrier b; b.bar = bar; b.x = xb_xcc_id(); b.st = st;
    if (threadIdx.x == 0) (void)xb_add(&bar[XB_XCNT(b.x)], 1u);
    return b;
}
__device__ __forceinline__ void xcd_barrier_complete(unsigned* bar, unsigned x, unsigned& nloc, unsigned& nx) {
    const unsigned G = gridDim.x * gridDim.y * gridDim.z;
    unsigned sum, cnt, mine, sp = 0u;
    for (;;) {
        sum = 0u; cnt = 0u; mine = 0u;
#pragma unroll
        for (unsigned j = 0; j < 16; ++j) { const unsigned c = xb_ld(&bar[XB_XCNT(j)]); sum += c; cnt += (c > 0u) ? 1u : 0u; mine = (j == x) ? c : mine; }
        if (sum == G) break;
        __builtin_amdgcn_s_sleep(1);
        if ((++sp & 255u) == 0u) { if (xb_ld(&bar[XB_TMO])) break; if (sp > XB_SPIN_CAP) { atomicAdd(&bar[XB_TMO], 1u); break; } }
    }
    nloc = mine > 0u ? mine : 1u; nx = cnt > 0u ? cnt : 1u;
}

__device__ __forceinline__ void xcd_barrier(const XcdBarrier& b) {
    asm volatile("s_waitcnt vmcnt(0)" ::: "memory");
    __syncthreads();
    if (threadIdx.x == 0) {
        unsigned* bar = b.bar;
        __builtin_amdgcn_s_waitcnt(0);
        unsigned nloc = b.st[0], nx = b.st[1];
        if (nloc == 0u) { xcd_barrier_complete(bar, b.x, nloc, nx); b.st[0] = nloc; b.st[1] = nx; }
        const unsigned old = xb_add(&bar[XB_XSUB(b.x)], 1u);
        const unsigned gen = old / nloc;
        if (old + 1u == (gen + 1u) * nloc) {
            __builtin_amdgcn_fence(__ATOMIC_RELEASE, "agent");
            asm volatile("s_waitcnt vmcnt(0)" ::: "memory");
            const unsigned og = xb_add(&bar[XB_TOP], 1u);
            const unsigned tg = og / nx;
            if (og + 1u == (tg + 1u) * nx) xb_add(&bar[XB_TOPGEN], 1u);
            else XB_SPIN(xb_ld(&bar[XB_TOPGEN]) == tg, bar);
            __builtin_amdgcn_fence(__ATOMIC_ACQUIRE, "agent");
            xb_add(&bar[XB_XGEN(b.x)], 1u);
            asm volatile("s_waitcnt vmcnt(0)" ::: "memory");
        } else {
            XB_SPIN(xb_ld(&bar[XB_XGEN(b.x)]) == gen, bar);
            __builtin_amdgcn_fence(__ATOMIC_ACQUIRE, "agent");
            asm volatile("s_waitcnt vmcnt(0)" ::: "memory");
        }
    }
    __syncthreads();
}
#endif


#ifndef CPU_SIM
namespace lru {
using bf16x8 = __attribute__((ext_vector_type(8))) short;
using f32x16 = __attribute__((ext_vector_type(16))) float;
typedef float f32x4 __attribute__((ext_vector_type(4)));
typedef unsigned u32x4 __attribute__((ext_vector_type(4)));
__device__ __forceinline__ float gelu_fast(float v) { const float z = 1.5957691216057308f * (v + 0.044715f * v * v * v); return v * __builtin_amdgcn_rcpf(1.0f + __expf(-z)); }
template <int PASS> __device__ __forceinline__ void lru_phase(const Params& p, FLAS unsigned char* lds_raw) {
    static_assert(LRU_BD == 64 && LRU_NBLK == 8 && LRU_CH == 32, "one wave per 64-channel block, 32-token chunks");
    const int tid = threadIdx.x, wave = tid >> 6, lane = tid & 63, r32 = lane & 31, hi = lane >> 5;
    FLAS unsigned* Wl = (FLAS unsigned*)lds_raw + wave * (LRU_CH * 64);
    const bf16_t* P = P_of(p); const int c = wave * 64 + lane;
    const float cw0 = p.e_conv_w[c], cw1 = p.e_conv_w[LRU_W + c], cw2 = p.e_conv_w[2 * LRU_W + c], cw3 = p.e_conv_w[3 * LRU_W + c], cb = p.e_conv_b[c];
    float* SUM = (float*)(p.M + M_SUM); const float* HIN = (const float*)(p.M + M_HIN); unsigned* GW = (unsigned*)(p.M + M_GW);
    FLAS float* ws_scr = (FLAS float*)(lds_raw + 8 * LRU_CH * 64 * 4) + wave * (64 * 33); const int ws_gw = __builtin_amdgcn_readfirstlane((int)blockIdx.x * 8 + wave), ws_ngw = (int)gridDim.x * 8; int ws_slice = 0;
    static_assert(8 * LRU_CH * 64 * 4 + 8 * 64 * 33 * 4 <= 147456, "LRU images + weight-stream scratch fit LDS");
    for (int u = blockIdx.x; u < NB * LRU_NV; u += gridDim.x) {
        int b, row0, lo, hi_, v0, v1; lru_chunk_geom(u, b, row0, lo, hi_, v0, v1);
        bf16x8 af[4];
#pragma unroll
        for (int s = 0; s < 4; ++s) {
            const int ch0 = wave * 64 + 16 * s + 8 * hi; f32x4 a0 = *(const f32x4*)(p.e_conv_b + ch0), a1 = *(const f32x4*)(p.e_conv_b + ch0 + 4);
            u32x4 wr_[4]; f32x4 w0_[4], w1_[4];
#pragma unroll
            for (int tau = 0; tau < 4; ++tau) { const int rr = row0 + r32 + tau - 1; const int rc = rr < lo ? lo : (rr >= hi_ ? hi_ - 1 : rr);
                wr_[tau] = *(const u32x4*)(P + (size_t)rc * EPLD + EC_U + ch0); w0_[tau] = *(const f32x4*)(p.e_conv_w + tau * LRU_W + ch0); w1_[tau] = *(const f32x4*)(p.e_conv_w + tau * LRU_W + ch0 + 4); }
            asm volatile("" ::: "memory");
#pragma unroll
            for (int tau = 0; tau < 4; ++tau) { const int rr = row0 + r32 + tau - 1; const bool ok = rr >= lo && rr < hi_;
                u32x4 w = wr_[tau]; if (!ok) w = (u32x4){0u, 0u, 0u, 0u};
                const f32x4 w0 = w0_[tau], w1 = w1_[tau];
                a0 += w0 * (f32x4){__uint_as_float(w.x << 16), __uint_as_float(w.x & 0xffff0000u), __uint_as_float(w.y << 16), __uint_as_float(w.y & 0xffff0000u)};
                a1 += w1 * (f32x4){__uint_as_float(w.z << 16), __uint_as_float(w.z & 0xffff0000u), __uint_as_float(w.w << 16), __uint_as_float(w.w & 0xffff0000u)}; }
            u32x4 o; o.x = fast::pk2(a0[0], a0[1]); o.y = fast::pk2(a0[2], a0[3]); o.z = fast::pk2(a1[0], a1[1]); o.w = fast::pk2(a1[2], a1[3]); af[s] = *reinterpret_cast<bf16x8*>(&o);
        }
        float ucv[LRU_CH];
        { bf16_t ur_[LRU_CH + 3];
#pragma unroll
          for (int t = 0; t < LRU_CH + 3; ++t) { const int rr = row0 + t - 1; ur_[t] = P[(size_t)(rr < lo ? lo : (rr >= hi_ ? hi_ - 1 : rr)) * EPLD + EC_U + c]; }
          asm volatile("" ::: "memory");
          float um1 = row0 - 1 < lo ? 0.f : bf2f(ur_[0]), u0 = bf2f(ur_[1]), u1 = bf2f(ur_[2]);
#pragma unroll
          for (int t = 0; t < LRU_CH; ++t) { const int rr = row0 + t + 2; float u2 = rr >= hi_ ? 0.f : bf2f(ur_[t + 3]);
              ucv[t] = cb + cw0 * um1 + cw1 * u0 + cw2 * u1 + cw3 * u2; um1 = u0; u0 = u1; u1 = u2; } }
        float hf[LRU_CH];
#pragma unroll
        for (int d = 0; d < 2; ++d) {
            f32x16 C[4]; bf16x8 bw_[4][4];
#pragma unroll
            for (int nt = 0; nt < 4; ++nt)
#pragma unroll
                for (int s = 0; s < 4; ++s) bw_[nt][s] = *reinterpret_cast<const bf16x8*>(p.LRUW + ((((size_t)(d * LRU_NBLK + wave) * 2 + (nt >> 1)) * 64 + (nt & 1) * 32 + r32) * 64 + 16 * s + 8 * hi));
            asm volatile("" ::: "memory");
#pragma unroll
            for (int nt = 0; nt < 4; ++nt) { C[nt] = f32x16{};
#pragma unroll
                for (int s = 0; s < 4; ++s) C[nt] = __builtin_amdgcn_mfma_f32_32x32x16_bf16(af[s], bw_[nt][s], C[nt], 0, 0, 0); }
#pragma unroll
            for (int j = 0; j < 2; ++j) { const float* cc = p.LRUC + (size_t)(d * LRU_W + wave * 64 + 32 * j + r32) * 3; const float ba = cc[0], bxv = cc[1], sp = cc[2];
                const float nba = -ba * LOG2E, nbx = -bxv * LOG2E, ksp = -LRU_C * sp, kspl = ksp * LOG2E;
#pragma unroll
                for (int r = 0; r < 16; ++r) { const int tok = (r & 3) + 8 * (r >> 2) + 4 * hi;
                    const float rg = __builtin_amdgcn_rcpf(1.0f + __builtin_amdgcn_exp2f(__builtin_fmaf(C[j][r], -LOG2E, nba))), ig = __builtin_amdgcn_rcpf(1.0f + __builtin_amdgcn_exp2f(__builtin_fmaf(C[2 + j][r], -LOG2E, nbx)));
                    const float la = ksp * rg, a = __builtin_amdgcn_exp2f(kspl * rg), bq = __builtin_amdgcn_sqrtf(fmaxf(1.0f - a * a, 0.f)) * ig;
                    Wl[tok * 64 + 32 * j + r32] = fast::pk2(la, bq); } }
            const int v = d ? v1 : v0; const size_t sidx = (((size_t)b * 2 + d) * LRU_NV + v) * LRU_W + c;
            float h = PASS == 2 ? HIN[sidx] : 0.f, lsum = 0.f;
            unsigned wq_[LRU_CH];
#pragma unroll
            for (int t = 0; t < LRU_CH; ++t) wq_[t] = Wl[t * 64 + lane];
            asm volatile("" ::: "memory");
#pragma unroll
            for (int tt = 0; tt < LRU_CH; ++tt) { const int t = d ? LRU_CH - 1 - tt : tt; const unsigned w = wq_[t];
                const float la = __uint_as_float(w << 16), bq = __uint_as_float(w & 0xffff0000u);
                h = __expf(la) * h + bq * ucv[t]; lsum += la;
                if (PASS == 1) GW[((size_t)d * TT + row0 + t) * LRU_W + c] = w;
                if (PASS == 2) { if (d == 0) hf[t] = h; else p.ACT[(size_t)(row0 + t) * DM + c] = f2bf((hf[t] + h) * gelu_fast(bf2f(P[(size_t)(row0 + t) * EPLD + EC_G + c]))); } }
            if (PASS == 1) { SUM[2 * sidx] = __expf(lsum); SUM[2 * sidx + 1] = h; }
        }
        (void)ws_scr; (void)ws_gw; (void)ws_ngw; (void)ws_slice;
    }
    if (PASS == 1) { const int f_ = (NB * LRU_NV) % (int)gridDim.x; fast::weights_phase(p, lds_raw + 8 * LRU_CH * 64 * 4, 0, f_, fast::WS_SMALL0, 1 << 30); }
    if (PASS == 1) fast::moe_stream_extra(p, lds_raw + 8 * LRU_CH * 64 * 4, fast::WS_B, fast::WS_NMH, (NB * LRU_NV) % (int)gridDim.x);
}


__device__ __forceinline__ void lru_pass2_light(const Params& p) {
    const int tid = threadIdx.x, wave = tid >> 6, lane = tid & 63; const int c = wave * 64 + lane;
    const float cw0 = p.e_conv_w[c], cw1 = p.e_conv_w[LRU_W + c], cw2 = p.e_conv_w[2 * LRU_W + c], cw3 = p.e_conv_w[3 * LRU_W + c], cb = p.e_conv_b[c];
    const float* HIN = (const float*)(p.M + M_HIN);
    const unsigned oc4 = (unsigned)c * 4u, oc2 = (unsigned)c * 2u;
    for (int u = blockIdx.x; u < NB * LRU_NV; u += gridDim.x) {
        int b, row0, lo, hi_, v0, v1; lru_chunk_geom(u, b, row0, lo, hi_, v0, v1);
        const unsigned char* gw0 = p.M + M_GW + (size_t)row0 * LRU_W * 4; const unsigned char* gw1 = gw0 + (size_t)TT * LRU_W * 4;
        const unsigned char* pg = p.M + M_P + ((size_t)row0 * EPLD + EC_G) * 2; const unsigned char* pu = p.M + M_P + ((size_t)row0 * EPLD + EC_U) * 2;
        unsigned w0[LRU_CH], w1[LRU_CH]; bf16_t gv[LRU_CH], uu[LRU_CH + 3];
#pragma unroll
        for (int t = 0; t < LRU_CH; ++t) { w0[t] = *(const unsigned*)(gw0 + (size_t)t * LRU_W * 4 + oc4); w1[t] = *(const unsigned*)(gw1 + (size_t)t * LRU_W * 4 + oc4); gv[t] = *(const bf16_t*)(pg + (size_t)t * EPLD * 2 + oc2); }
#pragma unroll
        for (int t = -1; t < LRU_CH + 2; ++t) { const int rr = row0 + t; const int tc = rr < lo ? lo - row0 : (rr >= hi_ ? hi_ - 1 - row0 : t); uu[t + 1] = *(const bf16_t*)(pu + (long)tc * EPLD * 2 + oc2); }
        float hf = HIN[(((size_t)b * 2 + 0) * LRU_NV + v0) * LRU_W + c], hb = HIN[(((size_t)b * 2 + 1) * LRU_NV + v1) * LRU_W + c];
        float ucv[LRU_CH];
#pragma unroll
        for (int t = 0; t < LRU_CH; ++t) { const float um1 = (row0 + t - 1 >= lo) ? bf2f(uu[t]) : 0.f, u0 = bf2f(uu[t + 1]), u1 = (row0 + t + 1 < hi_) ? bf2f(uu[t + 2]) : 0.f, u2 = (row0 + t + 2 < hi_) ? bf2f(uu[t + 3]) : 0.f;
            ucv[t] = cb + cw0 * um1 + cw1 * u0 + cw2 * u1 + cw3 * u2; }
        float hfv[LRU_CH];
#pragma unroll
        for (int t = 0; t < LRU_CH; ++t) { hf = __expf(__uint_as_float(w0[t] << 16)) * hf + __uint_as_float(w0[t] & 0xffff0000u) * ucv[t]; hfv[t] = hf; }
        bf16_t* orow = p.ACT + (size_t)row0 * DM + c;
#pragma unroll
        for (int tt = 0; tt < LRU_CH; ++tt) { const int t = LRU_CH - 1 - tt; hb = __expf(__uint_as_float(w1[t] << 16)) * hb + __uint_as_float(w1[t] & 0xffff0000u) * ucv[t];
            orow[(size_t)t * DM] = fast::f2bf_hw((hfv[t] + hb) * gelu_fast(bf2f(gv[t]))); }
    }
}
__device__ __forceinline__ void lru_carry_phase(const Params& p, FLAS unsigned char* lds_raw) {
    typedef float f32x2 __attribute__((ext_vector_type(2)));
    FLAS f32x2* S = (FLAS f32x2*)lds_raw;
    const f32x2* SUM = (const f32x2*)(p.M + M_SUM); float* HIN = (float*)(p.M + M_HIN); const int tid = threadIdx.x;
    static_assert(LRU_NV * 64 * 8 <= 147456, "carry image fits LDS");
    for (int u = blockIdx.x; u < NB * 2 * (LRU_W / 64); u += gridDim.x) {
        const int bd = u / (LRU_W / 64), c0 = (u % (LRU_W / 64)) * 64;
        static_assert(LRU_NV % 8 == 0 && (LRU_NV * 64) % (512 * 11) == 0, "carry batching");
        __syncthreads();
#pragma unroll 11
        for (int i = tid; i < LRU_NV * 64; i += 512) S[i] = SUM[((size_t)bd * LRU_NV + (i >> 6)) * LRU_W + c0 + (i & 63)];
        __syncthreads();
        if (tid < 64) { float h = 0.f;
            for (int v0 = 0; v0 < LRU_NV; v0 += 8) { f32x2 ab[8];
#pragma unroll
                for (int i = 0; i < 8; ++i) ab[i] = S[(v0 + i) * 64 + tid];
                asm volatile("" ::: "memory");
#pragma unroll
                for (int i = 0; i < 8; ++i) { S[(v0 + i) * 64 + tid].x = h; h = ab[i].x * h + ab[i].y; } } }
        __syncthreads();
#pragma unroll 11
        for (int i = tid; i < LRU_NV * 64; i += 512) HIN[((size_t)bd * LRU_NV + (i >> 6)) * LRU_W + c0 + (i & 63)] = S[i].x;
    }
    __syncthreads();
}
}
#endif


#ifndef CPU_SIM
namespace conf {
typedef float f32x4 __attribute__((ext_vector_type(4)));
typedef unsigned u32x4 __attribute__((ext_vector_type(4)));
constexpr int TCH = 64, HALO = (CONF_K - 1) / 2, NROW = TCH + CONF_K - 1;
constexpr int LDS_G = 0, LDS_W = NROW * CONF_CH * 2, LDS_END = LDS_W + CONF_K * CONF_CH * 2;
__device__ __forceinline__ void up8(const u32x4 w, f32x4& lo, f32x4& hi) {
    lo = (f32x4){__uint_as_float(w.x << 16), __uint_as_float(w.x & 0xffff0000u), __uint_as_float(w.y << 16), __uint_as_float(w.y & 0xffff0000u)};
    hi = (f32x4){__uint_as_float(w.z << 16), __uint_as_float(w.z & 0xffff0000u), __uint_as_float(w.w << 16), __uint_as_float(w.w & 0xffff0000u)}; }
__device__ __forceinline__ void conf_phase(const Params& p, FLAS unsigned char* lds_raw) {
    static_assert(CONF_CH == 512 && LDS_END <= 147456, "lane = 8 channels");
    const int tid = threadIdx.x, wave = tid >> 6, lane = tid & 63;
    FLAS unsigned char* lds = (FLAS unsigned char*)lds_raw; const bf16_t* P = P_of(p);
    if ((int)blockIdx.x >= NB * (SEQ / TCH)) return;
    for (int i = tid; i < CONF_K * CONF_CH / 4; i += 512) { const f32x4 w = *(const f32x4*)(p.o_dw_w + 4 * i); *(FLAS unsigned long long*)(lds + LDS_W + 8 * i) = (unsigned long long)fast::pk2(w[0], w[1]) | ((unsigned long long)fast::pk2(w[2], w[3]) << 32); }
    const f32x4 cb0 = *(const f32x4*)(p.o_dw_b + 8 * lane), cb1 = *(const f32x4*)(p.o_dw_b + 8 * lane + 4);
    for (int u = blockIdx.x; u < NB * (SEQ / TCH); u += gridDim.x) {
        const int b = u / (SEQ / TCH), t0 = (u % (SEQ / TCH)) * TCH;
        __syncthreads();
        for (int i0 = tid; i0 < NROW * (CONF_CH / 8); i0 += 4 * 512) {
            u32x4 av_[4], gv_[4];
#pragma unroll
            for (int q = 0; q < 4; ++q) { const int i = i0 + 512 * q < NROW * (CONF_CH / 8) ? i0 + 512 * q : i0; const int rr = i / (CONF_CH / 8), ch = (i % (CONF_CH / 8)) * 8, t = t0 - HALO + rr; const int tc = t < 0 ? 0 : (t >= SEQ ? SEQ - 1 : t);
                const bf16_t* row = P + (size_t)(b * SEQ + tc) * OPLD; av_[q] = *(const u32x4*)(row + OC_A + ch); gv_[q] = *(const u32x4*)(row + OC_G + ch); }
            asm volatile("" ::: "memory");
#pragma unroll
            for (int q = 0; q < 4; ++q) { const int i = i0 + 512 * q; if (i < NROW * (CONF_CH / 8)) {
                const int rr = i / (CONF_CH / 8), ch = (i % (CONF_CH / 8)) * 8, t = t0 - HALO + rr; const bool ok = t >= 0 && t < SEQ;
                f32x4 a0, a1, g0, g1; up8(av_[q], a0, a1); up8(gv_[q], g0, g1);
#pragma unroll
                for (int j = 0; j < 4; ++j) { a0[j] = a0[j] * __builtin_amdgcn_rcpf(1.0f + __expf(-g0[j])); a1[j] = a1[j] * __builtin_amdgcn_rcpf(1.0f + __expf(-g1[j])); }
                u32x4 o; o.x = fast::pk2(a0[0], a0[1]); o.y = fast::pk2(a0[2], a0[3]); o.z = fast::pk2(a1[0], a1[1]); o.w = fast::pk2(a1[2], a1[3]); if (!ok) o = (u32x4){0u, 0u, 0u, 0u};
                *(FLAS u32x4*)(lds + LDS_G + (size_t)(rr * CONF_CH + ch) * 2) = o; } }
        }
        __syncthreads();
        static_assert(TCH / 8 == 8, "eight tokens per wave");
        f32x4 a0_[8], a1_[8]; const int tb = wave * (TCH / 8);
#pragma unroll
        for (int tk = 0; tk < 8; ++tk) { a0_[tk] = cb0; a1_[tk] = cb1; }
        f32x4 gw0_[8], gw1_[8];
#pragma unroll
        for (int q = 0; q < 8; ++q) up8(*(const FLAS u32x4*)(lds + LDS_G + (size_t)((tb + q) * CONF_CH + 8 * lane) * 2), gw0_[q], gw1_[q]);
#pragma unroll
        for (int j = 0; j < CONF_K; ++j) { f32x4 w0, w1; up8(*(const FLAS u32x4*)(lds + LDS_W + (size_t)(j * CONF_CH + 8 * lane) * 2), w0, w1);
#pragma unroll
            for (int tk = 0; tk < 8; ++tk) { a0_[tk] += gw0_[(tk + j) & 7] * w0; a1_[tk] += gw1_[(tk + j) & 7] * w1; }
            if (j + 1 < CONF_K) up8(*(const FLAS u32x4*)(lds + LDS_G + (size_t)((tb + j + 8) * CONF_CH + 8 * lane) * 2), gw0_[j & 7], gw1_[j & 7]); }
        const f32x4 lg0 = *(const f32x4*)(p.o_cln_g + 8 * lane), lg1 = *(const f32x4*)(p.o_cln_g + 8 * lane + 4), lb0 = *(const f32x4*)(p.o_cln_b + 8 * lane), lb1 = *(const f32x4*)(p.o_cln_b + 8 * lane + 4);
#pragma unroll
        for (int tk = 0; tk < 8; ++tk) {
            const int tl = tb + tk; f32x4 s0 = a0_[tk], s1 = a1_[tk];
            float sm = (s0[0] + s0[1]) + (s0[2] + s0[3]) + (s1[0] + s1[1]) + (s1[2] + s1[3]);
            const float mu = fast::wave_sum(sm) * (1.0f / CONF_CH); s0 = s0 - mu; s1 = s1 - mu;
            float q = (s0[0] * s0[0] + s0[1] * s0[1]) + (s0[2] * s0[2] + s0[3] * s0[3]) + (s1[0] * s1[0] + s1[1] * s1[1]) + (s1[2] * s1[2] + s1[3] * s1[3]);
            const float rstd = 1.0f / sqrtf(fast::wave_sum(q) * (1.0f / CONF_CH) + LN_EPS);
            s0 = s0 * rstd * lg0 + lb0; s1 = s1 * rstd * lg1 + lb1;
#pragma unroll
            for (int j = 0; j < 4; ++j) { s0[j] = s0[j] * __builtin_amdgcn_rcpf(1.0f + __expf(-s0[j])); s1[j] = s1[j] * __builtin_amdgcn_rcpf(1.0f + __expf(-s1[j])); }
            u32x4 o; o.x = fast::pk2(s0[0], s0[1]); o.y = fast::pk2(s0[2], s0[3]); o.z = fast::pk2(s1[0], s1[1]); o.w = fast::pk2(s1[2], s1[3]);
            *(u32x4*)(p.ACT + (size_t)(b * SEQ + t0 + tl) * DM + MLA_H * MLA_V + 8 * lane) = o;
        }
    }
    __syncthreads();
}
}
#endif

enum Phase { PH_PROLOGUE = 0, PH_L0_MODULATE, PH_L0_INPROJ, PH_L0_ROPE, PH_L0_CARRY, PH_L0_MIX, PH_L0_OUTPROJ, PH_L0_LN1, PH_L0_SCATTER, PH_L0_MOE1, PH_L0_MOE2, PH_L0_LN2,
             PH_L1_INPROJ, PH_L1_POST, PH_L1_UP, PH_L1_ATTN, PH_L1_OUTPROJ, PH_L1_LN1, PH_L1_SCATTER, PH_L1_MOE1, PH_L1_MOE2, PH_L1_LN2, N_PHASES };
DEV void run_phase(const Params& p, int ph, long gtid, long gsize) {
    switch (ph) {
    case PH_PROLOGUE: ph_mod(p, gtid, gsize); ph_weights_naive(p, gtid, gsize); break;
    case PH_L0_MODULATE: ph_modulate0(p, gtid, gsize); break;
    case PH_L0_INPROJ: gemm_naive(p.ACT, DM, p.W_ein, DM, TT, EVEN_IN, EpiInE_naive{&p}, gtid, gsize); break;
    case PH_L0_ROPE: ph_rope_swa(p, gtid, gsize); ph_lru_naive<1>(p, gtid, gsize); break;
    case PH_L0_CARRY: ph_lru_carry(p, gtid, gsize); break;
    case PH_L0_MIX: ph_lru_naive<2>(p, gtid, gsize); ph_swa(p, gtid, gsize); ph_ctxattn(p, gtid, gsize); break;
    case PH_L0_OUTPROJ: gemm_naive(p.ACT, DM, p.W_eout, DM, TT, DM, EpiOut_naive{P_of(p), p.e_b_out}, gtid, gsize); break;
    case PH_L0_LN1: ph_ln1(p, 0, gtid, gsize); break;
    case PH_L0_SCATTER: ph_scatter(p, 0, gtid, gsize); break;
    case PH_L0_MOE1: ph_moe1_naive(p, 0, gtid, gsize); break;
    case PH_L0_MOE2: ph_moe2_naive(p, 0, gtid, gsize); break;
    case PH_L0_LN2: ph_ln2(p, 0, gtid, gsize); break;
    case PH_L1_INPROJ: gemm_naive(p.ACT, DM, p.W_oin, DM, TT, OPLD, EpiInO_naive{&p}, gtid, gsize); break;
    case PH_L1_POST: ph_l1_post_inproj(p, gtid, gsize); ph_conf_conv(p, gtid, gsize); break;
    case PH_L1_UP: ph_uq_naive(p, gtid, gsize);
                   gemm_naive(P_of(p) + OC_CKV, OPLD, p.W_ukv, MLA_KVR, TT, MLA_H * (MLA_NOPE + MLA_V), EpiUkv_naive{&p}, gtid, gsize);
                   ph_conf_ln(p, gtid, gsize); break;
    case PH_L1_ATTN: ph_mla_attn(p, gtid, gsize); break;
    case PH_L1_OUTPROJ: gemm_naive(p.ACT, DM, p.W_oout, DM, TL, DM, EpiOut_naive{P_of(p), p.o_b_out}, gtid, gsize); break;
    case PH_L1_LN1: ph_ln1(p, 1, gtid, gsize); break;
    case PH_L1_SCATTER: ph_scatter(p, 1, gtid, gsize); break;
    case PH_L1_MOE1: ph_moe1_naive(p, 1, gtid, gsize); break;
    case PH_L1_MOE2: ph_moe2_naive(p, 1, gtid, gsize); break;
    case PH_L1_LN2: ph_ln2(p, 1, gtid, gsize); break;
    default: break;
    }
}

static size_t fill_params(Params& p, void* const* d_in, void* d_out, void* d_ws) {
    const float* const* in = (const float* const*)d_in;
    int k = 0;
    p.x = in[k++]; p.c = in[k++]; p.ctx = in[k++]; p.c_ctx = in[k++]; p.w_mod = in[k++]; p.b_mod = in[k++]; p.ln_g = in[k++]; p.ln_b = in[k++];
    p.e_w_in = in[k++]; p.e_b_in = in[k++]; p.e_conv_w = in[k++]; p.e_conv_b = in[k++]; p.e_wa = in[k++]; p.e_ba = in[k++]; p.e_wx = in[k++]; p.e_bx = in[k++];
    p.e_lam = in[k++]; p.e_sink = in[k++]; p.e_w_out = in[k++]; p.e_b_out = in[k++];
    p.o_w_in = in[k++]; p.o_b_in = in[k++]; p.o_q_norm = in[k++]; p.o_kv_norm = in[k++]; p.o_w_uq = in[k++]; p.o_w_uk = in[k++]; p.o_w_uv = in[k++];
    p.o_dw_w = in[k++]; p.o_dw_b = in[k++]; p.o_cln_g = in[k++]; p.o_cln_b = in[k++]; p.o_w_out = in[k++]; p.o_b_out = in[k++];
    p.moe_wg = in[k++]; p.moe_bg = in[k++]; p.moe_wr = in[k++]; p.moe_br = in[k++]; p.moe_w1 = in[k++]; p.moe_w3 = in[k++]; p.moe_w2 = in[k++];
    p.out = (float*)d_out;
    char* w = (char*)d_ws; size_t off = 0;
    auto take = [&](size_t bytes) { char* r = w + off; off += (bytes + 255) & ~(size_t)255; return r; };
    p.bar = (unsigned*)take(16384);
    p.LRUW = (bf16_t*)take((size_t)2 * LRU_NBLK * 2 * LRU_BD * LRU_BD * 2); p.LRUC = (float*)take((size_t)2 * LRU_W * 3 * 4);
    p.WTR = (float*)take((size_t)2 * (N_GROUPS + N_EXP) * DM * 4);
    p.WRH = (bf16_t*)take((size_t)2 * 64 * DM * 2); p.WRL = (bf16_t*)take((size_t)2 * 64 * DM * 2);
    p.MOD = (float*)take((size_t)2 * (NB + 1) * 6 * DM * 4);
    p.XC = (float*)take((size_t)TC * DM * 4);
    p.ROPE_SWA = (float*)take((size_t)128 * (SWA_HD / 4) * 2 * 4);
    p.ROPE_MLA = (float*)take((size_t)128 * (MLA_ROPE / 4) * 2 * 4);
    p.SSQ = (float*)take((size_t)TT * 8 * 4);
    p.cnt = (int*)take(2 * N_EXP * CS * 4);
    p.tok_e = (int*)take((size_t)TT * 2 * 4); p.tok_pos = (int*)take((size_t)TT * 2 * 4); p.tok_gate = (float*)take((size_t)TT * 2 * 4); p.tok_row = (int*)take((size_t)TT * 2 * 4); p.slot_tok = (int*)take((size_t)N_EXP * TT * 4);
    p.W_ein = (bf16_t*)take((size_t)EVEN_IN * DM * 2); p.W_eout = (bf16_t*)take((size_t)DM * DM * 2);
    p.W_oin = (bf16_t*)take((size_t)OPLD * DM * 2); p.W_oout = (bf16_t*)take((size_t)DM * DM * 2);
    p.W_uq = (bf16_t*)take((size_t)MLA_H * MLA_QD * MLA_QR * 2); p.W_ukv = (bf16_t*)take((size_t)MLA_H * (MLA_NOPE + MLA_V) * MLA_KVR * 2);
    p.W_up = (bf16_t*)take((size_t)2 * N_EXP * 2 * D_EXP * DM * 2); p.W_dn = (bf16_t*)take((size_t)2 * N_EXP * DM * D_EXP * 2);
    p.ACT = (bf16_t*)take((size_t)TT * DM * 2);
    p.M = (unsigned char*)take(M_BYTES);
    return off;
}

#ifndef CPU_SIM
constexpr int LDS_MAIN = 147456, LDS_BYTES = LDS_MAIN + 256;
#ifndef ENG_MASK
#define ENG_MASK 0xffffffffu
#endif
__global__ void __launch_bounds__(512, 2) mega(Params p) {
    extern __shared__ __attribute__((aligned(16))) unsigned char lds_raw[];
    PG8_LAS unsigned char* lds = (PG8_LAS unsigned char*)lds_raw;
    cg::grid_group grid = cg::this_grid();
    volatile LAS unsigned* bar_st = (volatile LAS unsigned*)(lds + LDS_MAIN);
    if (threadIdx.x < 2) bar_st[threadIdx.x] = 0u;
    __syncthreads();
    (void)xcd_barrier_post(p.bar, bar_st);
    const int G = (int)gridDim.x, bx = (int)blockIdx.x;
#define gtid ((long)((int)blockIdx.x * 512 + (int)threadIdx.x))
#define gsize ((long)((int)gridDim.x * 512))
#ifndef REP_PHASE
#define REP_PHASE -1
#endif
#ifndef ATT_VAR
#define ATT_VAR 0
#endif
#ifndef TS_PHASE
#define TS_PHASE -1
#endif
#define TS_SLOT ((volatile LAS unsigned long long*)((LAS unsigned char*)lds + LDS_MAIN + 64))
#define TS_ME ({ unsigned t_ = threadIdx.x; asm volatile("" : "+v"(t_)); t_ == 0u && blockIdx.x == 0u; })
#define TS_BEGIN(k) do { if ((k) == TS_PHASE && TS_ME) TS_SLOT[0] = __builtin_amdgcn_s_memrealtime(); } while (0)
#define TS_END(k) do { if ((k) == TS_PHASE && TS_ME) TS_SLOT[1] = __builtin_amdgcn_s_memrealtime() - TS_SLOT[0]; } while (0)
#define IN(k) (p.ph_lo <= (k) && (k) <= p.ph_hi)
#define SYNC(k) do { if ((k) < p.ph_hi) { XcdBarrier b_; b_.bar = p.bar; b_.x = xb_xcc_id(); b_.st = (volatile LAS unsigned*)((LAS unsigned char*)lds + LDS_MAIN); xcd_barrier(b_); } } while (0)
#define NAIVE(k) do { if (IN(k)) { run_phase(p, (k), gtid, gsize); SYNC(k); } } while (0)
    if (IN(PH_PROLOGUE)) { TS_BEGIN(PH_PROLOGUE); ph_misc(p, gtid, gsize); fast::mod_phase(p, lds); fast::weights_phase(p, lds, 0, G > 2 * (6 * DM / 64) ? 2 * (6 * DM / 64) : 0, 0, fast::WS_SMALL0);
        SYNC(PH_PROLOGUE);  TS_END(PH_PROLOGUE); }
    if (REP_PHASE == PH_PROLOGUE && IN(PH_PROLOGUE)) { ph_misc(p, gtid, gsize); fast::mod_phase(p, lds); fast::weights_phase(p, lds, 0, G > 2 * (6 * DM / 64) ? 2 * (6 * DM / 64) : 0, 0, fast::WS_SMALL0);
        SYNC(PH_PROLOGUE); }
    if (IN(PH_L0_MODULATE)) { TS_BEGIN(PH_L0_MODULATE); fast::modulate0_phase(p);
        SYNC(PH_L0_MODULATE);  TS_END(PH_L0_MODULATE); }
    if (REP_PHASE == PH_L0_MODULATE && IN(PH_L0_MODULATE)) { fast::modulate0_phase(p);
        SYNC(PH_L0_MODULATE); }
    if (IN(PH_L0_INPROJ)) { TS_BEGIN(PH_L0_INPROJ);
        pg8::Gemm g{p.ACT, p.W_ein, TT, EVEN_IN, DM, DM}; pg8::StaticOrder S; S.init(TT, EVEN_IN, G, bx);
        pg8::EpiInE E{P_of(p), p.e_b_in, p.ROPE_SWA};
        pg8::gemm_phase<pg8::EpiInE, pg8::StaticOrder, true, true>(lds, g, S, E);
        fast::moe_stream_extra(p, (FLAS unsigned char*)lds, fast::WS_A, fast::WS_B, (TT / 256) * (EVEN_IN / 256) % G);
        SYNC(PH_L0_INPROJ);
     TS_END(PH_L0_INPROJ); }
    if (REP_PHASE == PH_L0_INPROJ && IN(PH_L0_INPROJ)) {
        pg8::Gemm g{p.ACT, p.W_ein, TT, EVEN_IN, DM, DM}; pg8::StaticOrder S; S.init(TT, EVEN_IN, G, bx);
        pg8::EpiInE E{P_of(p), p.e_b_in, p.ROPE_SWA};
        pg8::gemm_phase<pg8::EpiInE, pg8::StaticOrder, true, true>(lds, g, S, E); SYNC(PH_L0_INPROJ);
    }
    if (IN(PH_L0_ROPE)) { TS_BEGIN(PH_L0_ROPE); lru::lru_phase<1>(p, lds); SYNC(PH_L0_ROPE);  TS_END(PH_L0_ROPE); }
    if (REP_PHASE == PH_L0_ROPE && IN(PH_L0_ROPE)) { lru::lru_phase<1>(p, lds); SYNC(PH_L0_ROPE); }
    if (IN(PH_L0_CARRY)) { TS_BEGIN(PH_L0_CARRY);
        lru::lru_carry_phase(p, lds);
        const bf16_t* P = P_of(p);
        for (int u = bx; u < NB * SWA_H * (SEQ / 256); u += G) {
            const int c = u % 256, i = u / 256, bh = (c % 8) + 8 * i, qb = c / 8, b = bh / SWA_H, h = bh % SWA_H, kv = h / (SWA_H / SWA_KV), q0 = qb * 256;
            auto rowof = [=](int t) -> long { if (t >= 8) return (long)TL + b * CTX + 64 * (t - 8); int k0 = q0 - 128 + 64 * t; k0 = k0 < 0 ? 0 : (k0 > SEQ - 64 ? SEQ - 64 : k0); return (long)b * SEQ + k0; };
            auto mask = [=](fa::f32x16& p0, fa::f32x16& p1, int t, int qrow, int hi) { if (t < 8) { const int d0 = (q0 - 128 + 64 * t + 4 * hi) - (q0 + qrow);
                const unsigned dwb = (unsigned)(d0 + WINDOW), kub = (unsigned)(q0 - 128 + 64 * t + 4 * hi);
#pragma unroll
                for (int r = 0; r < 16; ++r) { const unsigned o_ = (unsigned)((r & 3) + 8 * (r >> 2)); const unsigned dw = dwb + o_, ku = kub + o_;
                    if (dw > 2u * WINDOW || ku >= (unsigned)SEQ) p0[r] = -1e30f;
                    if (dw + 32u > 2u * WINDOW || ku + 32u >= (unsigned)SEQ) p1[r] = -1e30f; } } };
            auto act = [](int t, int w) -> bool { return t >= 8 || (64 * t <= 32 * w + 31 + 2 * WINDOW && 64 * t + 63 >= 32 * w); };
            fa::attn_unit<SWA_HD, decltype(rowof), decltype(mask), 0, decltype(act)>(P + (size_t)(b * SEQ + q0) * EPLD + EC_Q + h * SWA_HD, EPLD, P + EC_K + kv * SWA_HD, EPLD, P + EC_V + kv * SWA_HD, EPLD,
                                  p.ACT + (size_t)(b * SEQ + q0) * DM + LRU_W + h * SWA_HD, DM, 12, rowof, mask, p.e_sink[h] * LOG2E, 1.0f, (FLAS char*)lds, act);
        }
        for (int u = (bx + NB * SWA_H) % G; u < NB * SWA_H; u += G) {
            const int b = u / SWA_H, h = u % SWA_H, kv = h / (SWA_H / SWA_KV);
            auto rowof = [=](int t) -> long { return (long)TL + b * CTX + 64 * t; };
            fa::attn_unit<SWA_HD>(P + (size_t)(TL + b * CTX) * EPLD + EC_Q + h * SWA_HD, EPLD, P + EC_K + kv * SWA_HD, EPLD, P + EC_V + kv * SWA_HD, EPLD,
                                  p.ACT + (size_t)(TL + b * CTX) * DM + LRU_W + h * SWA_HD, DM, 4, rowof, fa::NoMask{}, p.e_sink[h] * LOG2E, 1.0f, (FLAS char*)lds);
        }
        fast::moe_stream_extra(p, (FLAS unsigned char*)lds, 0, fast::WS_A, NB * 2 * (LRU_W / 64));
        SYNC(PH_L0_CARRY);
     TS_END(PH_L0_CARRY); }
    if (REP_PHASE == PH_L0_CARRY && IN(PH_L0_CARRY)) {
        lru::lru_carry_phase(p, lds);
        const bf16_t* P = P_of(p);
        for (int u = bx; u < NB * SWA_H * (SEQ / 256); u += G) {
            const int c = u % 256, i = u / 256, bh = (c % 8) + 8 * i, qb = c / 8, b = bh / SWA_H, h = bh % SWA_H, kv = h / (SWA_H / SWA_KV), q0 = qb * 256;
            auto rowof = [=](int t) -> long { if (t >= 8) return (long)TL + b * CTX + 64 * (t - 8); int k0 = q0 - 128 + 64 * t; k0 = k0 < 0 ? 0 : (k0 > SEQ - 64 ? SEQ - 64 : k0); return (long)b * SEQ + k0; };
            auto mask = [=](fa::f32x16& p0, fa::f32x16& p1, int t, int qrow, int hi) { if (t < 8) { const int d0 = (q0 - 128 + 64 * t + 4 * hi) - (q0 + qrow);
                const unsigned dwb = (unsigned)(d0 + WINDOW), kub = (unsigned)(q0 - 128 + 64 * t + 4 * hi);
#pragma unroll
                for (int r = 0; r < 16; ++r) { const unsigned o_ = (unsigned)((r & 3) + 8 * (r >> 2)); const unsigned dw = dwb + o_, ku = kub + o_;
                    if (dw > 2u * WINDOW || ku >= (unsigned)SEQ) p0[r] = -1e30f;
                    if (dw + 32u > 2u * WINDOW || ku + 32u >= (unsigned)SEQ) p1[r] = -1e30f; } } };
            auto act = [](int t, int w) -> bool { return t >= 8 || (64 * t <= 32 * w + 31 + 2 * WINDOW && 64 * t + 63 >= 32 * w); };
            fa::attn_unit<SWA_HD, decltype(rowof), decltype(mask), 0, decltype(act)>(P + (size_t)(b * SEQ + q0) * EPLD + EC_Q + h * SWA_HD, EPLD, P + EC_K + kv * SWA_HD, EPLD, P + EC_V + kv * SWA_HD, EPLD,
                                  p.ACT + (size_t)(b * SEQ + q0) * DM + LRU_W + h * SWA_HD, DM, 12, rowof, mask, p.e_sink[h] * LOG2E, 1.0f, (FLAS char*)lds, act);
        }
        for (int u = (bx + NB * SWA_H) % G; u < NB * SWA_H; u += G) {
            const int b = u / SWA_H, h = u % SWA_H, kv = h / (SWA_H / SWA_KV);
            auto rowof = [=](int t) -> long { return (long)TL + b * CTX + 64 * t; };
            fa::attn_unit<SWA_HD>(P + (size_t)(TL + b * CTX) * EPLD + EC_Q + h * SWA_HD, EPLD, P + EC_K + kv * SWA_HD, EPLD, P + EC_V + kv * SWA_HD, EPLD,
                                  p.ACT + (size_t)(TL + b * CTX) * DM + LRU_W + h * SWA_HD, DM, 4, rowof, fa::NoMask{}, p.e_sink[h] * LOG2E, 1.0f, (FLAS char*)lds);
        }
        SYNC(PH_L0_CARRY);
    }
    if (IN(PH_L0_MIX)) { TS_BEGIN(PH_L0_MIX); lru::lru_pass2_light(p); fast::moe_stream_extra(p, (FLAS unsigned char*)lds, fast::WS_NMH, fast::WS_L1A, (NB * LRU_NV) % G); SYNC(PH_L0_MIX);  TS_END(PH_L0_MIX); }
    if (REP_PHASE == PH_L0_MIX && IN(PH_L0_MIX)) { lru::lru_pass2_light(p); SYNC(PH_L0_MIX); }
    if (IN(PH_L0_OUTPROJ)) { TS_BEGIN(PH_L0_OUTPROJ);
        pg8::Gemm g{p.ACT, p.W_eout, TT, DM, DM, DM}; pg8::StaticOrder S; S.init(TT, DM, G, bx);
        pg8::EpiPlain E{P_of(p), DM, p.e_b_out, 0};
        pg8::gemm_phase<pg8::EpiPlain, pg8::StaticOrder, true, true>(lds, g, S, E);
        fast::moe_stream_extra(p, (FLAS unsigned char*)lds, fast::WS_L1B, 2 * fast::WS_NMH, (TT / 256) * (DM / 256) % G);
        SYNC(PH_L0_OUTPROJ);
     TS_END(PH_L0_OUTPROJ); }
    if (REP_PHASE == PH_L0_OUTPROJ && IN(PH_L0_OUTPROJ)) {
        pg8::Gemm g{p.ACT, p.W_eout, TT, DM, DM, DM}; pg8::StaticOrder S; S.init(TT, DM, G, bx);
        pg8::EpiPlain E{P_of(p), DM, p.e_b_out, 0};
        pg8::gemm_phase<pg8::EpiPlain, pg8::StaticOrder, true, true>(lds, g, S, E);
        SYNC(PH_L0_OUTPROJ);
    }
    if (IN(PH_L0_LN1)) { TS_BEGIN(PH_L0_LN1); fast::ln1_phase(p, 0, lds); fast::moe_stream_extra(p, (FLAS unsigned char*)lds, fast::WS_L1A, fast::WS_L1B, (TT / 32) % G); SYNC(PH_L0_LN1);  TS_END(PH_L0_LN1); }
    if (REP_PHASE == PH_L0_LN1 && IN(PH_L0_LN1)) { fast::ln1_phase(p, 0, lds); SYNC(PH_L0_LN1); }
    if (IN(PH_L0_SCATTER)) { TS_BEGIN(PH_L0_SCATTER);    TS_END(PH_L0_SCATTER); }
    if (REP_PHASE == PH_L0_SCATTER && IN(PH_L0_SCATTER)) {   }
    if (IN(PH_L0_MOE1)) { TS_BEGIN(PH_L0_MOE1);
        pg8::Gemm g{p.ACT, p.W_up, CR_MAX, 2 * D_EXP, DM / 2, DM / 2}; pg8::MoeOrder S; S.init(p.cnt, 2 * D_EXP / pg8::BM, G, bx, (PG8_LAS int*)(lds + pg8::STAGE_BYTES), p.slot_tok);
        pg8::EpiMoeUp8 E{(unsigned char*)(p.M + M_H1)};
        pg8::gemm_phase<pg8::EpiMoeUp8, pg8::MoeOrder, true, true, true, true>(lds, g, S, E); SYNC(PH_L0_MOE1);
     TS_END(PH_L0_MOE1); }
    if (REP_PHASE == PH_L0_MOE1 && IN(PH_L0_MOE1)) {
        pg8::Gemm g{p.ACT, p.W_up, CR_MAX, 2 * D_EXP, DM / 2, DM / 2}; pg8::MoeOrder S; S.init(p.cnt, 2 * D_EXP / pg8::BM, G, bx, (PG8_LAS int*)(lds + pg8::STAGE_BYTES), p.slot_tok);
        pg8::EpiMoeUp8 E{(unsigned char*)(p.M + M_H1)};
        pg8::gemm_phase<pg8::EpiMoeUp8, pg8::MoeOrder, true, true, true, true>(lds, g, S, E); SYNC(PH_L0_MOE1);
    }
    if (IN(PH_L0_MOE2)) { TS_BEGIN(PH_L0_MOE2);
        pg8::Gemm g{(const bf16_t*)(p.M + M_H1), p.W_dn, CR_MAX, DM, D_EXP / 2, D_EXP / 2}; pg8::MoeOrder S; S.init(p.cnt, DM / pg8::BM, G, bx, (PG8_LAS int*)(lds + pg8::STAGE_BYTES));
        pg8::EpiScale E{(unsigned char*)(p.M + M_XS), DM, FP8_SY / (FP8_SH * FP8_SW2), DM / pg8::BM};
        pg8::gemm_phase<pg8::EpiScale, pg8::MoeOrder, true, true, false, true>(lds, g, S, E); SYNC(PH_L0_MOE2);
     TS_END(PH_L0_MOE2); }
    if (REP_PHASE == PH_L0_MOE2 && IN(PH_L0_MOE2)) {
        pg8::Gemm g{(const bf16_t*)(p.M + M_H1), p.W_dn, CR_MAX, DM, D_EXP / 2, D_EXP / 2}; pg8::MoeOrder S; S.init(p.cnt, DM / pg8::BM, G, bx, (PG8_LAS int*)(lds + pg8::STAGE_BYTES));
        pg8::EpiScale E{(unsigned char*)(p.M + M_XS), DM, FP8_SY / (FP8_SH * FP8_SW2), DM / pg8::BM};
        pg8::gemm_phase<pg8::EpiScale, pg8::MoeOrder, true, true, false, true>(lds, g, S, E); SYNC(PH_L0_MOE2);
    }
    if (IN(PH_L0_LN2)) { TS_BEGIN(PH_L0_LN2); fast::ln2_phase(p, 0); SYNC(PH_L0_LN2);  TS_END(PH_L0_LN2); }
    if (REP_PHASE == PH_L0_LN2 && IN(PH_L0_LN2)) { fast::ln2_phase(p, 0); SYNC(PH_L0_LN2); }
    if (IN(PH_L1_INPROJ)) { TS_BEGIN(PH_L1_INPROJ);
        pg8::Gemm g{p.ACT, p.W_oin, TT, OPLD, DM, DM}; pg8::StaticOrder S; S.init(TT, OPLD, G, bx);
        pg8::EpiInO E{P_of(p), p.o_b_in, p.ROPE_MLA, p.SSQ, (bf16_t*)(p.M + M_K)};
        pg8::gemm_phase<pg8::EpiInO, pg8::StaticOrder, true, true>(lds, g, S, E); SYNC(PH_L1_INPROJ);
     TS_END(PH_L1_INPROJ); }
    if (REP_PHASE == PH_L1_INPROJ && IN(PH_L1_INPROJ)) {
        pg8::Gemm g{p.ACT, p.W_oin, TT, OPLD, DM, DM}; pg8::StaticOrder S; S.init(TT, OPLD, G, bx);
        pg8::EpiInO E{P_of(p), p.o_b_in, p.ROPE_MLA, p.SSQ, (bf16_t*)(p.M + M_K)};
        pg8::gemm_phase<pg8::EpiInO, pg8::StaticOrder, true, true>(lds, g, S, E); SYNC(PH_L1_INPROJ);
    }
    if (IN(PH_L1_UP)) { TS_BEGIN(PH_L1_UP);
        conf::conf_phase(p, lds);
#ifndef DBG_NO_UQ
        { pg8::Gemm g{P_of(p), p.W_uq, TL, MLA_H * MLA_QD, MLA_QR, OPLD}; pg8::StaticOrder S; S.init(TL, MLA_H * MLA_QD, G, bx);
          pg8::EpiUq E{(bf16_t*)(p.M + M_Q), p.ROPE_MLA, p.SSQ};
          pg8::gemm_phase<pg8::EpiUq, pg8::StaticOrder, true, true>(lds, g, S, E); }
#endif
#ifndef DBG_NO_UKV
        { pg8::Gemm g{P_of(p) + OC_CKV, p.W_ukv, TT, MLA_H * (MLA_NOPE + MLA_V), MLA_KVR, OPLD}; pg8::StaticOrder S; S.init(TT, MLA_H * (MLA_NOPE + MLA_V), G, (bx + G / 2) % G);
          pg8::EpiUkv E{(bf16_t*)(p.M + M_K), (bf16_t*)(p.M + M_V), p.SSQ};
          pg8::gemm_phase<pg8::EpiUkv, pg8::StaticOrder, true, true>(lds, g, S, E); }
#endif
        SYNC(PH_L1_UP);
     TS_END(PH_L1_UP); }
    if (REP_PHASE == PH_L1_UP && IN(PH_L1_UP)) {
        conf::conf_phase(p, lds);
#ifndef DBG_NO_UQ
        { pg8::Gemm g{P_of(p), p.W_uq, TL, MLA_H * MLA_QD, MLA_QR, OPLD}; pg8::StaticOrder S; S.init(TL, MLA_H * MLA_QD, G, bx);
          pg8::EpiUq E{(bf16_t*)(p.M + M_Q), p.ROPE_MLA, p.SSQ};
          pg8::gemm_phase<pg8::EpiUq, pg8::StaticOrder, true, true>(lds, g, S, E); }
#endif
#ifndef DBG_NO_UKV
        { pg8::Gemm g{P_of(p) + OC_CKV, p.W_ukv, TT, MLA_H * (MLA_NOPE + MLA_V), MLA_KVR, OPLD}; pg8::StaticOrder S; S.init(TT, MLA_H * (MLA_NOPE + MLA_V), G, (bx + G / 2) % G);
          pg8::EpiUkv E{(bf16_t*)(p.M + M_K), (bf16_t*)(p.M + M_V), p.SSQ};
          pg8::gemm_phase<pg8::EpiUkv, pg8::StaticOrder, true, true>(lds, g, S, E); }
#endif
        SYNC(PH_L1_UP);
    }
    if (IN(PH_L1_ATTN)) { TS_BEGIN(PH_L1_ATTN);
        const bf16_t* Q = (const bf16_t*)(p.M + M_Q); const bf16_t* Kb = (const bf16_t*)(p.M + M_K); const bf16_t* V = (const bf16_t*)(p.M + M_V);
        for (int u = bx; u < NB * MLA_H * (SEQ / 256); u += G) {
            const int c = u % 256, i = u / 256, bh = (c % 8) + 8 * i, qb = c / 8, b = bh / MLA_H, h = bh % MLA_H, q0 = qb * 256;
            auto rowof = [=](int t) -> long { return t < CTX / 64 ? (long)TL + b * CTX + 64 * t : (long)b * SEQ + 64 * (t - CTX / 64); };
            fa::attn_unit<MLA_QD>(Q + (size_t)(b * SEQ + q0) * MLA_H * MLA_QD + h * MLA_QD, MLA_H * MLA_QD, Kb + h * MLA_QD, MLA_H * MLA_QD, V + h * MLA_V, MLA_H * MLA_V,
                                  p.ACT + (size_t)(b * SEQ + q0) * DM + h * MLA_V, DM, (CTX + SEQ) / 64, rowof, fa::NoMask{}, -1e30f, 0.0f, (FLAS char*)lds);
        }
        SYNC(PH_L1_ATTN);
     TS_END(PH_L1_ATTN); }
    if (REP_PHASE == PH_L1_ATTN && IN(PH_L1_ATTN)) {
        const bf16_t* Q = (const bf16_t*)(p.M + M_Q); const bf16_t* Kb = (const bf16_t*)(p.M + M_K); const bf16_t* V = (const bf16_t*)(p.M + M_V);
        for (int u = bx; u < NB * MLA_H * (SEQ / 256); u += G) {
            const int c = u % 256, i = u / 256, bh = (c % 8) + 8 * i, qb = c / 8, b = bh / MLA_H, h = bh % MLA_H, q0 = qb * 256;
            auto rowof = [=](int t) -> long { return t < CTX / 64 ? (long)TL + b * CTX + 64 * t : (long)b * SEQ + 64 * (t - CTX / 64); };
            fa::attn_unit<MLA_QD, decltype(rowof), fa::NoMask, ATT_VAR>(Q + (size_t)(b * SEQ + q0) * MLA_H * MLA_QD + h * MLA_QD, MLA_H * MLA_QD, Kb + h * MLA_QD, MLA_H * MLA_QD, V + h * MLA_V, MLA_H * MLA_V,
                                  (bf16_t*)P_of(p), 64, (CTX + SEQ) / 64, rowof, fa::NoMask{}, -1e30f, 0.0f, (FLAS char*)lds);
        }
        SYNC(PH_L1_ATTN);
    }
    if (IN(PH_L1_OUTPROJ)) { TS_BEGIN(PH_L1_OUTPROJ);
        pg8::Gemm g{p.ACT, p.W_oout, TL, DM, DM, DM}; pg8::StaticOrder S; S.init(TL, DM, G, bx);
        pg8::EpiPlain E{P_of(p), DM, p.o_b_out, 0};
        pg8::gemm_phase<pg8::EpiPlain, pg8::StaticOrder, true, true>(lds, g, S, E); SYNC(PH_L1_OUTPROJ);
     TS_END(PH_L1_OUTPROJ); }
    if (REP_PHASE == PH_L1_OUTPROJ && IN(PH_L1_OUTPROJ)) {
        pg8::Gemm g{p.ACT, p.W_oout, TL, DM, DM, DM}; pg8::StaticOrder S; S.init(TL, DM, G, bx);
        pg8::EpiPlain E{P_of(p), DM, p.o_b_out, 0};
        pg8::gemm_phase<pg8::EpiPlain, pg8::StaticOrder, true, true>(lds, g, S, E); SYNC(PH_L1_OUTPROJ);
    }
    if (IN(PH_L1_LN1)) { TS_BEGIN(PH_L1_LN1); fast::ln1_phase(p, 1, lds); SYNC(PH_L1_LN1);  TS_END(PH_L1_LN1); }
    if (REP_PHASE == PH_L1_LN1 && IN(PH_L1_LN1)) { fast::ln1_phase(p, 1, lds); SYNC(PH_L1_LN1); }
    if (IN(PH_L1_SCATTER)) { TS_BEGIN(PH_L1_SCATTER);    TS_END(PH_L1_SCATTER); }
    if (REP_PHASE == PH_L1_SCATTER && IN(PH_L1_SCATTER)) {   }
    if (IN(PH_L1_MOE1)) { TS_BEGIN(PH_L1_MOE1);
        pg8::Gemm g{p.ACT, p.W_up + (size_t)N_EXP * 2 * D_EXP * DM / 2, CR_MAX, 2 * D_EXP, DM / 2, DM / 2}; pg8::MoeOrder S; S.init(p.cnt + N_EXP * CS, 2 * D_EXP / pg8::BM, G, bx, (PG8_LAS int*)(lds + pg8::STAGE_BYTES), p.slot_tok);
        pg8::EpiMoeUp8 E{(unsigned char*)(p.M + M_H1)};
        pg8::gemm_phase<pg8::EpiMoeUp8, pg8::MoeOrder, true, true, true, true>(lds, g, S, E); SYNC(PH_L1_MOE1);
     TS_END(PH_L1_MOE1); }
    if (REP_PHASE == PH_L1_MOE1 && IN(PH_L1_MOE1)) {
        pg8::Gemm g{p.ACT, p.W_up + (size_t)N_EXP * 2 * D_EXP * DM / 2, CR_MAX, 2 * D_EXP, DM / 2, DM / 2}; pg8::MoeOrder S; S.init(p.cnt + N_EXP * CS, 2 * D_EXP / pg8::BM, G, bx, (PG8_LAS int*)(lds + pg8::STAGE_BYTES), p.slot_tok);
        pg8::EpiMoeUp8 E{(unsigned char*)(p.M + M_H1)};
        pg8::gemm_phase<pg8::EpiMoeUp8, pg8::MoeOrder, true, true, true, true>(lds, g, S, E); SYNC(PH_L1_MOE1);
    }
    if (IN(PH_L1_MOE2)) { TS_BEGIN(PH_L1_MOE2);
        pg8::Gemm g{(const bf16_t*)(p.M + M_H1), p.W_dn + (size_t)N_EXP * DM * D_EXP / 2, CR_MAX, DM, D_EXP / 2, D_EXP / 2}; pg8::MoeOrder S; S.init(p.cnt + N_EXP * CS, DM / pg8::BM, G, bx, (PG8_LAS int*)(lds + pg8::STAGE_BYTES));
        pg8::EpiScale E{(unsigned char*)(p.M + M_XS), DM, FP8_SY / (FP8_SH * FP8_SW2), DM / pg8::BM};
        pg8::gemm_phase<pg8::EpiScale, pg8::MoeOrder, true, true, false, true>(lds, g, S, E); SYNC(PH_L1_MOE2);
     TS_END(PH_L1_MOE2); }
    if (REP_PHASE == PH_L1_MOE2 && IN(PH_L1_MOE2)) {
        pg8::Gemm g{(const bf16_t*)(p.M + M_H1), p.W_dn + (size_t)N_EXP * DM * D_EXP / 2, CR_MAX, DM, D_EXP / 2, D_EXP / 2}; pg8::MoeOrder S; S.init(p.cnt + N_EXP * CS, DM / pg8::BM, G, bx, (PG8_LAS int*)(lds + pg8::STAGE_BYTES));
        pg8::EpiScale E{(unsigned char*)(p.M + M_XS), DM, FP8_SY / (FP8_SH * FP8_SW2), DM / pg8::BM};
        pg8::gemm_phase<pg8::EpiScale, pg8::MoeOrder, true, true, false, true>(lds, g, S, E); SYNC(PH_L1_MOE2);
    }
    if (IN(PH_L1_LN2)) { TS_BEGIN(PH_L1_LN2); fast::ln2_phase(p, 1);
        SYNC(PH_L1_LN2);  TS_END(PH_L1_LN2); }
    if (REP_PHASE == PH_L1_LN2 && IN(PH_L1_LN2)) { fast::ln2_phase(p, 1);
        SYNC(PH_L1_LN2); }
    if (TS_PHASE >= 0 && TS_ME) { const unsigned long long t0 = __builtin_amdgcn_s_memrealtime(); const unsigned long long dt4 = 4ull * TS_SLOT[1]; while (__builtin_amdgcn_s_memrealtime() - t0 < dt4) __builtin_amdgcn_s_sleep(8); }
#undef gtid
#undef gsize
}

extern "C" void kernel_launch(void* const* d_in, const int* in_sizes, int n_in, void* d_out, int out_size, void* d_ws, size_t ws_size, hipStream_t stream) {
    static int grid_blocks = 0;
    if (!grid_blocks) {
        int dev = 0, cus = 0, per_cu = 0;
        (void)hipGetDevice(&dev);
        (void)hipDeviceGetAttribute(&cus, hipDeviceAttributeMultiprocessorCount, dev);
        (void)hipFuncSetAttribute((const void*)mega, hipFuncAttributeMaxDynamicSharedMemorySize, LDS_BYTES);
        (void)hipOccupancyMaxActiveBlocksPerMultiprocessor(&per_cu, mega, 512, LDS_BYTES);
        if (per_cu < 1) { fprintf(stderr, "occupancy query says %d blocks per CU\n", per_cu); per_cu = 1; }
        grid_blocks = cus;
    }
    Params p{};
    const size_t need = fill_params(p, d_in, d_out, d_ws);
    if (need > ws_size) { fprintf(stderr, "workspace too small: need %zu have %zu\n", need, ws_size); return; }
    p.ph_lo = 0; p.ph_hi = N_PHASES - 1;
    (void)hipMemsetAsync(p.bar, 0, 16384, stream);
    void* args[] = {&p};
    hipError_t e = hipLaunchCooperativeKernel((void*)mega, dim3(grid_blocks), dim3(512), args, LDS_BYTES, stream);
    if (e != hipSuccess) fprintf(stderr, "cooperative launch failed: %s (grid %d)\n", hipGetErrorString(e), grid_blocks);
}
#endif
```
